# Optimizing an MI355X kernel written in HIP

```python
import jax, jax.numpy as jnp
from jax import lax
import numpy as np

D_MODEL = 2048
BATCH = 4
SEQ = 4096
DEPTH = 2

CHUNK = 64
MIX_WIDTH = D_MODEL
RET_WIDTH = MIX_WIDTH // 2
GMLP_WIDTH = MIX_WIDTH - RET_WIDTH
RET_HEADS = 8
RET_HEAD_DIM = RET_WIDTH // RET_HEADS
GMLP_GROUPS = 8
GMLP_GROUP_DIM = GMLP_WIDTH // GMLP_GROUPS
GMLP_BLOCK = 128
ROPE_BASE = 10000.0
N_GROUPS = 4
EXPERTS_PER_GROUP = 8
N_EXPERTS = N_GROUPS * EXPERTS_PER_GROUP
TOP_K_IN_GROUP = 2
D_EXPERT = D_MODEL // 2
IN_WIDTH = 4 * RET_WIDTH + 2 * GMLP_WIDTH
EPS = 1e-6

kernel_name = "hybrid_retention_gmlp_hmoe"


def rmsnorm(x, w):
    xf = x.astype(jnp.float32)
    y = xf * lax.rsqrt(jnp.mean(xf * xf, axis=-1, keepdims=True) + EPS)
    return (y * w.astype(jnp.float32)).astype(x.dtype)


def group_layernorm(x, w):
    xf = x.astype(jnp.float32)
    mu = jnp.mean(xf, axis=-1, keepdims=True)
    var = jnp.mean(jnp.square(xf - mu), axis=-1, keepdims=True)
    y = (xf - mu) * lax.rsqrt(var + EPS)
    y = y.reshape(x.shape[:-2] + (x.shape[-2] * x.shape[-1],))
    return y * w.astype(jnp.float32)


def rope(x, pos):
    half = x.shape[-1] // 2
    freqs = ROPE_BASE ** (-jnp.arange(half, dtype=jnp.float32) / half)
    ang = pos[:, None] * freqs[None, :]
    cos = jnp.cos(ang)[None, :, None, :]
    sin = jnp.sin(ang)[None, :, None, :]
    xf = x.astype(jnp.float32)
    x1, x2 = xf[..., :half], xf[..., half:]
    return jnp.concatenate([x1 * cos - x2 * sin, x1 * sin + x2 * cos], axis=-1)


def retention(q, k, v):
    B, S, H, Dh = q.shape
    nc = S // CHUNK
    log_g = jnp.log1p(-jnp.exp2(-5.0 - jnp.arange(H, dtype=jnp.float32)))
    qc = q.astype(jnp.float32).reshape(B, nc, CHUNK, H, Dh)
    kc = (k.astype(jnp.float32) * (Dh ** -0.5)).reshape(B, nc, CHUNK, H, Dh)
    vc = v.astype(jnp.float32).reshape(B, nc, CHUNK, H, Dh)
    idx = jnp.arange(CHUNK, dtype=jnp.float32)
    diff = idx[:, None] - idx[None, :]
    d_intra = jnp.where(diff[None] >= 0,
                        jnp.exp(log_g[:, None, None] * jnp.maximum(diff, 0.0)[None]), 0.0)
    scores = jnp.einsum('bnthd,bnshd->bnhts', qc, kc) * d_intra[None, None]
    o_intra = jnp.einsum('bnhts,bnshe->bnthe', scores, vc)
    k_decay = jnp.exp(log_g[:, None] * (CHUNK - 1.0 - idx)[None])
    kv = jnp.einsum('bnshd,hs,bnshe->bnhde', kc, k_decay, vc)
    chunk_decay = jnp.exp(log_g * CHUNK)[None, :, None, None]

    def step(state, kv_n):
        return state * chunk_decay + kv_n, state

    init = jnp.zeros((B, H, Dh, Dh), jnp.float32)
    _, prev = lax.scan(step, init, jnp.moveaxis(kv, 1, 0))
    prev = jnp.moveaxis(prev, 0, 1)
    q_decay = jnp.exp(log_g[:, None] * (idx + 1.0)[None])
    o_inter = jnp.einsum('bnthd,ht,bnhde->bnthe', qc, q_decay, prev)
    return (o_intra + o_inter).reshape(B, S, H, Dh)


def spatial_gating(u, v, norm_w, w_s, b_s):
    B, S, _ = v.shape
    nb = S // GMLP_BLOCK
    vn = group_layernorm(v.reshape(B, S, GMLP_GROUPS, GMLP_GROUP_DIM), norm_w).astype(v.dtype)
    vb = vn.reshape(B, nb, GMLP_BLOCK, GMLP_GROUPS, GMLP_GROUP_DIM)
    cpos = jnp.arange(GMLP_BLOCK) // CHUNK
    mask = cpos[None, :] <= cpos[:, None]
    ws = jnp.where(mask[None], w_s, 0.0).astype(v.dtype)
    z = jnp.einsum('gts,bnsgc->bntgc', ws, vb) + b_s.T.astype(v.dtype)[None, None, :, :, None]
    return u * z.reshape(B, S, GMLP_WIDTH)


def hier_moe(h, rg_w, rg_b, re_w, re_b, w_gate, w_up, w_down):
    B, S, D = h.shape
    t = h.reshape(B * S, D)
    g_logits = jnp.matmul(t, rg_w).astype(jnp.float32) + rg_b.astype(jnp.float32)
    g_prob = jax.nn.softmax(g_logits, axis=-1)
    g_sel = jnp.argmax(g_logits, axis=-1)
    p_sel = jnp.take_along_axis(g_prob, g_sel[:, None], axis=-1)[:, 0]
    e_logits = (jnp.matmul(t, re_w).astype(jnp.float32) + re_b.astype(jnp.float32)
                ).reshape(-1, N_GROUPS, EXPERTS_PER_GROUP)
    e_sel_logits = jnp.take_along_axis(e_logits, g_sel[:, None, None], axis=1)[:, 0]
    top_v, top_i = lax.top_k(e_sel_logits, TOP_K_IN_GROUP)
    top_w = jax.nn.softmax(top_v, axis=-1) * p_sel[:, None]
    expert_ids = g_sel[:, None] * EXPERTS_PER_GROUP + top_i
    combine = jnp.sum(jax.nn.one_hot(expert_ids, N_EXPERTS, dtype=jnp.float32)
                      * top_w[..., None], axis=1).astype(h.dtype)
    y = jnp.zeros_like(t)
    for e in range(N_EXPERTS):
        he = jax.nn.silu(jnp.matmul(t, w_gate[e])) * jnp.matmul(t, w_up[e])
        y = y + combine[:, e:e + 1] * jnp.matmul(he, w_down[e])
    return y.reshape(B, S, D)


def setup_inputs(seed: int = 0) -> dict:
    key = jax.random.key(seed)
    ks = jax.random.split(key, 20)
    f32 = jnp.float32
    L, D = DEPTH, D_MODEL

    def nrm(k, shape, scale):
        return jax.random.normal(k, shape, f32) * scale

    return {
        "x": jax.random.normal(ks[0], (BATCH, SEQ, D), f32),
        "norm1_w": 1.0 + nrm(ks[1], (L, D), 0.02),
        "w_in": nrm(ks[2], (L, D, IN_WIDTH), D ** -0.5),
        "ret_gn_w": 1.0 + nrm(ks[3], (L, RET_WIDTH), 0.02),
        "gmlp_norm_w": 1.0 + nrm(ks[4], (L, GMLP_WIDTH), 0.02),
        "w_s": nrm(ks[5], (L, GMLP_GROUPS, GMLP_BLOCK, GMLP_BLOCK), 0.5 * GMLP_BLOCK ** -0.5),
        "b_s": 1.0 + nrm(ks[6], (L, GMLP_GROUPS, GMLP_BLOCK), 0.1),
        "w_out": nrm(ks[7], (L, MIX_WIDTH, D), MIX_WIDTH ** -0.5),
        "norm2_w": 1.0 + nrm(ks[8], (L, D), 0.02),
        "router_group_w": nrm(ks[9], (L, D, N_GROUPS), D ** -0.5),
        "router_group_b": nrm(ks[10], (L, N_GROUPS), 0.01),
        "router_expert_w": nrm(ks[11], (L, D, N_EXPERTS), D ** -0.5),
        "router_expert_b": nrm(ks[12], (L, N_EXPERTS), 0.01),
        "w_gate": nrm(ks[13], (L, N_EXPERTS, D, D_EXPERT), D ** -0.5),
        "w_up": nrm(ks[14], (L, N_EXPERTS, D, D_EXPERT), D ** -0.5),
        "w_down": nrm(ks[15], (L, N_EXPERTS, D_EXPERT, D), D_EXPERT ** -0.5),
        "final_norm_w": 1.0 + nrm(ks[16], (D,), 0.02),
    }


def reference(x, norm1_w, w_in, ret_gn_w, gmlp_norm_w, w_s, b_s, w_out, norm2_w,
              router_group_w, router_group_b, router_expert_w, router_expert_b,
              w_gate, w_up, w_down, final_norm_w):
    B, S, D = x.shape
    pos = jnp.arange(S, dtype=jnp.float32)
    splits = [RET_WIDTH, 2 * RET_WIDTH, 3 * RET_WIDTH, 4 * RET_WIDTH, 4 * RET_WIDTH + GMLP_WIDTH]
    for l in range(DEPTH):
        h = rmsnorm(x, norm1_w[l])
        proj = jnp.matmul(h, w_in[l])
        q, k, v, g, u, vs = jnp.split(proj, splits, axis=-1)
        q = rope(q.reshape(B, S, RET_HEADS, RET_HEAD_DIM), pos)
        k = rope(k.reshape(B, S, RET_HEADS, RET_HEAD_DIM), pos)
        r = retention(q, k, v.reshape(B, S, RET_HEADS, RET_HEAD_DIM))
        r = group_layernorm(r, ret_gn_w[l]).astype(x.dtype)
        ret_out = jax.nn.silu(g) * r
        gm_out = spatial_gating(jax.nn.gelu(u), jax.nn.gelu(vs), gmlp_norm_w[l], w_s[l], b_s[l])
        mix = jnp.concatenate([ret_out, gm_out], axis=-1)
        x = x + jnp.matmul(mix, w_out[l])
        h2 = rmsnorm(x, norm2_w[l])
        x = x + hier_moe(h2, router_group_w[l], router_group_b[l], router_expert_w[l],
                         router_expert_b[l], w_gate[l], w_up[l], w_down[l])
    return rmsnorm(x, final_norm_w)
```

```cpp
#include <hip/hip_runtime.h>
#include <cstdio>
#include <cstdint>

#define GAS __attribute__((address_space(1)))
#define LAS __attribute__((address_space(3)))
typedef unsigned short bf16_t;
typedef short bf16x8 __attribute__((ext_vector_type(8)));
typedef float f32x4 __attribute__((ext_vector_type(4)));
typedef float f32x2 __attribute__((ext_vector_type(2)));
typedef unsigned u32x4 __attribute__((ext_vector_type(4)));
typedef unsigned u32x2 __attribute__((ext_vector_type(2)));

constexpr int NTOK = 16384, DM = 2048, SEQ = 4096, NBATCH = 4, NH = 8, DH = 128, INW = 6144, NE = 32, EPG = 8, NGRP = 4, DE = 1024, NL = 2;
constexpr int GG = 8, GBLK = 128;
constexpr int SLOTS = 40960;
constexpr float EPS = 1e-6f;
constexpr int COL_Q = 0, COL_K = 1024, COL_V = 2048, COL_G = 3072, COL_U = 4096, COL_VS = 5120;

constexpr size_t MiB = 1u << 20;
constexpr size_t WS_CTL = 0, CTL_BYTES = 1 * MiB;
constexpr size_t WS_ROPE = 1 * MiB;
constexpr size_t WS_WINT = 3 * MiB;
constexpr size_t WS_WOUT = WS_WINT + 48 * MiB;
constexpr size_t WS_WGU = WS_WOUT + 16 * MiB;
constexpr size_t WS_WD = WS_WGU + 512 * MiB;
constexpr size_t WS_WR = WS_WD + 256 * MiB;
constexpr size_t WS_WSB = WS_WR + 1 * MiB;
constexpr size_t WS_XB = WS_WSB + 1 * MiB;
constexpr size_t WS_P = WS_XB + 64 * MiB;
constexpr size_t WS_SSUP = WS_P + 192 * MiB;
constexpr size_t WS_MIX = WS_SSUP + 16 * MiB;
constexpr size_t WS_X1 = WS_MIX + 64 * MiB;
constexpr size_t WS_X0B = WS_X1 + 64 * MiB;
constexpr size_t WS_H2B = WS_X1 + 128 * MiB;
constexpr size_t WS_REC = WS_H2B + 64 * MiB;
constexpr size_t WS_TOK = WS_REC + 1 * MiB;
constexpr size_t WS_RSE = WS_TOK + 2 * MiB;
constexpr size_t WS_HE = WS_RSE + 2 * MiB;
constexpr size_t WS_Y = WS_HE + 80 * MiB;
constexpr size_t WS_X2 = WS_Y + 160 * MiB;
constexpr size_t WS_END = WS_X2 + 128 * MiB;
constexpr int CW_TMO = 0, CW_BAR = 4096, CW_CNT = 8192;

struct Rec { int e0, s0; float w0; int e1, s1; float w1; int pad0, pad1; };

__device__ __forceinline__ unsigned f2bf(float f) { unsigned u = __builtin_bit_cast(unsigned, f); return (u + 0x7fffu + ((u >> 16) & 1u)) >> 16; }
__device__ __forceinline__ float bf2f(unsigned b) { return __builtin_bit_cast(float, b << 16); }
__device__ __forceinline__ unsigned pk2(float lo, float hi) { return f2bf(lo) | (f2bf(hi) << 16); }
__device__ __forceinline__ float wave_sum(float v) {
#pragma unroll
    for (int o = 1; o < 64; o <<= 1) v += __shfl_xor(v, o);
    return v;
}
__device__ __forceinline__ float shx(float v, int lane, int m) { return __builtin_bit_cast(float, __builtin_amdgcn_ds_bpermute((lane ^ m) << 2, __builtin_bit_cast(int, v))); }
__device__ __forceinline__ float wave_sum_l(float v, int lane) {
#pragma unroll
    for (int o = 1; o < 64; o <<= 1) v += shx(v, lane, o);
    return v;
}
__device__ __forceinline__ float gelu_tanh(float x) {
    const float u = x * (-2.302208198f) * (1.0f + 0.044715f * x * x);
    return x * __builtin_amdgcn_rcpf(1.0f + __builtin_amdgcn_exp2f(u));
}
__device__ __forceinline__ float silu(float x) { return x * __builtin_amdgcn_rcpf(1.0f + __builtin_amdgcn_exp2f(x * -1.4426950408889634f)); }
__device__ __forceinline__ float log2_gamma(int h) { return log2f(1.0f - exp2f(-5.0f - (float)h)); }

struct Ptrs {
    const float *x, *norm1_w, *w_in, *ret_gn_w, *gmlp_norm_w, *w_s, *b_s, *w_out, *norm2_w, *rg_w, *rg_b, *re_w, *re_b, *w_gate, *w_up, *w_down, *final_w;
    float* out; unsigned char* ws;
};

template <int MODE, class EB>
__device__ __forceinline__ void row_phase(const Ptrs& p, const float* src, float* x2, bf16_t* xb, const Rec* rec, const bf16_t* y, EB ebase  , int gw, int ngw, int lane) {
    for (int row = gw; row < NTOK; row += ngw) {
        const f32x4* xr = (const f32x4*)(src + (size_t)row * DM) + lane;
        f32x4 v[8];
#pragma unroll
        for (int j = 0; j < 8; ++j) v[j] = xr[64 * j];
        if (MODE >= 1) {
            const Rec r = rec[row];
            const size_t r0 = (size_t)(ebase[r.e0] + r.s0), r1 = (size_t)(ebase[r.e1] + r.s1);
            const u32x2* y0 = (const u32x2*)(y + r0 * DM) + lane; const u32x2* y1 = (const u32x2*)(y + r1 * DM) + lane;
#pragma unroll
            for (int j = 0; j < 8; ++j) {
                const u32x2 a = y0[64 * j], b = y1[64 * j];
                v[j].x += r.w0 * bf2f(a.x & 0xffffu) + r.w1 * bf2f(b.x & 0xffffu);
                v[j].y += r.w0 * bf2f(a.x >> 16) + r.w1 * bf2f(b.x >> 16);
                v[j].z += r.w0 * bf2f(a.y & 0xffffu) + r.w1 * bf2f(b.y & 0xffffu);
                v[j].w += r.w0 * bf2f(a.y >> 16) + r.w1 * bf2f(b.y >> 16);
            }
        }
        float s = 0.f;
#pragma unroll
        for (int j = 0; j < 8; ++j) s += (v[j].x * v[j].x + v[j].y * v[j].y) + (v[j].z * v[j].z + v[j].w * v[j].w);
        const float rstd = 1.0f / sqrtf(wave_sum_l(s, lane) * (1.0f / DM) + EPS);
        if (MODE == 1) { f32x4* o = (f32x4*)(x2 + (size_t)row * DM) + lane;
#pragma unroll
            for (int j = 0; j < 8; ++j) o[64 * j] = v[j]; }
        if (MODE <= 1) { u32x2* o = (u32x2*)(xb + (size_t)row * DM) + lane;
#pragma unroll
            for (int j = 0; j < 8; ++j) { u32x2 w; w.x = pk2(v[j].x * rstd, v[j].y * rstd); w.y = pk2(v[j].z * rstd, v[j].w * rstd); o[64 * j] = w; } }
        if (MODE == 2) { f32x4* o = (f32x4*)(p.out + (size_t)row * DM) + lane; const f32x4* fw = (const f32x4*)p.final_w + lane;
#pragma unroll
            for (int j = 0; j < 8; ++j) o[64 * j] = v[j] * rstd * fw[64 * j]; }
    }
}
__device__ __forceinline__ void compute_ebase(const unsigned* ctl, int l, int* ebase  ) {
    int acc = 0;
    for (int e = 0; e < NE; ++e) { ebase[e] = acc; const int c = (int)ctl[CW_CNT + (l * NE + e) * 16]; acc += ((c + 255) >> 8) << 8; }
    ebase[NE] = acc;
}
template <int MODE>
__global__ void __launch_bounds__(512) k_row(Ptrs p, int l) {
    __shared__ int ebase[NE + 1];
    const unsigned* ctl = (const unsigned*)(p.ws + WS_CTL);
    if (MODE >= 1) { if (threadIdx.x == 0) compute_ebase(ctl, l - 1, ebase); __syncthreads(); }
    const int lane = threadIdx.x & 63, gw = blockIdx.x * 8 + (threadIdx.x >> 6), ngw = gridDim.x * 8;
    const float* src = (MODE == 0) ? p.x : (const float*)(p.ws + WS_X1);
    row_phase<MODE>(p, src, (float*)(p.ws + WS_X2), (bf16_t*)(p.ws + WS_XB), (const Rec*)(p.ws + WS_REC), (const bf16_t*)(p.ws + WS_Y), (const int*)ebase, gw, ngw, lane);
}

enum { NV_G1 = 0, NV_G2 = 1, NV_G3 = 2, NV_G4 = 3 };
template <int MODE>
__global__ void __launch_bounds__(256) nv_gemm(Ptrs p, int l) {
    __shared__ float As[16][68], Bs[16][68], Bs2[16][68];
    __shared__ int s_ebase[NE + 1];
    const unsigned* ctl = (const unsigned*)(p.ws + WS_CTL);
    const int tid = threadIdx.x, tx = tid & 15, ty = tid >> 4;
    int M, N, K, lda, ldb; const bf16_t* A; const float *B, *B2 = nullptr, *kscale = nullptr; const int* arow = nullptr; int e = 0, rbase = 0;
    if (MODE == NV_G1) { M = NTOK; N = INW; K = DM; A = (const bf16_t*)(p.ws + WS_XB); lda = DM; B = p.w_in + (size_t)l * DM * INW; ldb = INW; kscale = p.norm1_w + l * DM; }
    else if (MODE == NV_G2) { M = NTOK; N = DM; K = DM; A = (const bf16_t*)(p.ws + WS_MIX); lda = DM; B = p.w_out + (size_t)l * DM * DM; ldb = DM; }
    else {
        e = blockIdx.z;
        if (tid == 0) compute_ebase(ctl, l, s_ebase);
        __syncthreads();
        M = (int)ctl[CW_CNT + (l * NE + e) * 16]; rbase = s_ebase[e];
        if (MODE == NV_G3) { N = DE; K = DM; A = (const bf16_t*)(p.ws + WS_H2B); lda = DM; arow = (const int*)(p.ws + WS_TOK) + (size_t)e * NTOK;
            B = p.w_gate + ((size_t)l * NE + e) * DM * DE; B2 = p.w_up + ((size_t)l * NE + e) * DM * DE; ldb = DE; kscale = p.norm2_w + l * DM; }
        else { N = DM; K = DE; A = (const bf16_t*)(p.ws + WS_HE) + (size_t)rbase * DE; lda = DE; B = p.w_down + ((size_t)l * NE + e) * DE * DM; ldb = DM; }
    }
    const int m0 = blockIdx.y * 64, n0 = blockIdx.x * 64;
    if (m0 >= M) return;
    float acc[4][4], acc2[4][4];
#pragma unroll
    for (int i = 0; i < 4; ++i)
#pragma unroll
        for (int j = 0; j < 4; ++j) { acc[i][j] = 0.f; acc2[i][j] = 0.f; }
    int ar = m0 + (tid >> 2); if (ar >= M) ar = M - 1;
    const size_t arow_g = (MODE == NV_G3) ? (size_t)arow[ar] : (size_t)ar;
    const bf16_t* ap = A + arow_g * lda + (tid & 3) * 4;
    const int bk = tid >> 4, bn = (tid & 15) * 4;
    for (int k0 = 0; k0 < K; k0 += 16) {
        const u32x2 av = *(const u32x2*)(ap + k0);
        float a0 = bf2f(av.x & 0xffffu), a1 = bf2f(av.x >> 16), a2 = bf2f(av.y & 0xffffu), a3 = bf2f(av.y >> 16);
        if (kscale) { const int kk = k0 + (tid & 3) * 4; a0 *= kscale[kk]; a1 *= kscale[kk + 1]; a2 *= kscale[kk + 2]; a3 *= kscale[kk + 3]; }
        const int kr = (tid & 3) * 4, rr = tid >> 2;
        As[kr][rr] = a0; As[kr + 1][rr] = a1; As[kr + 2][rr] = a2; As[kr + 3][rr] = a3;
        const f32x4 bv = *(const f32x4*)(B + (size_t)(k0 + bk) * ldb + n0 + bn);
        Bs[bk][bn] = bv.x; Bs[bk][bn + 1] = bv.y; Bs[bk][bn + 2] = bv.z; Bs[bk][bn + 3] = bv.w;
        if (MODE == NV_G3) { const f32x4 b2 = *(const f32x4*)(B2 + (size_t)(k0 + bk) * ldb + n0 + bn);
            Bs2[bk][bn] = b2.x; Bs2[bk][bn + 1] = b2.y; Bs2[bk][bn + 2] = b2.z; Bs2[bk][bn + 3] = b2.w; }
        __syncthreads();
#pragma unroll
        for (int kk = 0; kk < 16; ++kk) {
            float a[4], b[4], c[4];
#pragma unroll
            for (int i = 0; i < 4; ++i) { a[i] = As[kk][ty * 4 + i]; b[i] = Bs[kk][tx * 4 + i]; c[i] = (MODE == NV_G3) ? Bs2[kk][tx * 4 + i] : 0.f; }
#pragma unroll
            for (int i = 0; i < 4; ++i)
#pragma unroll
                for (int j = 0; j < 4; ++j) { acc[i][j] += a[i] * b[j]; if (MODE == NV_G3) acc2[i][j] += a[i] * c[j]; }
        }
        __syncthreads();
    }
#pragma unroll
    for (int i = 0; i < 4; ++i) {
        const int r = m0 + ty * 4 + i; if (r >= M) continue;
        const int c0 = n0 + tx * 4;
        if (MODE == NV_G1) {
            bf16_t* o = (bf16_t*)(p.ws + WS_P) + (size_t)r * INW + c0;
            const float sc = (c0 >= COL_K && c0 < COL_V) ? 0.08838834764831845f : 1.0f;
            u32x2 w; w.x = pk2(acc[i][0] * sc, acc[i][1] * sc); w.y = pk2(acc[i][2] * sc, acc[i][3] * sc); *(u32x2*)o = w;
        } else if (MODE == NV_G2) {
            const float* xin = (l == 0) ? p.x : (const float*)(p.ws + WS_X2);
            const f32x4 xv = *(const f32x4*)(xin + (size_t)r * DM + c0);
            *(f32x4*)((float*)(p.ws + WS_X1) + (size_t)r * DM + c0) = (f32x4){xv.x + acc[i][0], xv.y + acc[i][1], xv.z + acc[i][2], xv.w + acc[i][3]};
        } else if (MODE == NV_G3) {
            const float rs = ((const float*)(p.ws + WS_RSE))[(size_t)e * NTOK + r];
            float h[4];
#pragma unroll
            for (int j = 0; j < 4; ++j) h[j] = silu(acc[i][j] * rs) * (acc2[i][j] * rs);
            u32x2 w; w.x = pk2(h[0], h[1]); w.y = pk2(h[2], h[3]);
            *(u32x2*)((bf16_t*)(p.ws + WS_HE) + (size_t)(rbase + r) * DE + c0) = w;
        } else {
            u32x2 w; w.x = pk2(acc[i][0], acc[i][1]); w.y = pk2(acc[i][2], acc[i][3]);
            *(u32x2*)((bf16_t*)(p.ws + WS_Y) + (size_t)(rbase + r) * DM + c0) = w;
        }
    }
}

__global__ void __launch_bounds__(256) nv_rope_act(Ptrs p) {
    bf16_t* P = (bf16_t*)(p.ws + WS_P);
    const size_t total = (size_t)NTOK * (16 * 64 + 2048);
    for (size_t i = (size_t)blockIdx.x * 256 + threadIdx.x; i < total; i += (size_t)gridDim.x * 256) {
        const int row = (int)(i / 3072), c = (int)(i % 3072);
        bf16_t* pr = P + (size_t)row * INW;
        if (c < 1024) {
            const int hd = c >> 6, ii = c & 63; const int col = hd * 128 + ii;
            const float pos = (float)(row & (SEQ - 1));
            const float freq = powf(10000.0f, -(float)ii / 64.0f);
            const float ang = pos * freq; const float cs = cosf(ang), sn = sinf(ang);
            const float x1 = bf2f(pr[col]), x2 = bf2f(pr[col + 64]);
            pr[col] = (bf16_t)f2bf(x1 * cs - x2 * sn); pr[col + 64] = (bf16_t)f2bf(x1 * sn + x2 * cs);
        } else {
            const int col = COL_U + (c - 1024);
            pr[col] = (bf16_t)f2bf(gelu_tanh(bf2f(pr[col])));
        }
    }
}

__global__ void __launch_bounds__(256) nv_retention(Ptrs p, int l) {
    extern __shared__ float sm[];
    float* qs = sm; float* ks = qs + 64 * 129; float* vs = ks + 64 * 129; float* sc = vs + 64 * 129;
    const bf16_t* P = (const bf16_t*)(p.ws + WS_P);
    const int ti = blockIdx.x, h = blockIdx.y, b = blockIdx.z, tid = threadIdx.x;
    const float lg = log2_gamma(h);
    const int row0 = b * SEQ + ti * 64;
    for (int i = tid; i < 64 * 128; i += 256) { const int r = i >> 7, d = i & 127; qs[r * 129 + d] = bf2f(P[(size_t)(row0 + r) * INW + COL_Q + h * 128 + d]); }
    const int t = tid >> 2, part = tid & 3;
    float o[32];
#pragma unroll
    for (int j = 0; j < 32; ++j) o[j] = 0.f;
    for (int sj = 0; sj <= ti; ++sj) {
        __syncthreads();
        const int srow0 = b * SEQ + sj * 64;
        for (int i = tid; i < 64 * 128; i += 256) { const int r = i >> 7, d = i & 127;
            ks[r * 129 + d] = bf2f(P[(size_t)(srow0 + r) * INW + COL_K + h * 128 + d]); vs[r * 129 + d] = bf2f(P[(size_t)(srow0 + r) * INW + COL_V + h * 128 + d]); }
        __syncthreads();
#pragma unroll 4
        for (int si = 0; si < 16; ++si) {
            const int s = part * 16 + si; float a = 0.f;
            for (int d = 0; d < 128; ++d) a += qs[t * 129 + d] * ks[s * 129 + d];
            const int dt = (ti * 64 + t) - (sj * 64 + s);
            sc[t * 65 + s] = (dt >= 0) ? a * exp2f(lg * (float)dt) : 0.f;
        }
        __syncthreads();
        for (int s = 0; s < 64; ++s) { const float w = sc[t * 65 + s];
#pragma unroll
            for (int j = 0; j < 32; ++j) o[j] += w * vs[s * 129 + part * 32 + j]; }
    }
    float sum = 0.f;
#pragma unroll
    for (int j = 0; j < 32; ++j) sum += o[j];
    sum += __shfl_xor(sum, 1); sum += __shfl_xor(sum, 2);
    const float mu = sum * (1.0f / 128.0f); float q = 0.f;
#pragma unroll
    for (int j = 0; j < 32; ++j) { const float d = o[j] - mu; q += d * d; }
    q += __shfl_xor(q, 1); q += __shfl_xor(q, 2);
    const float rs = 1.0f / sqrtf(q * (1.0f / 128.0f) + EPS);
    const size_t row = (size_t)(row0 + t);
    bf16_t* mix = (bf16_t*)(p.ws + WS_MIX);
#pragma unroll
    for (int j = 0; j < 32; ++j) { const int e = part * 32 + j;
        const float g = bf2f(P[row * INW + COL_G + h * 128 + e]);
        mix[row * DM + h * 128 + e] = (bf16_t)f2bf(silu(g) * ((o[j] - mu) * rs * p.ret_gn_w[l * 1024 + h * 128 + e])); }
}
__global__ void __launch_bounds__(256) nv_gmlp(Ptrs p, int l) {
    extern __shared__ float sm[];
    float* vn = sm;
    const bf16_t* P = (const bf16_t*)(p.ws + WS_P);
    const int nb = blockIdx.x, g = blockIdx.y, b = blockIdx.z, tid = threadIdx.x;
    const int row0 = b * SEQ + nb * 128;
    { const int s = tid >> 1, half = tid & 1; float v[64]; float sum = 0.f;
#pragma unroll
      for (int j = 0; j < 64; ++j) { v[j] = bf2f(P[(size_t)(row0 + s) * INW + COL_VS + g * 128 + half * 64 + j]); sum += v[j]; }
      sum += __shfl_xor(sum, 1); const float mu = sum * (1.0f / 128.0f); float q = 0.f;
#pragma unroll
      for (int j = 0; j < 64; ++j) { const float d = v[j] - mu; q += d * d; }
      q += __shfl_xor(q, 1); const float rs = 1.0f / sqrtf(q * (1.0f / 128.0f) + EPS);
#pragma unroll
      for (int j = 0; j < 64; ++j) vn[s * 129 + half * 64 + j] = (v[j] - mu) * rs * p.gmlp_norm_w[l * 1024 + g * 128 + half * 64 + j]; }
    __syncthreads();
    const int t = tid >> 1, half = tid & 1;
    float z[64];
#pragma unroll
    for (int j = 0; j < 64; ++j) z[j] = 0.f;
    const float* W = p.w_s + (((size_t)l * GG + g) * 128 + t) * 128;
    const int smax = (t < 64) ? 64 : 128;
    for (int s = 0; s < smax; ++s) { const float w = W[s];
#pragma unroll
        for (int j = 0; j < 64; ++j) z[j] += w * vn[s * 129 + half * 64 + j]; }
    const float bs = p.b_s[((size_t)l * GG + g) * 128 + t];
    const size_t row = (size_t)(row0 + t);
    bf16_t* mix = (bf16_t*)(p.ws + WS_MIX);
#pragma unroll
    for (int j = 0; j < 64; ++j) { const int c = g * 128 + half * 64 + j;
        mix[row * DM + 1024 + c] = (bf16_t)f2bf(bf2f(P[row * INW + COL_U + c]) * (z[j] + bs)); }
}
template <class LP>
__device__ __forceinline__ void route_token(LP lg  , int& e0, int& e1, float& w0, float& w1) {
    int gs = 0; float gm = lg[0];
#pragma unroll
    for (int j = 1; j < NGRP; ++j) { const float v = lg[j]; if (v > gm) { gm = v; gs = j; } }
    float den = 0.f;
#pragma unroll
    for (int j = 0; j < NGRP; ++j) den += __expf(lg[j] - gm);
    const float psel = 1.0f / den;
    const int eb = 4 + 8 * gs;
    int i0 = 0; float v0 = lg[eb];
#pragma unroll
    for (int i = 1; i < EPG; ++i) { const float v = lg[eb + i]; if (v > v0) { v0 = v; i0 = i; } }
    int i1 = -1; float v1 = -3.0e38f;
#pragma unroll
    for (int i = 0; i < EPG; ++i) { const float v = lg[eb + i]; if (i != i0 && v > v1) { v1 = v; i1 = i; } }
    const float a = 1.0f / (1.0f + __expf(v1 - v0));
    e0 = gs * 8 + i0; e1 = gs * 8 + i1; w0 = a * psel; w1 = (1.0f - a) * psel;
}
__global__ void __launch_bounds__(256) nv_r2(Ptrs p, int l) {
    __shared__ float red[8][40]; __shared__ float lgs[40];
    unsigned* ctl = (unsigned*)(p.ws + WS_CTL);
    const int row = blockIdx.x, tid = threadIdx.x, lane = tid & 63, w = tid >> 6;
    const float* xr = (const float*)(p.ws + WS_X1) + (size_t)row * DM;
    float v[8]; float s = 0.f;
#pragma unroll
    for (int j = 0; j < 8; ++j) { v[j] = xr[tid + 256 * j]; s += v[j] * v[j]; }
    bf16_t* hb = (bf16_t*)(p.ws + WS_H2B) + (size_t)row * DM;
#pragma unroll
    for (int j = 0; j < 8; ++j) hb[tid + 256 * j] = (bf16_t)f2bf(v[j]);
    s = wave_sum(s); if (lane == 0) red[w][36] = s;
    float part[36];
#pragma unroll
    for (int o = 0; o < 36; ++o) part[o] = 0.f;
#pragma unroll
    for (int j = 0; j < 8; ++j) { const int k = tid + 256 * j; const float a = v[j] * p.norm2_w[l * DM + k];
#pragma unroll
        for (int o = 0; o < 4; ++o) part[o] += a * p.rg_w[((size_t)l * DM + k) * NGRP + o];
#pragma unroll
        for (int o = 0; o < 32; ++o) part[4 + o] += a * p.re_w[((size_t)l * DM + k) * NE + o]; }
#pragma unroll
    for (int o = 0; o < 36; ++o) { const float t = wave_sum(part[o]); if (lane == 0) red[w][o] = t; }
    __syncthreads();
    if (tid < 37) lgs[tid] = red[0][tid] + red[1][tid] + red[2][tid] + red[3][tid];
    __syncthreads();
    const float rstd = 1.0f / sqrtf(lgs[36] * (1.0f / DM) + EPS);
    __syncthreads();
    if (tid < 36) lgs[tid] = lgs[tid] * rstd + (tid < 4 ? p.rg_b[l * NGRP + tid] : p.re_b[l * NE + tid - 4]);
    __syncthreads();
    if (tid == 0) {
        int e0, e1; float w0, w1; route_token((const float*)lgs, e0, e1, w0, w1);
        const int s0 = (int)atomicAdd(&ctl[CW_CNT + (l * NE + e0) * 16], 1u), s1 = (int)atomicAdd(&ctl[CW_CNT + (l * NE + e1) * 16], 1u);
        int* tok = (int*)(p.ws + WS_TOK); float* rse = (float*)(p.ws + WS_RSE);
        tok[(size_t)e0 * NTOK + s0] = row; rse[(size_t)e0 * NTOK + s0] = rstd; tok[(size_t)e1 * NTOK + s1] = row; rse[(size_t)e1 * NTOK + s1] = rstd;
        Rec r; r.e0 = e0; r.s0 = s0; r.w0 = w0; r.e1 = e1; r.s1 = s1; r.w1 = w1; r.pad0 = 0; r.pad1 = 0;
        ((Rec*)(p.ws + WS_REC))[row] = r;
    }
}

#define XB_TMO      128
#define XB_XCNT(j)  (256  + 64 * (j))
#define XB_XSUB(j)  (1280 + 64 * (j))
#define XB_XGEN(j)  (2304 + 64 * (j))
#define XB_TOP      3328
#define XB_TOPGEN   3392
#define XCD_BAR_WORDS 3456
#define XB_SPIN_CAP (1u << 18)

__device__ __forceinline__ unsigned xb_ld(unsigned* p)              { return __hip_atomic_load(p, __ATOMIC_RELAXED, __HIP_MEMORY_SCOPE_AGENT); }
__device__ __forceinline__ unsigned xb_add(unsigned* p, unsigned v) { return __hip_atomic_fetch_add(p, v, __ATOMIC_RELAXED, __HIP_MEMORY_SCOPE_AGENT); }
__device__ __forceinline__ unsigned xb_xcc_id() { return (unsigned)__builtin_amdgcn_s_getreg((3 << 11) | 20) & 0xFu; }
#define XB_SPIN(cond, bar) do { unsigned _sp = 0; while (cond) { __builtin_amdgcn_s_sleep(1); \
    if ((++_sp & 255u) == 0u) { if (xb_ld(&(bar)[XB_TMO])) break; if (_sp > XB_SPIN_CAP) { atomicAdd(&(bar)[XB_TMO], 1u); break; } } } } while (0)

struct XcdBarrier {
    unsigned* bar; unsigned x;
    volatile LAS unsigned* st;
};

__device__ __forceinline__ XcdBarrier xcd_barrier_post(unsigned* bar, volatile LAS unsigned* st) {
    XcdBarrier b; b.bar = bar; b.x = xb_xcc_id(); b.st = st;
    if (threadIdx.x == 0) (void)xb_add(&bar[XB_XCNT(b.x)], 1u);
    return b;
}
__device__ __forceinline__ void xcd_barrier_complete(unsigned* bar, unsigned x, unsigned& nloc, unsigned& nx) {
    const unsigned G = gridDim.x * gridDim.y * gridDim.z;
    unsigned sum, cnt, mine, sp = 0u;
    for (;;) {
        sum = 0u; cnt = 0u; mine = 0u;
#pragma unroll
        for (unsigned j = 0; j < 16; ++j) { const unsigned c = xb_ld(&bar[XB_XCNT(j)]); sum += c; cnt += (c > 0u) ? 1u : 0u; mine = (j == x) ? c : mine; }
        if (sum == G) break;
        __builtin_amdgcn_s_sleep(1);
        if ((++sp & 255u) == 0u) { if (xb_ld(&bar[XB_TMO])) break; if (sp > XB_SPIN_CAP) { atomicAdd(&bar[XB_TMO], 1u); break; } }
    }
    nloc = mine > 0u ? mine : 1u; nx = cnt > 0u ? cnt : 1u;
}

__device__ __forceinline__ void xcd_barrier(const XcdBarrier& b) {
    asm volatile("s_waitcnt vmcnt(0)" ::: "memory");
    __syncthreads();
    if (threadIdx.x == 0) {
        unsigned* bar = b.bar;
        __builtin_amdgcn_s_waitcnt(0);
        unsigned nloc = b.st[0], nx = b.st[1];
        if (nloc == 0u) { xcd_barrier_complete(bar, b.x, nloc, nx); b.st[0] = nloc; b.st[1] = nx; }
        const unsigned old = xb_add(&bar[XB_XSUB(b.x)], 1u);
        const unsigned gen = old / nloc;
        if (old + 1u == (gen + 1u) * nloc) {
            __builtin_amdgcn_fence(__ATOMIC_RELEASE, "agent");
            asm volatile("s_waitcnt vmcnt(0)" ::: "memory");
            const unsigned og = xb_add(&bar[XB_TOP], 1u);
            const unsigned tg = og / nx;
            if (og + 1u == (tg + 1u) * nx) xb_add(&bar[XB_TOPGEN], 1u);
            else XB_SPIN(xb_ld(&bar[XB_TOPGEN]) == tg, bar);
            __builtin_amdgcn_fence(__ATOMIC_ACQUIRE, "agent");
            xb_add(&bar[XB_XGEN(b.x)], 1u);
            asm volatile("s_waitcnt vmcnt(0)" ::: "memory");
        } else {
            XB_SPIN(xb_ld(&bar[XB_XGEN(b.x)]) == gen, bar);
            __builtin_amdgcn_fence(__ATOMIC_ACQUIRE, "agent");
            asm volatile("s_waitcnt vmcnt(0)" ::: "memory");
        }
    }
    __syncthreads();
}

__device__ __forceinline__ int hidden_tid() { int t = threadIdx.x; asm volatile("" : "+v"(t)); return t; }
__device__ __forceinline__ void unpack8(const u32x4 v, float (&f)[8]) { f[0] = bf2f(v.x & 0xffffu); f[1] = bf2f(v.x >> 16); f[2] = bf2f(v.y & 0xffffu); f[3] = bf2f(v.y >> 16); f[4] = bf2f(v.z & 0xffffu); f[5] = bf2f(v.z >> 16); f[6] = bf2f(v.w & 0xffffu); f[7] = bf2f(v.w >> 16); }
__device__ __forceinline__ u32x4 pack8(const float (&f)[8]) { u32x4 w; w.x = pk2(f[0], f[1]); w.y = pk2(f[2], f[3]); w.z = pk2(f[4], f[5]); w.w = pk2(f[6], f[7]); return w; }
__device__ __forceinline__ void unpack8_fp8(const u32x2 v, float (&f)[8]) {
    const f32x2 a = __builtin_amdgcn_cvt_pk_f32_fp8((int)v.x, false), b = __builtin_amdgcn_cvt_pk_f32_fp8((int)v.x, true), c = __builtin_amdgcn_cvt_pk_f32_fp8((int)v.y, false), d = __builtin_amdgcn_cvt_pk_f32_fp8((int)v.y, true);
    f[0] = a.x; f[1] = a.y; f[2] = b.x; f[3] = b.y; f[4] = c.x; f[5] = c.y; f[6] = d.x; f[7] = d.y; }
constexpr int LDS_STAGE = 0;
constexpr int LDS_TAB = 131072;
constexpr int LDS_UL = LDS_TAB + 8192;
constexpr int LDS_EB = LDS_UL + 256;
constexpr int LDS_MISC = LDS_EB + 256;
constexpr int LDS_BYTES = 147456;
constexpr int NWAVES = 8;

__device__ __forceinline__ unsigned cvt_pk_bf16(float lo, float hi) { unsigned r; asm volatile("v_cvt_pk_bf16_f32 %0, %1, %2" : "=v"(r) : "v"(lo), "v"(hi)); return r; }

#ifndef FP8MOE
#define FP8MOE 1
#endif
typedef int i32x8 __attribute__((ext_vector_type(8)));
typedef int i32x4 __attribute__((ext_vector_type(4)));
__device__ __forceinline__ unsigned pk4_fp8(float a, float b, float c, float d) { int w = 0; w = __builtin_amdgcn_cvt_pk_fp8_f32(a, b, w, false); w = __builtin_amdgcn_cvt_pk_fp8_f32(c, d, w, true); return (unsigned)w; }
namespace pg8 {
constexpr int BM = 256, BK = 64, HALF = 128, HTB = HALF * BK * 2, STAGE_BYTES = 8 * HTB, NXCD = 8, WGM = 8;
__host__ __device__ __forceinline__ int lds_byte(int r, int c) { const int st = (r >> 4) * 2 + (c >> 5), rr = r & 15, cc = c & 31, ob = rr * 64 + cc * 2; return st * 1024 + (ob ^ (((ob >> 9) & 1) << 5)); }
__host__ __device__ __forceinline__ void stage_rc(int b, int& R, int& C) { const int st = b / 1024, sb = b % 1024, swz = sb ^ (((sb >> 9) & 1) << 5); R = (st >> 1) * 16 + swz / 64; C = (st & 1) * 32 + (swz % 64) / 2; }
__host__ __device__ __forceinline__ int perm32(int rho) { const int n = rho >> 4, i = rho & 15; return 8 * (i >> 2) + 4 * n + (i & 3); }

struct Unit { int pm, pn, e, pnl; };

struct DenseOrder {
    int nM, nN, nwg, G, c;
    __device__ void init(int M, int N, int G_, int c_) { nM = M / BM; nN = N / BM; nwg = nM * nN; G = G_; c = c_; }
    __device__ __forceinline__ bool next(int i, Unit& u) const {
        const long L = (long)i * G + c; if (L >= nwg) return false;
        int wgid = (int)L; { const int q = nwg / NXCD, r = nwg % NXCD, xcd = wgid % NXCD, off = wgid / NXCD; wgid = (xcd < r ? xcd * (q + 1) : r * (q + 1) + (xcd - r) * q) + off; }
        const int nig = WGM * nN, gid = wgid / nig, fm = gid * WGM, gsz = (nM - fm) < WGM ? (nM - fm) : WGM;
        u.pm = fm + ((wgid % nig) % gsz); u.pn = (wgid % nig) / gsz; u.e = 0; u.pnl = u.pn; return true;
    }
    __device__ __forceinline__ int arow(int, const Unit& u, int r) const { return u.pm * BM + r; }
};
template <bool GATHER> struct MoeOrder {
    const LAS int* ul; const LAS int* tab; int nu;
    __device__ __forceinline__ bool next(int i, Unit& u) const {
        if (i >= nu) return false;
        u.pm = __builtin_amdgcn_readfirstlane(ul[4 * i + 0]); u.pn = __builtin_amdgcn_readfirstlane(ul[4 * i + 1]);
        u.e = __builtin_amdgcn_readfirstlane(ul[4 * i + 2]); u.pnl = __builtin_amdgcn_readfirstlane(ul[4 * i + 3]); return true;
    }
    __device__ __forceinline__ int arow(int ui, const Unit& u, int r) const { return GATHER ? tab[ui * 256 + r] : u.pm * BM + r; }
};

template <bool FP8, class Epi, class Sched>
__device__ __forceinline__ void gemm_phase(LAS unsigned char* lds, const bf16_t* A, const bf16_t* Bt, const int K, const Sched& S, const Epi& E) {
    const int tid = hidden_tid(), wid = __builtin_amdgcn_readfirstlane(tid >> 6), lane = tid & 63, wr = wid >> 2, wc = wid & 3, fr = lane & 15, fq = lane >> 4;
    const int nt = K / BK;
    unsigned voffB[2];
#pragma unroll
    for (int i = 0; i < 2; ++i) { int R_, C_; stage_rc(tid * 16 + i * 8192, R_, C_); const int Rb = Epi::PERM ? ((R_ & ~31) + perm32(R_ & 31)) : R_; voffB[i] = (unsigned)(Rb * K + C_) * 2u; }
    const size_t kstep = (size_t)(BK * 2);
    const size_t hstep = (size_t)HALF * K * 2;
    const size_t tstep = 2 * hstep;
    const unsigned ldsw = (unsigned)wid * 1024u;
    const int aoff = lds_byte(wr * 64 + fr, fq * 8), boff = lds_byte(wc * 32 + fr, fq * 8);
#define PG8_SA(b, h) (((b) * 2 + (h)) * HTB)
#define PG8_SB(b, h) ((4 + (b) * 2 + (h)) * HTB)
#define PG8_STAGE(bufoff, gbase, voff) do { _Pragma("unroll") for (int _i = 0; _i < 2; ++_i) \
        __builtin_amdgcn_global_load_lds((const unsigned*)((const char*)(gbase) + (voff)[_i]), (LAS unsigned*)(lds + (bufoff) + ldsw + _i * 8192), 16, 0, 0); } while (0)
#define PG8_LDA(dst, b, h) do { _Pragma("unroll") for (int m = 0; m < 4; ++m) _Pragma("unroll") for (int k = 0; k < 2; ++k) dst[m][k] = *(const LAS bf16x8*)(lds + PG8_SA(b, h) + aoff + m * 2048 + k * 1024); } while (0)
#define PG8_LDB(dst, b, h) do { _Pragma("unroll") for (int n = 0; n < 2; ++n) _Pragma("unroll") for (int k = 0; k < 2; ++k) dst[n][k] = *(const LAS bf16x8*)(lds + PG8_SB(b, h) + boff + n * 2048 + k * 1024); } while (0)
#define PG8_CAT(x0, x1) __builtin_shufflevector(__builtin_bit_cast(i32x4, x0), __builtin_bit_cast(i32x4, x1), 0, 1, 2, 3, 4, 5, 6, 7)
#define PG8_MMA(ai, bj, At, Bt_) do { __builtin_amdgcn_s_setprio(1); _Pragma("unroll") for (int m = 0; m < 4; ++m) _Pragma("unroll") for (int n = 0; n < 2; ++n) { \
        if constexpr (FP8) acc[ai][bj][m][n] = __builtin_amdgcn_mfma_scale_f32_16x16x128_f8f6f4(PG8_CAT(Bt_[n][0], Bt_[n][1]), PG8_CAT(At[m][0], At[m][1]), acc[ai][bj][m][n], 0, 0, 0, 0x7f7f7f7f, 0, 0x7f7f7f7f); \
        else { _Pragma("unroll") for (int k = 0; k < 2; ++k) acc[ai][bj][m][n] = __builtin_amdgcn_mfma_f32_16x16x32_bf16(Bt_[n][k], At[m][k], acc[ai][bj][m][n], 0, 0, 0); } } \
        __builtin_amdgcn_s_setprio(0); } while (0)
#define PG8_WAIT_V(n) asm volatile("s_waitcnt vmcnt(" #n ")" ::: "memory")
#define PG8_WAIT_L(n) asm volatile("s_waitcnt lgkmcnt(" #n ")" ::: "memory")
#define PG8_BAR __builtin_amdgcn_s_barrier()
#define PG8_SCHED __builtin_amdgcn_sched_barrier(0)
#define PG8_AOFF(dst, ui_, u_, h) do { int _tz = threadIdx.x; asm volatile("" : "+v"(_tz)); _Pragma("unroll") for (int _i = 0; _i < 2; ++_i) { int _R, _C; stage_rc(_tz * 16 + _i * 8192, _R, _C); \
        dst[_i] = (unsigned)(S.arow(ui_, u_, (h) * HALF + _R) * K + _C) * 2u; } } while (0)
    Unit cur, nxt; int ui = 0;
    if (!S.next(0, cur)) return;
    f32x4 acc[2][2][4][2];
#pragma unroll
    for (int a = 0; a < 2; ++a)
#pragma unroll
        for (int b = 0; b < 2; ++b)
#pragma unroll
            for (int m = 0; m < 4; ++m)
#pragma unroll
                for (int n = 0; n < 2; ++n) acc[a][b][m][n] = (f32x4){0.f, 0.f, 0.f, 0.f};
    bf16x8 At[4][2], B0[2][2], B1[2][2];
    unsigned vA0[2], vA1[2];
    PG8_AOFF(vA0, 0, cur, 0); PG8_AOFF(vA1, 0, cur, 1);
    const char* cA = (const char*)A; const char* cB = (const char*)Bt + (size_t)cur.pn * tstep;
    PG8_STAGE(PG8_SB(0, 0), cB, voffB); PG8_STAGE(PG8_SB(0, 1), cB + hstep, voffB); PG8_STAGE(PG8_SA(0, 0), cA, vA0); PG8_STAGE(PG8_SA(0, 1), cA, vA1);
    if (wr == 1) PG8_BAR;
    PG8_WAIT_V(2); PG8_BAR;
    PG8_STAGE(PG8_SB(1, 0), cB + kstep, voffB); PG8_STAGE(PG8_SA(1, 0), cA + kstep, vA0); PG8_STAGE(PG8_SB(1, 1), cB + hstep + kstep, voffB);
    PG8_WAIT_V(6); PG8_BAR;
    for (;;) {
        const bool has_next = S.next(ui + 1, nxt);
        const char* nB = has_next ? (const char*)Bt + (size_t)nxt.pn * tstep : cB;
        for (int t = 0; t < nt; t += 2) {
            const bool last = (t == nt - 2);
            const char* a1 = cA + (size_t)(t + 1) * kstep;
            const char* a2 = last ? cA : cA + (size_t)(t + 2) * kstep; const char* b2 = last ? nB : cB + (size_t)(t + 2) * kstep;
            const char* a3 = a2 + kstep; const char* b3 = b2 + kstep;
            if (last && has_next) { PG8_AOFF(vA0, ui + 1, nxt, 0); }
            PG8_LDB(B0, 0, 0); PG8_LDB(B1, 0, 1); PG8_SCHED; PG8_LDA(At, 0, 0); PG8_STAGE(PG8_SA(1, 1), a1, vA1);
            PG8_WAIT_V(8); PG8_WAIT_L(0); PG8_BAR; PG8_MMA(0, 0, At, B0); PG8_MMA(0, 1, At, B1); PG8_BAR; PG8_SCHED;
            if (last && has_next) { PG8_AOFF(vA1, ui + 1, nxt, 1); }
            PG8_LDA(At, 0, 1); PG8_STAGE(PG8_SB(0, 0), b2, voffB); PG8_STAGE(PG8_SB(0, 1), b2 + hstep, voffB); PG8_STAGE(PG8_SA(0, 0), a2, vA0);
            PG8_WAIT_V(8); PG8_WAIT_L(0); PG8_BAR; PG8_MMA(1, 0, At, B0); PG8_MMA(1, 1, At, B1); PG8_BAR; PG8_SCHED;
            PG8_LDB(B0, 1, 0); PG8_LDB(B1, 1, 1); PG8_SCHED; PG8_LDA(At, 1, 0); PG8_STAGE(PG8_SA(0, 1), a2, vA1);
            PG8_WAIT_V(8); PG8_WAIT_L(0); PG8_BAR; PG8_MMA(0, 0, At, B0); PG8_MMA(0, 1, At, B1); PG8_BAR; PG8_SCHED;
            PG8_LDA(At, 1, 1); PG8_STAGE(PG8_SB(1, 0), b3, voffB); PG8_STAGE(PG8_SB(1, 1), b3 + hstep, voffB); PG8_STAGE(PG8_SA(1, 0), a3, vA0);
            PG8_WAIT_V(8); PG8_WAIT_L(0); PG8_BAR; PG8_MMA(1, 0, At, B0); PG8_MMA(1, 1, At, B1); PG8_BAR; PG8_SCHED;
        }
        if (wr == 0) PG8_BAR;
        E(acc, cur, wr, wc, fr, fq);
        if (!has_next) break;
#pragma unroll
        for (int a = 0; a < 2; ++a)
#pragma unroll
            for (int b = 0; b < 2; ++b)
#pragma unroll
                for (int m = 0; m < 4; ++m)
#pragma unroll
                    for (int n = 0; n < 2; ++n) acc[a][b][m][n] = (f32x4){0.f, 0.f, 0.f, 0.f};
        cur = nxt; cB = nB; ++ui;
        if (wr == 1) PG8_BAR;
    }
    PG8_WAIT_V(0);
    PG8_BAR;
#undef PG8_SA
#undef PG8_SB
#undef PG8_STAGE
#undef PG8_LDA
#undef PG8_LDB
#undef PG8_MMA
#undef PG8_CAT
#undef PG8_WAIT_V
#undef PG8_WAIT_L
#undef PG8_BAR
#undef PG8_SCHED
#undef PG8_AOFF
}

struct EpiG1 {
    static constexpr bool PERM = true;
    bf16_t* P; const float* cosT; const float* sinT; int skip;
    __device__ __forceinline__ void operator()(const f32x4 (&acc)[2][2][4][2], const Unit& u, int wr, int wc, int fr, int fq) const {
        const int row0 = u.pm * BM + wr * 64 + fr;
#ifdef PROBE_NULL_EPI
        if (skip) return;
#endif
        if (u.pn < 8) {
            const int i0 = (32 * wc + 8 * fq) & 63, hl = wc >> 1, colb = u.pn * 256 + hl * 128 + i0;
#pragma unroll
            for (int ai = 0; ai < 2; ++ai) {
                f32x4 cs[4][4];
#pragma unroll
                for (int m = 0; m < 4; ++m) { const int pos = (row0 + ai * HALF + m * 16) & (SEQ - 1);
                    cs[m][0] = *(const f32x4*)(cosT + pos * 64 + i0); cs[m][1] = *(const f32x4*)(cosT + pos * 64 + i0 + 4); cs[m][2] = *(const f32x4*)(sinT + pos * 64 + i0); cs[m][3] = *(const f32x4*)(sinT + pos * 64 + i0 + 4); }
                asm volatile("" ::: "memory");
#pragma unroll
                for (int m = 0; m < 4; ++m) { const int row = row0 + ai * HALF + m * 16;
                    const f32x4 c0 = cs[m][0], c1 = cs[m][1], s0 = cs[m][2], s1 = cs[m][3];
                    const f32x4 a0 = acc[ai][0][m][0], a1 = acc[ai][0][m][1], b0 = acc[ai][1][m][0], b1 = acc[ai][1][m][1];
                    const f32x4 o10 = a0 * c0 - b0 * s0, o11 = a1 * c1 - b1 * s1, o20 = a0 * s0 + b0 * c0, o21 = a1 * s1 + b1 * c1;
                    u32x4 w1, w2; w1.x = cvt_pk_bf16(o10[0], o10[1]); w1.y = cvt_pk_bf16(o10[2], o10[3]); w1.z = cvt_pk_bf16(o11[0], o11[1]); w1.w = cvt_pk_bf16(o11[2], o11[3]);
                    w2.x = cvt_pk_bf16(o20[0], o20[1]); w2.y = cvt_pk_bf16(o20[2], o20[3]); w2.z = cvt_pk_bf16(o21[0], o21[1]); w2.w = cvt_pk_bf16(o21[2], o21[3]);
                    bf16_t* rp = P + (size_t)row * INW + colb; *(u32x4*)rp = w1; *(u32x4*)(rp + 64) = w2; }
                asm volatile("" ::: "memory");
            }
        } else {
            const bool act = (u.pn >= 16);
            const int colb = u.pn * 256 + wc * 32 + 8 * fq;
#pragma unroll
            for (int ai = 0; ai < 2; ++ai)
#pragma unroll
                for (int m = 0; m < 4; ++m) { bf16_t* rp = P + (size_t)(row0 + ai * HALF + m * 16) * INW + colb;
#pragma unroll
                    for (int bj = 0; bj < 2; ++bj) { f32x4 v0 = acc[ai][bj][m][0], v1 = acc[ai][bj][m][1];
                        if (act) {
#pragma unroll
                            for (int j = 0; j < 4; ++j) { v0[j] = gelu_tanh(v0[j]); v1[j] = gelu_tanh(v1[j]); } }
                        u32x4 w; w.x = cvt_pk_bf16(v0[0], v0[1]); w.y = cvt_pk_bf16(v0[2], v0[3]); w.z = cvt_pk_bf16(v1[0], v1[1]); w.w = cvt_pk_bf16(v1[2], v1[3]);
                        *(u32x4*)(rp + bj * HALF) = w; } }
        }
    }
};
struct EpiNull {
    static constexpr bool PERM = true;
    __device__ __forceinline__ void operator()(const f32x4 (&acc)[2][2][4][2], const Unit& u, int wr, int wc, int fr, int fq) const {
#pragma unroll
        for (int ai = 0; ai < 2; ++ai)
#pragma unroll
            for (int bj = 0; bj < 2; ++bj)
#pragma unroll
                for (int m = 0; m < 4; ++m)
#pragma unroll
                    for (int n = 0; n < 2; ++n) asm volatile("" :: "v"(acc[ai][bj][m][n]));
    }
};
struct EpiG2 {
    static constexpr bool PERM = true;
    const bf16_t* xin; bf16_t* x1;
    __device__ __forceinline__ void operator()(const f32x4 (&acc)[2][2][4][2], const Unit& u, int wr, int wc, int fr, int fq) const {
        const int row0 = u.pm * BM + wr * 64 + fr, col0 = u.pn * BM + wc * 32 + 8 * fq;
        u32x4 xv[2][4][2];
#pragma unroll
        for (int ai = 0; ai < 2; ++ai)
#pragma unroll
            for (int m = 0; m < 4; ++m) { const size_t off = (size_t)(row0 + ai * HALF + m * 16) * DM + col0;
#pragma unroll
                for (int bj = 0; bj < 2; ++bj) xv[ai][m][bj] = *(const u32x4*)(xin + off + bj * HALF); }
        asm volatile("" ::: "memory");
#pragma unroll
        for (int ai = 0; ai < 2; ++ai)
#pragma unroll
            for (int m = 0; m < 4; ++m) { const size_t off = (size_t)(row0 + ai * HALF + m * 16) * DM + col0;
#pragma unroll
                for (int bj = 0; bj < 2; ++bj) { const u32x4 x = xv[ai][m][bj]; const f32x4 a0 = acc[ai][bj][m][0], a1 = acc[ai][bj][m][1];
                    u32x4 w; w.x = cvt_pk_bf16(bf2f(x.x & 0xffffu) + a0[0], bf2f(x.x >> 16) + a0[1]); w.y = cvt_pk_bf16(bf2f(x.y & 0xffffu) + a0[2], bf2f(x.y >> 16) + a0[3]);
                    w.z = cvt_pk_bf16(bf2f(x.z & 0xffffu) + a1[0], bf2f(x.z >> 16) + a1[1]); w.w = cvt_pk_bf16(bf2f(x.w & 0xffffu) + a1[2], bf2f(x.w >> 16) + a1[3]);
                    *(u32x4*)(x1 + off + bj * HALF) = w; } }
    }
};
struct EpiG3 {
    static constexpr bool PERM = true;
    bf16_t* he; const float* rse; const LAS int* etb;
    __device__ __forceinline__ void operator()(const f32x4 (&acc)[2][2][4][2], const Unit& u, int wr, int wc, int fr, int fq) const {
        const int rl0 = wr * 64 + fr, mt = u.pm - etb[u.e];
        const float* rsp = rse + (size_t)u.e * NTOK + mt * 256;
        const int colb = u.pnl * 128 + wc * 32 + 8 * fq;
        float rsv[2][4];
#pragma unroll
        for (int ai = 0; ai < 2; ++ai)
#pragma unroll
            for (int m = 0; m < 4; ++m) rsv[ai][m] = rsp[rl0 + ai * HALF + m * 16];
        asm volatile("" ::: "memory");
#pragma unroll
        for (int ai = 0; ai < 2; ++ai)
#pragma unroll
            for (int m = 0; m < 4; ++m) { const int rl = rl0 + ai * HALF + m * 16; const float rs = rsv[ai][m] * (FP8MOE ? (1.0f / 256.0f) : 1.0f);
                const f32x4 g0 = acc[ai][0][m][0] * rs, g1 = acc[ai][0][m][1] * rs, u0 = acc[ai][1][m][0] * rs, u1 = acc[ai][1][m][1] * rs;
                f32x4 h0, h1;
#pragma unroll
                for (int j = 0; j < 4; ++j) { h0[j] = silu(g0[j]) * u0[j]; h1[j] = silu(g1[j]) * u1[j]; }
                if (FP8MOE) { u32x2 w; w.x = pk4_fp8(h0[0] * 16.f, h0[1] * 16.f, h0[2] * 16.f, h0[3] * 16.f); w.y = pk4_fp8(h1[0] * 16.f, h1[1] * 16.f, h1[2] * 16.f, h1[3] * 16.f);
                    *(u32x2*)((unsigned char*)he + (size_t)(u.pm * BM + rl) * DE + colb) = w; }
                else { u32x4 w; w.x = cvt_pk_bf16(h0[0], h0[1]); w.y = cvt_pk_bf16(h0[2], h0[3]); w.z = cvt_pk_bf16(h1[0], h1[1]); w.w = cvt_pk_bf16(h1[2], h1[3]);
                    *(u32x4*)(he + (size_t)(u.pm * BM + rl) * DE + colb) = w; } }
    }
};
struct EpiG4 {
    static constexpr bool PERM = true;
    bf16_t* y;
    __device__ __forceinline__ void operator()(const f32x4 (&acc)[2][2][4][2], const Unit& u, int wr, int wc, int fr, int fq) const {
        const int row0 = u.pm * BM + wr * 64 + fr, colb = u.pnl * 256 + wc * 32 + 8 * fq;
#pragma unroll
        for (int ai = 0; ai < 2; ++ai)
#pragma unroll
            for (int m = 0; m < 4; ++m) {
#pragma unroll
                for (int bj = 0; bj < 2; ++bj) {
                    if (FP8MOE) { const f32x4 v0 = acc[ai][bj][m][0] * (1.0f / 256.0f), v1 = acc[ai][bj][m][1] * (1.0f / 256.0f);
                        u32x2 w; w.x = pk4_fp8(v0[0], v0[1], v0[2], v0[3]); w.y = pk4_fp8(v1[0], v1[1], v1[2], v1[3]);
                        *(u32x2*)((unsigned char*)y + (size_t)(row0 + ai * HALF + m * 16) * DM + colb + bj * HALF) = w; }
                    else { const f32x4 v0 = acc[ai][bj][m][0], v1 = acc[ai][bj][m][1];
                        u32x4 w; w.x = cvt_pk_bf16(v0[0], v0[1]); w.y = cvt_pk_bf16(v0[2], v0[3]); w.z = cvt_pk_bf16(v1[0], v1[1]); w.w = cvt_pk_bf16(v1[2], v1[3]);
                        *(u32x4*)(y + (size_t)(row0 + ai * HALF + m * 16) * DM + colb + bj * HALF) = w; } } }
    }
};
}

__device__ __forceinline__ int moe_units(const unsigned* ctl, int l, LAS unsigned char* lds, bool gather, const int* tokg) {
    LAS int* etb = (LAS int*)(lds + LDS_EB); LAS int* ul = (LAS int*)(lds + LDS_UL); LAS int* tab = (LAS int*)(lds + LDS_TAB);
    LAS int* nup = (LAS int*)(lds + LDS_UL + 192);
    const int tid = hidden_tid(), G = gridDim.x;
    __syncthreads();
    if (tid == 0) { int acc = 0; for (int e = 0; e < NE; ++e) { etb[e] = acc; acc += ((int)ctl[CW_CNT + (l * NE + e) * 16] + 255) >> 8; } etb[NE] = acc; }
    __syncthreads();
    const int T = etb[NE];
    const int nx = (G % 8 == 0) ? 8 : 1, x = (int)blockIdx.x % nx, rank = (int)blockIdx.x / nx, nrank = G / nx;
    const int lo = (int)((long)x * T / nx), hi = (int)((long)(x + 1) * T / nx), nun = (hi - lo) * 8;
    int nu = 0; for (int v = rank; v < nun && nu < 8; v += nrank) ++nu;
    if (tid < nu) { const int v = rank + tid * nrank, mtg = lo + (v >> 3), pnl = v & 7; int e = 0; while (etb[e + 1] <= mtg) ++e;
        ul[4 * tid + 0] = mtg; ul[4 * tid + 1] = e * 8 + pnl; ul[4 * tid + 2] = e; ul[4 * tid + 3] = pnl; }
    if (tid == 0) nup[0] = nu;
    __syncthreads();
    if (gather) {
        for (int idx = tid; idx < nu * 256; idx += 512) { const int i = idx >> 8, r = idx & 255; const int mtg = ul[4 * i + 0], e = ul[4 * i + 2], mt = mtg - etb[e]; const int cnt = (int)ctl[CW_CNT + (l * NE + e) * 16];
            int s = mt * 256 + r; if (s >= cnt) s = cnt - 1; tab[idx] = tokg[(size_t)e * NTOK + s]; }
        __syncthreads();
    }
    return nu;
}

struct CvItem { const float* sa; const float* sb; const float* ks; unsigned char* dst; int o0, o1, o2, o3, ld, K, k0, f8; float cmul; };
constexpr int IT_WIN = NL * 32 * 24, IT_WOUT = NL * 32 * 8, IT_WGU = NL * NE * 32 * 8, IT_WD = NL * NE * 16 * 8, IT_ALL = IT_WIN + IT_WOUT + IT_WGU + IT_WD;
__device__ __forceinline__ void cv_decode(const Ptrs& p, int it, CvItem& c) {
    int r = it;
    if (r < IT_WIN) { const int l = r / (32 * 24), q = r % (32 * 24), kt = q / 24, pn = q % 24; const bool qk = pn < 8;
        c.sa = c.sb = p.w_in + (size_t)l * DM * INW + pn * 256; c.o0 = 0; c.o1 = qk ? 128 : 64; c.o2 = qk ? 64 : 128; c.o3 = 192; c.ld = INW; c.K = DM; c.k0 = kt * 64; c.f8 = 0;
        c.dst = p.ws + WS_WINT + (((size_t)l * INW + pn * 256) * DM) * 2; c.ks = p.norm1_w + l * DM; c.cmul = (pn >= 4 && pn < 8) ? 0.08838834764831845f : 1.0f;
    } else if ((r -= IT_WIN) < IT_WOUT) { const int l = r / (32 * 8), q = r % (32 * 8), kt = q / 8, pn = q % 8;
        c.sa = c.sb = p.w_out + (size_t)l * DM * DM + pn * 256; c.o0 = 0; c.o1 = 64; c.o2 = 128; c.o3 = 192; c.ld = DM; c.K = DM; c.k0 = kt * 64; c.f8 = 0;
        c.dst = p.ws + WS_WOUT + (((size_t)l * DM + pn * 256) * DM) * 2; c.ks = nullptr; c.cmul = 1.0f;
    } else if ((r -= IT_WOUT) < IT_WGU) { const int le = r / (32 * 8), q = r % (32 * 8), kt = q / 8, pn = q % 8, l = le / NE;
        c.sa = p.w_gate + (size_t)le * DM * DE + pn * 128; c.sb = p.w_up + (size_t)le * DM * DE + pn * 128; c.o0 = 0; c.o1 = 64; c.o2 = 0; c.o3 = 64; c.ld = DE; c.K = DM; c.k0 = kt * 64; c.f8 = FP8MOE;
        c.dst = p.ws + WS_WGU + (((size_t)le * 2048 + pn * 256) * DM) * (FP8MOE ? 1 : 2); c.ks = p.norm2_w + l * DM; c.cmul = FP8MOE ? 256.0f : 1.0f;
    } else { r -= IT_WGU; const int le = r / (16 * 8), q = r % (16 * 8), kt = q / 8, pn = q % 8;
        c.sa = c.sb = p.w_down + (size_t)le * DE * DM + pn * 256; c.o0 = 0; c.o1 = 64; c.o2 = 128; c.o3 = 192; c.ld = DM; c.K = DE; c.k0 = kt * 64; c.f8 = FP8MOE;
        c.dst = p.ws + WS_WD + (((size_t)le * 2048 + pn * 256) * DE) * (FP8MOE ? 1 : 2); c.ks = nullptr; c.cmul = FP8MOE ? 256.0f : 1.0f;
    }
}
__device__ __forceinline__ void cv_load(const CvItem& c, int tid, f32x4 (&v)[8], float (&sc)[8]) {
    const int lane = tid & 63, w = tid >> 6, run = lane >> 4, rc = (lane & 15) * 4;
    const float* sp = (run < 2 ? c.sa : c.sb) + (run == 0 ? c.o0 : run == 1 ? c.o1 : run == 2 ? c.o2 : c.o3) + rc;
#pragma unroll
    for (int i = 0; i < 8; ++i) { const int k = c.k0 + w + 8 * i; v[i] = *(const f32x4*)(sp + (size_t)k * c.ld); sc[i] = (c.ks ? c.ks[k] : 1.0f) * c.cmul; }
}
__device__ __forceinline__ void cv_store(const CvItem& c, LAS unsigned char* lds, int tid, const f32x4 (&v)[8], const float (&sc)[8]) {
    const int lane = tid & 63, w = tid >> 6;
    if (c.f8) {
#pragma unroll
        for (int i = 0; i < 8; ++i) { const int kk = w + 8 * i; *(LAS unsigned*)(lds + kk * 260 + lane * 4) = pk4_fp8(v[i].x * sc[i], v[i].y * sc[i], v[i].z * sc[i], v[i].w * sc[i]); }
        __syncthreads();
#pragma unroll
        for (int pss = 0; pss < 2; ++pss) { const int idx = tid + 512 * pss, tl = idx >> 2, ko = idx & 3;
            unsigned wd[4];
#pragma unroll
            for (int j = 0; j < 4; ++j) { const LAS unsigned char* bp = lds + (16 * ko + 4 * j) * 260 + tl;
                wd[j] = (unsigned)bp[0] | ((unsigned)bp[260] << 8) | ((unsigned)bp[520] << 16) | ((unsigned)bp[780] << 24); }
            u32x4 o; o.x = wd[0]; o.y = wd[1]; o.z = wd[2]; o.w = wd[3];
            *(u32x4*)(c.dst + (size_t)tl * c.K + c.k0 + 16 * ko) = o; }
    } else {
#pragma unroll
        for (int i = 0; i < 8; ++i) { const int kk = w + 8 * i; LAS unsigned* d = (LAS unsigned*)(lds + kk * 516 + lane * 8);
            d[0] = pk2(v[i].x * sc[i], v[i].y * sc[i]); d[1] = pk2(v[i].z * sc[i], v[i].w * sc[i]); }
        __syncthreads();
#pragma unroll
        for (int pss = 0; pss < 4; ++pss) { const int idx = tid + 512 * pss, tl = idx >> 3, ko = idx & 7;
            const LAS unsigned short* bp = (const LAS unsigned short*)(lds + (8 * ko) * 516 + tl * 2);
            u32x4 o; o.x = (unsigned)bp[0] | ((unsigned)bp[258] << 16); o.y = (unsigned)bp[516] | ((unsigned)bp[774] << 16); o.z = (unsigned)bp[1032] | ((unsigned)bp[1290] << 16); o.w = (unsigned)bp[1548] | ((unsigned)bp[1806] << 16);
            *(u32x4*)(c.dst + ((size_t)tl * c.K + c.k0 + 8 * ko) * 2) = o; }
    }
    __syncthreads();
}
__device__ __forceinline__ void prologue_phase(const Ptrs& p, LAS unsigned char* lds, int vcu, int G) {
    const int tid = hidden_tid();
    {
        CvItem ca, cb; f32x4 va[8], vb[8]; float sa[8], sb[8];
        int it = vcu;
        if (it < IT_ALL) { cv_decode(p, it, ca); cv_load(ca, tid, va, sa); }
        while (it < IT_ALL) {
            const int itb = it + G; const bool hb = itb < IT_ALL;
            if (hb) { cv_decode(p, itb, cb); cv_load(cb, tid, vb, sb); }
            cv_store(ca, lds, tid, va, sa);
            if (!hb) break;
            const int ita = itb + G; const bool ha = ita < IT_ALL;
            if (ha) { cv_decode(p, ita, ca); cv_load(ca, tid, va, sa); }
            cv_store(cb, lds, tid, vb, sb);
            if (!ha) break;
            it = ita;
        }
    }
    const size_t gt = (size_t)vcu * 512 + tid, gn = (size_t)G * 512;
    bf16_t* wr = (bf16_t*)(p.ws + WS_WR);
    for (size_t i = gt; i < (size_t)NL * 48 * DM; i += gn) { const int l = (int)(i / (48 * DM)), o = (int)(i / DM) % 48, k = (int)(i % DM);
        float w = 0.f; if (o < 4) w = p.rg_w[((size_t)l * DM + k) * NGRP + o]; else if (o < 36) w = p.re_w[((size_t)l * DM + k) * NE + (o - 4)];
        w *= p.norm2_w[l * DM + k];
        const unsigned hi = f2bf(w); const unsigned lo = f2bf(w - bf2f(hi));
        wr[((size_t)(l * 2 + 0) * 48 + o) * DM + k] = (bf16_t)hi; wr[((size_t)(l * 2 + 1) * 48 + o) * DM + k] = (bf16_t)lo; }
    bf16_t* wsb = (bf16_t*)(p.ws + WS_WSB);
    for (size_t i = gt; i < (size_t)NL * GG * 128 * 128; i += gn) wsb[i] = (bf16_t)f2bf(p.w_s[i]);
    float* cosT = (float*)(p.ws + WS_ROPE); float* sinT = cosT + SEQ * 64;
    for (size_t i = gt; i < (size_t)SEQ * 64; i += gn) { const int pos = (int)(i >> 6), ii = (int)(i & 63);
        const float ang = (float)pos * powf(10000.0f, -(float)ii / 64.0f); cosT[i] = cosf(ang); sinT[i] = sinf(ang); }
}

__device__ __forceinline__ void r2_phase(const Ptrs& p, int l, LAS unsigned char* lds, int G) {
    unsigned* ctl = (unsigned*)(p.ws + WS_CTL);
    const int tid = hidden_tid(), lane = tid & 63, w = __builtin_amdgcn_readfirstlane(tid >> 6), r = lane & 15, q4 = lane >> 4, tp = w >> 1, kh = w & 1;
    LAS float* lgp = (LAS float*)lds;
    LAS float* ssq = (LAS float*)(lds + 8 * 16 * 48 * 4);
    LAS int* lcnt = (LAS int*)(lds + 8 * 16 * 48 * 4 + 512);
    LAS int* gbase = lcnt + 32;
    const bf16_t* x1 = (const bf16_t*)(p.ws + WS_X1); bf16_t* h2b = (bf16_t*)(p.ws + WS_H2B);
    const bf16_t* whi = (const bf16_t*)(p.ws + WS_WR) + (size_t)(l * 2 + 0) * 48 * DM; const bf16_t* wlo = (const bf16_t*)(p.ws + WS_WR) + (size_t)(l * 2 + 1) * 48 * DM;
    for (int base = (int)blockIdx.x * 64; base < NTOK; base += G * 64) {
        const int row = base + 16 * tp + r;
        f32x4 acc[3]; acc[0] = acc[1] = acc[2] = (f32x4){0.f, 0.f, 0.f, 0.f}; float ss = 0.f;
        const bf16_t* xr = x1 + (size_t)row * DM + kh * 1024 + 8 * q4; bf16_t* hr = h2b + (size_t)row * DM + kh * 1024 + 8 * q4;
        const bf16_t* bh = whi + (size_t)r * DM + kh * 1024 + 8 * q4; const bf16_t* bl = wlo + (size_t)r * DM + kh * 1024 + 8 * q4;
        for (int s0 = 0; s0 < 32; s0 += 4) {
            u32x4 xq[4]; u32x2 h8[4];
#pragma unroll
            for (int j = 0; j < 4; ++j) xq[j] = *(const u32x4*)(xr + 32 * (s0 + j));
#pragma unroll
            for (int j = 0; j < 4; ++j) { const int s = s0 + j;
                float xv[8]; unpack8(xq[j], xv);
#pragma unroll
                for (int i = 0; i < 8; ++i) ss += xv[i] * xv[i];
                h8[j].x = pk4_fp8(xv[0], xv[1], xv[2], xv[3]); h8[j].y = pk4_fp8(xv[4], xv[5], xv[6], xv[7]);
                const bf16x8 ahi = __builtin_bit_cast(bf16x8, xq[j]);
#pragma unroll
                for (int nt = 0; nt < 3; ++nt) {
                    const bf16x8 bhi = *(const bf16x8*)(bh + (size_t)nt * 16 * DM + 32 * s), blo = *(const bf16x8*)(bl + (size_t)nt * 16 * DM + 32 * s);
                    acc[nt] = __builtin_amdgcn_mfma_f32_16x16x32_bf16(ahi, bhi, acc[nt], 0, 0, 0);
                    acc[nt] = __builtin_amdgcn_mfma_f32_16x16x32_bf16(ahi, blo, acc[nt], 0, 0, 0);
                }
            }
            asm volatile("" ::: "memory");
#pragma unroll
            for (int j = 0; j < 4; ++j) { if (FP8MOE) *(u32x2*)((unsigned char*)h2b + (size_t)row * DM + kh * 1024 + 8 * q4 + 32 * (s0 + j)) = h8[j]; else *(u32x4*)(hr + 32 * (s0 + j)) = xq[j]; }
            asm volatile("" ::: "memory");
        }
#pragma unroll
        for (int nt = 0; nt < 3; ++nt)
#pragma unroll
            for (int rr = 0; rr < 4; ++rr) lgp[(w * 16 + 4 * q4 + rr) * 48 + 16 * nt + r] = acc[nt][rr];
        ss += shx(ss, lane, 16); ss += shx(ss, lane, 32);
        if (q4 == 0) ssq[w * 16 + r] = ss;
        if (tid < 32) lcnt[tid] = 0;
        __syncthreads();
        int e0 = 0, e1 = 0, lp0 = 0, lp1 = 0; float w0 = 0.f, w1 = 0.f, rstd = 0.f;
        const bool router = (kh == 0 && lane < 16);
        const int tokn = base + 16 * tp + lane;
        if (router) {
            rstd = 1.0f / sqrtf((ssq[w * 16 + lane] + ssq[(w + 1) * 16 + lane]) * (1.0f / DM) + EPS);
            LAS float* mine = lgp + (w * 16 + lane) * 48; const LAS float* oth = lgp + ((w + 1) * 16 + lane) * 48;
            for (int o = 0; o < 36; ++o) mine[o] = (mine[o] + oth[o]) * rstd + (o < 4 ? p.rg_b[l * NGRP + o] : p.re_b[l * NE + o - 4]);
            route_token((const LAS float*)mine, e0, e1, w0, w1);
            lp0 = __hip_atomic_fetch_add(&lcnt[e0], 1, __ATOMIC_RELAXED, __HIP_MEMORY_SCOPE_WORKGROUP); lp1 = __hip_atomic_fetch_add(&lcnt[e1], 1, __ATOMIC_RELAXED, __HIP_MEMORY_SCOPE_WORKGROUP);
        }
        __syncthreads();
        if (tid < 32) { const int c = lcnt[tid]; gbase[tid] = c ? (int)__hip_atomic_fetch_add(&ctl[CW_CNT + (l * NE + tid) * 16], (unsigned)c, __ATOMIC_RELAXED, __HIP_MEMORY_SCOPE_AGENT) : 0; }
        __syncthreads();
        if (router) {
            const int s0 = gbase[e0] + lp0, s1 = gbase[e1] + lp1;
            int* tok = (int*)(p.ws + WS_TOK); float* rse = (float*)(p.ws + WS_RSE);
            tok[(size_t)e0 * NTOK + s0] = tokn; rse[(size_t)e0 * NTOK + s0] = rstd; tok[(size_t)e1 * NTOK + s1] = tokn; rse[(size_t)e1 * NTOK + s1] = rstd;
            Rec rc; rc.e0 = e0; rc.s0 = s0; rc.w0 = w0; rc.e1 = e1; rc.s1 = s1; rc.w1 = w1; rc.pad0 = 0; rc.pad1 = 0;
            ((Rec*)(p.ws + WS_REC))[tokn] = rc;
        }
        __syncthreads();
    }
}

typedef short s16x4 __attribute__((ext_vector_type(4)));
__device__ __forceinline__ unsigned off_b(unsigned row, unsigned ch) { return 256u * row + 16u * (ch ^ (((row & 3u) << 2) | ((row >> 2) & 3u))); }
__device__ __forceinline__ unsigned tr_addr(unsigned r0, unsigned c, unsigned lane) { const unsigned q = (lane & 15u) >> 2, pp = lane & 3u; return off_b(r0 + q, 2u * c + (pp >> 1)) + 8u * (pp & 1u); }
__device__ __forceinline__ s16x4 trd(const LAS unsigned char* p) { return __builtin_amdgcn_ds_read_tr16_b64_v4i16((LAS s16x4*)p); }
__device__ __forceinline__ bf16x8 mk8(s16x4 a, s16x4 b) { return __builtin_shufflevector(a, b, 0, 1, 2, 3, 4, 5, 6, 7); }
constexpr unsigned IMG_K = 0, IMG_V = 32768, IMG_S = 65536;
constexpr unsigned BUF_K0 = 0, BUF_V0 = 32768, BUF_K1 = 65536, BUF_V1 = 98304;

__device__ __forceinline__ void load_image(LAS unsigned char* lds, unsigned img, const bf16_t* src, int tid) {
#pragma unroll
    for (int i = 0; i < 4; ++i) { const int idx = tid + 512 * i, row = idx >> 4, ch = idx & 15;
        const u32x4 v = *(const u32x4*)(src + (size_t)row * INW + ch * 8);
        *(LAS u32x4*)(lds + img + off_b(row, ch)) = v; }
}
__device__ __forceinline__ void dma_image(LAS unsigned char* lds, unsigned img, const bf16_t* src, int tid, int wv) {
#pragma unroll
    for (int j = 0; j < 4; ++j) { const unsigned row = 32u * j + ((unsigned)tid >> 4), cp = (unsigned)tid & 15u, cl = cp ^ (((row & 3u) << 2) | ((row >> 2) & 3u));
        __builtin_amdgcn_global_load_lds((const unsigned*)(src + (size_t)row * INW + cl * 8), (LAS unsigned*)(lds + img + (unsigned)(j * 512 + wv * 64) * 16u), 16, 0, 0); }
}
#define MIX_BAR() do { asm volatile("s_waitcnt lgkmcnt(0)" ::: "memory"); __builtin_amdgcn_s_barrier(); asm volatile("" ::: "memory"); } while (0)
struct TrBases { unsigned k0, v0[8], dv; };
__device__ __forceinline__ void make_bases(TrBases& B, int w, int lane) {
    const unsigned q4 = lane >> 4;
    B.k0 = tr_addr(8 * q4, w, lane); B.dv = tr_addr(8 * q4 + 4, 0, lane) - tr_addr(8 * q4, 0, lane);
#pragma unroll
    for (int c = 0; c < 8; ++c) B.v0[c] = tr_addr(8 * q4, c, lane);
}
template <int CB>
__device__ __forceinline__ void kv_chunk(const LAS unsigned char* kimg, const LAS unsigned char* vimg, const TrBases& B, const float (&f0)[8], float g32i, f32x4 (&D)[8]) {
    float sk = 1.0f; unsigned dv = B.dv; asm volatile("" : "+v"(dv));
#pragma unroll
    for (int ks = 0; ks < 4; ++ks) {
        const s16x4 ka = trd(kimg + B.k0 + 8192 * ks), kb = trd(kimg + (B.k0 + dv) + 8192 * ks);
        u32x4 kk;
        kk.x = pk2(bf2f((unsigned short)ka[0]) * (f0[0] * sk), bf2f((unsigned short)ka[1]) * (f0[1] * sk)); kk.y = pk2(bf2f((unsigned short)ka[2]) * (f0[2] * sk), bf2f((unsigned short)ka[3]) * (f0[3] * sk));
        kk.z = pk2(bf2f((unsigned short)kb[0]) * (f0[4] * sk), bf2f((unsigned short)kb[1]) * (f0[5] * sk)); kk.w = pk2(bf2f((unsigned short)kb[2]) * (f0[6] * sk), bf2f((unsigned short)kb[3]) * (f0[7] * sk));
        const bf16x8 af = __builtin_bit_cast(bf16x8, kk);
#pragma unroll
        for (int c4 = 0; c4 < 8; c4 += CB) {
            s16x4 va[CB], vb[CB];
#pragma unroll
            for (int c = 0; c < CB; ++c) { va[c] = trd(vimg + B.v0[c4 + c] + 8192 * ks); vb[c] = trd(vimg + (B.v0[c4 + c] + dv) + 8192 * ks); }
            __builtin_amdgcn_sched_barrier(0);
#pragma unroll
            for (int c = 0; c < CB; ++c) D[c4 + c] = __builtin_amdgcn_mfma_f32_16x16x32_bf16(af, mk8(va[c], vb[c]), D[c4 + c], 0, 0, 0);
            __builtin_amdgcn_sched_barrier(0);
        }
        sk *= g32i;
    }
}
__device__ __forceinline__ void kv_item(const Ptrs& p, LAS unsigned char* lds, int wg) {
    const int tid = hidden_tid(), lane = tid & 63, w = __builtin_amdgcn_readfirstlane(tid >> 6), q4 = lane >> 4;
    const int b = wg >> 6, h = (wg >> 3) & 7, q8 = wg & 7;
    const float lg = log2_gamma(h), g128 = exp2f(lg * 128.0f), g32i = exp2f(-lg * 32.0f);
    const bf16_t* P = (const bf16_t*)(p.ws + WS_P);
    const bf16_t* srcK = P + ((size_t)b * SEQ + q8 * 512) * INW + COL_K + h * 128; const bf16_t* srcV = srcK + (COL_V - COL_K);
    TrBases B; make_bases(B, w, lane);
    float f0[8];
#pragma unroll
    for (int j = 0; j < 8; ++j) f0[j] = exp2f(lg * (float)(127 - 8 * q4 - j));
    f32x4 st[8];
#pragma unroll
    for (int c = 0; c < 8; ++c) st[c] = (f32x4){0.f, 0.f, 0.f, 0.f};
    __syncthreads();
    dma_image(lds, BUF_K0, srcK, tid, w); dma_image(lds, BUF_V0, srcV, tid, w);
    for (int ch = 0; ch < 4; ++ch) {
        const unsigned cur = (ch & 1) ? BUF_K1 : BUF_K0, oth = (ch & 1) ? BUF_K0 : BUF_K1;
        if (ch < 3) { dma_image(lds, oth, srcK + (size_t)(ch + 1) * 128 * INW, tid, w); dma_image(lds, oth + 32768, srcV + (size_t)(ch + 1) * 128 * INW, tid, w);
            asm volatile("s_waitcnt vmcnt(8)" ::: "memory"); }
        else asm volatile("s_waitcnt vmcnt(0)" ::: "memory");
        MIX_BAR();
#pragma unroll
        for (int c = 0; c < 8; ++c) st[c] = st[c] * g128;
        kv_chunk<8>(lds + cur, lds + cur + 32768, B, f0, g32i, st);
        MIX_BAR();
    }
    f32x4* dump = (f32x4*)(p.ws + WS_SSUP) + (size_t)wg * 4096;
#pragma unroll
    for (int c = 0; c < 8; ++c) dump[c * 512 + tid] = st[c];
}
__device__ __forceinline__ void ret_item(const Ptrs& p, int l, LAS unsigned char* lds, int wg) {
    const int tid = hidden_tid(), lane = tid & 63, w = __builtin_amdgcn_readfirstlane(tid >> 6), q4 = lane >> 4, fr = lane & 15;
    const int b = wg >> 6, h = (wg >> 3) & 7, q8 = wg & 7;
    const float lg = log2_gamma(h), g128 = exp2f(lg * 128.0f), g512 = exp2f(lg * 512.0f), g32i = exp2f(-lg * 32.0f);
    const bf16_t* P = (const bf16_t*)(p.ws + WS_P); bf16_t* mix = (bf16_t*)(p.ws + WS_MIX);
    const size_t rowb = (size_t)b * SEQ + q8 * 512;
    const bf16_t* srcK = P + rowb * INW + COL_K + h * 128; const bf16_t* srcV = srcK + (COL_V - COL_K);
    __syncthreads();
    dma_image(lds, BUF_K0, srcK, tid, w); dma_image(lds, BUF_V0, srcV, tid, w);
    TrBases B; make_bases(B, w, lane);
    float f0[8];
#pragma unroll
    for (int j = 0; j < 8; ++j) f0[j] = exp2f(lg * (float)(127 - 8 * q4 - j));
    unsigned kb0[4], sb[4];
    const unsigned kr = 8 * (fr >> 2) + (fr & 3);
#pragma unroll
    for (int ks = 0; ks < 4; ++ks) { kb0[ks] = off_b(kr, 4 * ks + q4); sb[ks] = off_b(fr, 4 * ks + q4); }
    const unsigned dk = off_b(kr + 4, q4) - off_b(kr, q4);
    const unsigned stw = off_b(fr, 2 * w + (q4 >> 1)) + 8 * (q4 & 1);
    const int t = 16 * w + fr;
    const float gq = exp2f(lg * (float)(t + 1));
    bf16x8 qf[4];
#pragma unroll
    for (int ks = 0; ks < 4; ++ks) qf[ks] = *(const bf16x8*)(P + (rowb + t) * INW + COL_Q + h * 128 + 32 * ks + 8 * q4);
    LAS float* gnw = (LAS float*)(lds + LDS_TAB);
    if (tid < 128) gnw[tid] = p.ret_gn_w[l * 1024 + h * 128 + tid];
    f32x4 st[8];
#pragma unroll
    for (int c = 0; c < 8; ++c) st[c] = (f32x4){0.f, 0.f, 0.f, 0.f};
    for (int q0 = 0; q0 < q8; q0 += 4) {
        const f32x4* dump = (const f32x4*)(p.ws + WS_SSUP) + (size_t)(wg - q8 + q0) * 4096 + tid;
        f32x4 dv[4][8]; const int nq = q8 - q0;
#pragma unroll
        for (int i = 0; i < 4; ++i) if (i < nq) {
#pragma unroll
            for (int c = 0; c < 8; ++c) dv[i][c] = dump[(size_t)i * 4096 + c * 512]; }
#pragma unroll
        for (int i = 0; i < 4; ++i) if (i < nq) {
#pragma unroll
            for (int c = 0; c < 8; ++c) st[c] = st[c] * g512 + dv[i][c]; }
    }
    for (int ch = 0; ch < 4; ++ch) {
        const size_t row0 = rowb + ch * 128;
        const unsigned cur = (ch & 1) ? BUF_K1 : BUF_K0, oth = (ch & 1) ? BUF_K0 : BUF_K1;
        const LAS unsigned char* kimg = lds + cur; const LAS unsigned char* vimg = lds + cur + 32768; LAS unsigned char* simg = lds + oth + 32768;
        asm volatile("s_waitcnt vmcnt(0)" ::: "memory");
        MIX_BAR();
#pragma unroll
        for (int c = 0; c < 8; ++c) { u32x2 wv; wv.x = pk2(st[c][0], st[c][1]); wv.y = pk2(st[c][2], st[c][3]); *(LAS u32x2*)(simg + stw + 4096 * c) = wv; }
        if (ch < 3) dma_image(lds, oth, srcK + (size_t)(ch + 1) * 128 * INW, tid, w);
        u32x2 gv8[8];
#pragma unroll
        for (int c = 0; c < 8; ++c) gv8[c] = *(const u32x2*)(P + (row0 + t) * INW + COL_G + h * 128 + 16 * c + 4 * q4);
        MIX_BAR();
        f32x4 O[8];
#pragma unroll
        for (int c2 = 0; c2 < 8; c2 += 2) {
            bf16x8 sa[2][4];
#pragma unroll
            for (int c = 0; c < 2; ++c)
#pragma unroll
                for (int ks = 0; ks < 4; ++ks) sa[c][ks] = *(const LAS bf16x8*)(simg + sb[ks] + 4096 * (c2 + c));
            __builtin_amdgcn_sched_barrier(0);
#pragma unroll
            for (int c = 0; c < 2; ++c) { O[c2 + c] = (f32x4){0.f, 0.f, 0.f, 0.f};
#pragma unroll
                for (int ks = 0; ks < 4; ++ks) O[c2 + c] = __builtin_amdgcn_mfma_f32_16x16x32_bf16(sa[c][ks], qf[ks], O[c2 + c], 0, 0, 0);
                O[c2 + c] = O[c2 + c] * gq; }
            __builtin_amdgcn_sched_barrier(0);
        }
        MIX_BAR();
        if (ch < 3) dma_image(lds, oth + 32768, srcV + (size_t)(ch + 1) * 128 * INW, tid, w);
        for (int stp = 0; stp <= (w >> 1); ++stp) {
            f32x4 T0 = (f32x4){0.f, 0.f, 0.f, 0.f}, T1 = T0;
            const LAS unsigned char* kst = kimg + 8192 * stp; const LAS unsigned char* vst = vimg + 8192 * stp; unsigned dvl = B.dv, dkl = dk; asm volatile("" : "+v"(dvl), "+v"(dkl));
            bf16x8 a0[4], a1[4];
#pragma unroll
            for (int ks = 0; ks < 4; ++ks) { a0[ks] = *(const LAS bf16x8*)(kst + kb0[ks]); a1[ks] = *(const LAS bf16x8*)(kst + (kb0[ks] + dkl)); }
            __builtin_amdgcn_sched_barrier(0);
#pragma unroll
            for (int ks = 0; ks < 4; ++ks) { T0 = __builtin_amdgcn_mfma_f32_16x16x32_bf16(a0[ks], qf[ks], T0, 0, 0, 0); T1 = __builtin_amdgcn_mfma_f32_16x16x32_bf16(a1[ks], qf[ks], T1, 0, 0, 0); }
            float pv[8];
#pragma unroll
            for (int r = 0; r < 4; ++r) { const int s0 = 32 * stp + 8 * q4 + r, s1 = s0 + 4;
                pv[r] = (t >= s0) ? T0[r] * exp2f(lg * (float)(t - s0)) : 0.f; pv[4 + r] = (t >= s1) ? T1[r] * exp2f(lg * (float)(t - s1)) : 0.f; }
            u32x4 pk; pk.x = pk2(pv[0], pv[1]); pk.y = pk2(pv[2], pv[3]); pk.z = pk2(pv[4], pv[5]); pk.w = pk2(pv[6], pv[7]);
            const bf16x8 pf = __builtin_bit_cast(bf16x8, pk);
#pragma unroll
            for (int c4 = 0; c4 < 8; c4 += 4) {
                s16x4 va[4], vb[4];
#pragma unroll
                for (int c = 0; c < 4; ++c) { va[c] = trd(vst + B.v0[c4 + c]); vb[c] = trd(vst + (B.v0[c4 + c] + dvl)); }
                __builtin_amdgcn_sched_barrier(0);
#pragma unroll
                for (int c = 0; c < 4; ++c) O[c4 + c] = __builtin_amdgcn_mfma_f32_16x16x32_bf16(mk8(va[c], vb[c]), pf, O[c4 + c], 0, 0, 0);
                __builtin_amdgcn_sched_barrier(0);
            }
        }
        if (ch < 3) {
#pragma unroll
            for (int ks = 0; ks < 4; ++ks) qf[ks] = *(const bf16x8*)(P + (row0 + 128 + t) * INW + COL_Q + h * 128 + 32 * ks + 8 * q4); }
        { float s = 0.f;
#pragma unroll
          for (int c = 0; c < 8; ++c) s += (O[c][0] + O[c][1]) + (O[c][2] + O[c][3]);
          s += shx(s, lane, 16); s += shx(s, lane, 32);
          const float mu = s * (1.0f / 128.0f); float qv = 0.f;
#pragma unroll
          for (int c = 0; c < 8; ++c) { const f32x4 d = O[c] - mu; qv += (d[0] * d[0] + d[1] * d[1]) + (d[2] * d[2] + d[3] * d[3]); }
          qv += shx(qv, lane, 16); qv += shx(qv, lane, 32);
          const float rs = 1.0f / sqrtf(qv * (1.0f / 128.0f) + EPS);
          const size_t row = row0 + t;
#pragma unroll
          for (int c = 0; c < 8; ++c) { const int e0 = h * 128 + 16 * c + 4 * q4;
              const u32x2 gv = gv8[c]; const f32x4 gw = *(const LAS f32x4*)(gnw + 16 * c + 4 * q4);
              const float g0 = bf2f(gv.x & 0xffffu), g1 = bf2f(gv.x >> 16), g2 = bf2f(gv.y & 0xffffu), g3 = bf2f(gv.y >> 16);
              u32x2 o; o.x = pk2(silu(g0) * ((O[c][0] - mu) * rs * gw[0]), silu(g1) * ((O[c][1] - mu) * rs * gw[1])); o.y = pk2(silu(g2) * ((O[c][2] - mu) * rs * gw[2]), silu(g3) * ((O[c][3] - mu) * rs * gw[3]));
              *(u32x2*)(mix + row * DM + e0) = o; } }
#pragma unroll
        for (int c = 0; c < 8; ++c) st[c] = st[c] * g128;
        kv_chunk<4>(kimg, vimg, B, f0, g32i, st);
    }
    MIX_BAR();
}
__device__ __forceinline__ void gmlp_fetch(const Ptrs& p, int it, int tid, u32x4 (&vq)[4]) {
    const int b = it >> 8, nb = (it >> 3) & 31, g = it & 7;
    const bf16_t* src = (const bf16_t*)(p.ws + WS_P) + ((size_t)b * SEQ + nb * 128) * INW + COL_VS + g * 128;
#pragma unroll
    for (int i = 0; i < 4; ++i) { const int idx = tid + 512 * i, row = idx >> 4, ch = idx & 15; vq[i] = *(const u32x4*)(src + (size_t)row * INW + ch * 8); }
}
__device__ __forceinline__ void gmlp_items(const Ptrs& p, int l, LAS unsigned char* lds, int first, int G) {
    const int tid = hidden_tid(), lane = tid & 63, w = __builtin_amdgcn_readfirstlane(tid >> 6), q4 = lane >> 4, fr = lane & 15;
    const bf16_t* P = (const bf16_t*)(p.ws + WS_P); bf16_t* mix = (bf16_t*)(p.ws + WS_MIX);
    u32x4 vq[4];
    if (first < 1024) gmlp_fetch(p, first, tid, vq);
    for (int it = first; it < 1024; it += G) {
        const int b = it >> 8, nb = (it >> 3) & 31, g = it & 7;
        const size_t row0 = (size_t)b * SEQ + nb * 128;
        __syncthreads();
#pragma unroll
        for (int i = 0; i < 4; ++i) { const int idx = tid + 512 * i, row = idx >> 4, ch = idx & 15;
            float x[8]; unpack8(vq[i], x);
            float s = 0.f;
#pragma unroll
            for (int j = 0; j < 8; ++j) s += x[j];
            s += shx(s, lane, 1); s += shx(s, lane, 2); s += shx(s, lane, 4); s += shx(s, lane, 8);
            const float mu = s * (1.0f / 128.0f); float qv = 0.f;
#pragma unroll
            for (int j = 0; j < 8; ++j) { x[j] -= mu; qv += x[j] * x[j]; }
            qv += shx(qv, lane, 1); qv += shx(qv, lane, 2); qv += shx(qv, lane, 4); qv += shx(qv, lane, 8);
            const float rs = 1.0f / sqrtf(qv * (1.0f / 128.0f) + EPS);
            const f32x4 n0 = *(const f32x4*)(p.gmlp_norm_w + l * 1024 + g * 128 + ch * 8), n1 = *(const f32x4*)(p.gmlp_norm_w + l * 1024 + g * 128 + ch * 8 + 4);
            u32x4 o; o.x = pk2(x[0] * rs * n0[0], x[1] * rs * n0[1]); o.y = pk2(x[2] * rs * n0[2], x[3] * rs * n0[3]); o.z = pk2(x[4] * rs * n1[0], x[5] * rs * n1[1]); o.w = pk2(x[6] * rs * n1[2], x[7] * rs * n1[3]);
            *(LAS u32x4*)(lds + IMG_K + off_b(row, ch)) = o; }
        const bf16_t* Wm = (const bf16_t*)(p.ws + WS_WSB) + ((size_t)l * GG + g) * 128 * 128;
        const int c0 = g * 128 + 16 * w + 4 * q4;
        f32x4 Z[8]; u32x2 uv[8]; float bs[8]; bf16x8 bw[8][4];
#pragma unroll
        for (int tt = 0; tt < 8; ++tt) { const int tl = 16 * tt + fr; bs[tt] = p.b_s[((size_t)l * GG + g) * 128 + tl]; uv[tt] = *(const u32x2*)(P + (row0 + tl) * INW + COL_U + c0);
#pragma unroll
            for (int ks = 0; ks < 4; ++ks) { if (tt < 4 && ks >= 2) continue; bw[tt][ks] = *(const bf16x8*)(Wm + (size_t)tl * 128 + 32 * ks + 8 * q4); } }
        if (it + G < 1024) gmlp_fetch(p, it + G, tid, vq);
        __syncthreads();
        const unsigned tb0 = IMG_K + tr_addr(8 * q4, w, lane), tb1 = IMG_K + tr_addr(8 * q4 + 4, w, lane);
        bf16x8 af[4];
#pragma unroll
        for (int ks = 0; ks < 4; ++ks) af[ks] = mk8(trd(lds + tb0 + 8192 * ks), trd(lds + tb1 + 8192 * ks));
#pragma unroll
        for (int tt = 0; tt < 8; ++tt) {
            Z[tt] = (f32x4){0.f, 0.f, 0.f, 0.f};
#pragma unroll
            for (int ks = 0; ks < 4; ++ks) { if (tt < 4 && ks >= 2) continue; Z[tt] = __builtin_amdgcn_mfma_f32_16x16x32_bf16(af[ks], bw[tt][ks], Z[tt], 0, 0, 0); }
        }
        asm volatile("" ::: "memory");
#pragma unroll
        for (int tt = 0; tt < 8; ++tt) { const size_t row = row0 + 16 * tt + fr;
            u32x2 o; o.x = pk2(bf2f(uv[tt].x & 0xffffu) * (Z[tt][0] + bs[tt]), bf2f(uv[tt].x >> 16) * (Z[tt][1] + bs[tt])); o.y = pk2(bf2f(uv[tt].y & 0xffffu) * (Z[tt][2] + bs[tt]), bf2f(uv[tt].y >> 16) * (Z[tt][3] + bs[tt]));
            *(u32x2*)(mix + row * DM + 1024 + c0) = o; }
    }
}

template <int MODE, class EB>
__device__ __forceinline__ void row_phase2(const Ptrs& p, const void* srcv, bf16_t* xres  , bf16_t* xb, const Rec* rec, const bf16_t* y, EB ebase, int gw, int ngw, int lane) {
    for (int row = gw; row < NTOK; row += ngw) {
        float v[4][8];
        if (MODE == 0) { const f32x4* xr = (const f32x4*)((const float*)srcv + (size_t)row * DM) + 2 * lane;
#pragma unroll
            for (int j = 0; j < 4; ++j) { const f32x4 a = xr[128 * j], b = xr[128 * j + 1]; v[j][0] = a.x; v[j][1] = a.y; v[j][2] = a.z; v[j][3] = a.w; v[j][4] = b.x; v[j][5] = b.y; v[j][6] = b.z; v[j][7] = b.w; }
        } else {
            const Rec r = rec[row];
            const size_t r0 = (size_t)(ebase[r.e0] + r.s0), r1 = (size_t)(ebase[r.e1] + r.s1);
            const u32x4* xr = (const u32x4*)((const bf16_t*)srcv + (size_t)row * DM) + lane;
            u32x4 xv[4];
#pragma unroll
            for (int j = 0; j < 4; ++j) xv[j] = xr[64 * j];
            if (FP8MOE) {
                const u32x2* y0 = (const u32x2*)((const unsigned char*)y + r0 * DM) + lane; const u32x2* y1 = (const u32x2*)((const unsigned char*)y + r1 * DM) + lane;
                u32x2 av[4], bv[4]; const float w0 = r.w0 * (1.0f / 16.0f), w1 = r.w1 * (1.0f / 16.0f);
#pragma unroll
                for (int j = 0; j < 4; ++j) { av[j] = y0[64 * j]; bv[j] = y1[64 * j]; }
#pragma unroll
                for (int j = 0; j < 4; ++j) { float a[8], b[8]; unpack8(xv[j], v[j]); unpack8_fp8(av[j], a); unpack8_fp8(bv[j], b);
#pragma unroll
                    for (int i = 0; i < 8; ++i) v[j][i] += w0 * a[i] + w1 * b[i]; }
            } else {
                const u32x4* y0 = (const u32x4*)(y + r0 * DM) + lane; const u32x4* y1 = (const u32x4*)(y + r1 * DM) + lane;
                u32x4 av[4], bv[4];
#pragma unroll
                for (int j = 0; j < 4; ++j) { av[j] = y0[64 * j]; bv[j] = y1[64 * j]; }
#pragma unroll
                for (int j = 0; j < 4; ++j) { float a[8], b[8]; unpack8(xv[j], v[j]); unpack8(av[j], a); unpack8(bv[j], b);
#pragma unroll
                    for (int i = 0; i < 8; ++i) v[j][i] += r.w0 * a[i] + r.w1 * b[i]; }
            }
        }
        float s = 0.f;
#pragma unroll
        for (int j = 0; j < 4; ++j)
#pragma unroll
            for (int i = 0; i < 8; ++i) s += v[j][i] * v[j][i];
        const float rstd = 1.0f / sqrtf(wave_sum_l(s, lane) * (1.0f / DM) + EPS);
        if (MODE <= 1) { u32x4* o = (u32x4*)(xres + (size_t)row * DM) + lane; u32x4* o2 = (u32x4*)(xb + (size_t)row * DM) + lane;
#pragma unroll
            for (int j = 0; j < 4; ++j) { o[64 * j] = pack8(v[j]); float n[8];
#pragma unroll
                for (int i = 0; i < 8; ++i) n[i] = v[j][i] * rstd;
                o2[64 * j] = pack8(n); } }
        if (MODE == 2) { f32x4* o = (f32x4*)(p.out + (size_t)row * DM) + 2 * lane; const f32x4* fw = (const f32x4*)p.final_w + 2 * lane;
#pragma unroll
            for (int j = 0; j < 4; ++j) { const f32x4 f0 = fw[128 * j], f1 = fw[128 * j + 1];
                o[128 * j] = (f32x4){v[j][0] * rstd * f0.x, v[j][1] * rstd * f0.y, v[j][2] * rstd * f0.z, v[j][3] * rstd * f0.w};
                o[128 * j + 1] = (f32x4){v[j][4] * rstd * f1.x, v[j][5] * rstd * f1.y, v[j][6] * rstd * f1.z, v[j][7] * rstd * f1.w}; } }
    }
}

constexpr int NPH = 1 + 8 * NL;
struct MegaArgs { Ptrs p; int ph_lo, ph_hi, use_bar, pad; };
__global__ void __launch_bounds__(NWAVES * 64, 2) k_mega(MegaArgs a) {
    extern __shared__ __attribute__((aligned(16))) unsigned char lds_raw[];
    LAS unsigned char* lds = (LAS unsigned char*)lds_raw;
    const Ptrs& p = a.p;
    const int tid = threadIdx.x;
    const int G = gridDim.x; const int bx = blockIdx.x; const int vcu = (G % 8 == 0) ? (bx % 8) * (G / 8) + bx / 8 : bx;
    unsigned* ctl = (unsigned*)(p.ws + WS_CTL);
    volatile LAS unsigned* MISC = (volatile LAS unsigned*)(lds + LDS_MISC);
    if (tid < 32) MISC[tid] = 0u;
    __syncthreads();
    XcdBarrier bar; bar.bar = ctl + CW_BAR; bar.x = 0; bar.st = MISC + 8;
    if (a.use_bar) bar = xcd_barrier_post(ctl + CW_BAR, MISC + 8);
    const int lo = a.ph_lo, hi = a.ph_hi;
#ifndef PHSEL
#define PHSEL 0xff
#endif
#define IN(k) (lo <= (k) && (k) < hi)
#define SEL(j) ((PHSEL >> (j)) & 1)
#ifndef REPEAT_MASK
#define REPEAT_MASK 0
#endif
#define NREP(j) (((REPEAT_MASK >> (j)) & 1) ? 2 : 1)
#define SEAM(k) do { if (IN((k) + 1)) xcd_barrier(bar); } while (0)
    const int ngw = G * NWAVES;
#define ROWIDS() const int _ht = hidden_tid(); const int lane_ = _ht & 63, gw_ = vcu * NWAVES + (_ht >> 6)
    if (IN(0)) for (int rep = 0; rep < NREP(8); ++rep) {
        prologue_phase(p, lds, vcu, G);
        { ROWIDS(); row_phase2<0>(p, p.x, (bf16_t*)(p.ws + WS_X0B), (bf16_t*)(p.ws + WS_XB), nullptr, nullptr, (const int*)nullptr, gw_, ngw, lane_); }
        SEAM(0);
    }
    for (int l = 0; l < NL; ++l) {
        const int pb = 1 + 8 * l;
        if (SEL(0) && IN(pb + 0)) for (int rep = 0; rep < NREP(0); ++rep) {
            pg8::DenseOrder S; S.init(NTOK, INW, G, bx);
            pg8::EpiG1 E{(bf16_t*)(p.ws + WS_P), (const float*)(p.ws + WS_ROPE), (const float*)(p.ws + WS_ROPE) + SEQ * 64, rep};
            pg8::gemm_phase<false>(lds, (const bf16_t*)(p.ws + WS_XB), (const bf16_t*)(p.ws + WS_WINT) + (size_t)l * INW * DM, DM, S, E);
            SEAM(pb + 0);
        }
        if (SEL(1) && IN(pb + 1)) for (int rep = 0; rep < NREP(1); ++rep) {
            for (int it = bx; it < 256; it += G) kv_item(p, lds, it);
            gmlp_items(p, l, lds, bx, G);
            SEAM(pb + 1);
        }
        if (SEL(2) && IN(pb + 2)) for (int rep = 0; rep < NREP(2); ++rep) {
            for (int it = bx; it < 256; it += G) ret_item(p, l, lds, it);
            SEAM(pb + 2);
        }
        if (SEL(3) && IN(pb + 3)) for (int rep = 0; rep < NREP(3); ++rep) {
            pg8::DenseOrder S; S.init(NTOK, DM, G, bx);
            pg8::EpiG2 E{(const bf16_t*)(p.ws + ((l == 0) ? WS_X0B : WS_X2)), (bf16_t*)(p.ws + WS_X1)};
            pg8::gemm_phase<false>(lds, (const bf16_t*)(p.ws + WS_MIX), (const bf16_t*)(p.ws + WS_WOUT) + (size_t)l * DM * DM, DM, S, E);
            SEAM(pb + 3);
        }
        if (SEL(4) && IN(pb + 4)) {
            __syncthreads();
            r2_phase(p, l, lds, G);
            SEAM(pb + 4);
        }
        if (SEL(5) && IN(pb + 5)) for (int rep = 0; rep < NREP(5); ++rep) {
            const int nu = moe_units(ctl, l, lds, true, (const int*)(p.ws + WS_TOK));
            pg8::MoeOrder<true> S{(const LAS int*)(lds + LDS_UL), (const LAS int*)(lds + LDS_TAB), nu};
            pg8::EpiG3 E{(bf16_t*)(p.ws + WS_HE), (const float*)(p.ws + WS_RSE), (const LAS int*)(lds + LDS_EB)};
            if (FP8MOE) pg8::gemm_phase<true>(lds, (const bf16_t*)(p.ws + WS_H2B), (const bf16_t*)(p.ws + WS_WGU) + (size_t)l * NE * 2048 * (DM / 2), DM / 2, S, E);
            else pg8::gemm_phase<false>(lds, (const bf16_t*)(p.ws + WS_H2B), (const bf16_t*)(p.ws + WS_WGU) + (size_t)l * NE * 2048 * DM, DM, S, E);
            SEAM(pb + 5);
        }
        if (SEL(6) && IN(pb + 6)) for (int rep = 0; rep < NREP(6); ++rep) {
            const int nu = moe_units(ctl, l, lds, false, nullptr);
            pg8::MoeOrder<false> S{(const LAS int*)(lds + LDS_UL), (const LAS int*)(lds + LDS_TAB), nu};
            pg8::EpiG4 E{(bf16_t*)(p.ws + WS_Y)};
            if (FP8MOE) pg8::gemm_phase<true>(lds, (const bf16_t*)(p.ws + WS_HE), (const bf16_t*)(p.ws + WS_WD) + (size_t)l * NE * 2048 * (DE / 2), DE / 2, S, E);
            else pg8::gemm_phase<false>(lds, (const bf16_t*)(p.ws + WS_HE), (const bf16_t*)(p.ws + WS_WD) + (size_t)l * NE * 2048 * DE, DE, S, E);
            SEAM(pb + 6);
        }
        if (SEL(7) && IN(pb + 7)) {
            LAS int* eb = (LAS int*)(lds + LDS_EB);
            __syncthreads();
            if (tid == 0) { int acc = 0; for (int e = 0; e < NE; ++e) { eb[e] = acc; acc += (((int)ctl[CW_CNT + (l * NE + e) * 16] + 255) >> 8) << 8; } }
            __syncthreads();
            ROWIDS();
            if (l + 1 < NL) { row_phase2<1>(p, p.ws + WS_X1, (bf16_t*)(p.ws + WS_X2), (bf16_t*)(p.ws + WS_XB), (const Rec*)(p.ws + WS_REC), (const bf16_t*)(p.ws + WS_Y), (const LAS int*)eb, gw_, ngw, lane_); SEAM(pb + 7); }
            else row_phase2<2>(p, p.ws + WS_X1, nullptr, nullptr, (const Rec*)(p.ws + WS_REC), (const bf16_t*)(p.ws + WS_Y), (const LAS int*)eb, gw_, ngw, lane_);
        }
    }
#undef IN
#undef SEAM
}


#ifndef FAST_MASK
#define FAST_MASK 0x3f
#endif
#ifndef ONE_LAUNCH
#define ONE_LAUNCH 1
#endif
extern "C" void kernel_launch(void* const* d_in, const int* in_sizes, int n_in, void* d_out, int out_size, void* d_ws, size_t ws_size, hipStream_t stream) {
    static int init = 0; static int grid = 0;
    if (!init) {
        if (n_in != 17 || ws_size < WS_END) { fprintf(stderr, "kernel_launch: unexpected n_in %d or ws %zu < %zu\n", n_in, ws_size, (size_t)WS_END); init = -1; return; }
        (void)hipFuncSetAttribute((const void*)nv_retention, hipFuncAttributeMaxDynamicSharedMemorySize, (3 * 64 * 129 + 64 * 65) * 4);
        (void)hipFuncSetAttribute((const void*)nv_gmlp, hipFuncAttributeMaxDynamicSharedMemorySize, 128 * 129 * 4);
        if (hipFuncSetAttribute((const void*)k_mega, hipFuncAttributeMaxDynamicSharedMemorySize, LDS_BYTES) != hipSuccess) { fprintf(stderr, "kernel_launch: hipFuncSetAttribute(k_mega) failed\n"); init = -1; return; }
        int dev = 0, cus = 0, per_cu = 0;
        (void)hipGetDevice(&dev); (void)hipDeviceGetAttribute(&cus, hipDeviceAttributeMultiprocessorCount, dev);
        if (hipOccupancyMaxActiveBlocksPerMultiprocessor(&per_cu, (const void*)k_mega, NWAVES * 64, LDS_BYTES) != hipSuccess || per_cu < 1) fprintf(stderr, "kernel_launch: occupancy query reports %d blocks per CU\n", per_cu);
        (void)hipGetLastError();
        grid = cus > 0 ? cus : 256;
        init = 1;
    }
    if (init < 0) return;
    Ptrs p{};
    p.x = (const float*)d_in[0]; p.norm1_w = (const float*)d_in[1]; p.w_in = (const float*)d_in[2]; p.ret_gn_w = (const float*)d_in[3]; p.gmlp_norm_w = (const float*)d_in[4];
    p.w_s = (const float*)d_in[5]; p.b_s = (const float*)d_in[6]; p.w_out = (const float*)d_in[7]; p.norm2_w = (const float*)d_in[8]; p.rg_w = (const float*)d_in[9]; p.rg_b = (const float*)d_in[10];
    p.re_w = (const float*)d_in[11]; p.re_b = (const float*)d_in[12]; p.w_gate = (const float*)d_in[13]; p.w_up = (const float*)d_in[14]; p.w_down = (const float*)d_in[15]; p.final_w = (const float*)d_in[16];
    p.out = (float*)d_out; p.ws = (unsigned char*)d_ws;
    (void)hipMemsetAsync((char*)d_ws + WS_CTL, 0, CTL_BYTES, stream);
    MegaArgs a{}; a.p = p; a.pad = 0;
#if ONE_LAUNCH
    a.ph_lo = 0; a.ph_hi = NPH; a.use_bar = 1;
    hipLaunchKernelGGL(k_mega, dim3(grid), dim3(NWAVES * 64), LDS_BYTES, stream, a);
#else
    a.use_bar = 0;
    auto mega = [&](int ph) { a.ph_lo = ph; a.ph_hi = ph + 1; hipLaunchKernelGGL(k_mega, dim3(grid), dim3(NWAVES * 64), LDS_BYTES, stream, a); };
    mega(0);
    for (int l = 0; l < NL; ++l) {
        const int pb = 1 + 8 * l;
        if (FAST_MASK & 1) mega(pb + 0); else { hipLaunchKernelGGL(nv_gemm<NV_G1>, dim3(INW / 64, NTOK / 64, 1), dim3(256), 0, stream, p, l); hipLaunchKernelGGL(nv_rope_act, dim3(4096), dim3(256), 0, stream, p); }
        if (FAST_MASK & 2) { mega(pb + 1); mega(pb + 2); }
        else { hipLaunchKernelGGL(nv_retention, dim3(SEQ / 64, NH, NBATCH), dim3(256), (3 * 64 * 129 + 64 * 65) * 4, stream, p, l); hipLaunchKernelGGL(nv_gmlp, dim3(SEQ / 128, GG, NBATCH), dim3(256), 128 * 129 * 4, stream, p, l); }
        if (FAST_MASK & 4) mega(pb + 3); else hipLaunchKernelGGL(nv_gemm<NV_G2>, dim3(DM / 64, NTOK / 64, 1), dim3(256), 0, stream, p, l);
        if (FAST_MASK & 8) mega(pb + 4); else hipLaunchKernelGGL(nv_r2, dim3(NTOK), dim3(256), 0, stream, p, l);
        if (FAST_MASK & 16) mega(pb + 5); else hipLaunchKernelGGL(nv_gemm<NV_G3>, dim3(DE / 64, NTOK / 64, NE), dim3(256), 0, stream, p, l);
        if (FAST_MASK & 32) mega(pb + 6); else hipLaunchKernelGGL(nv_gemm<NV_G4>, dim3(DM / 64, NTOK / 64, NE), dim3(256), 0, stream, p, l);
        mega(pb + 7);
    }
#endif
}
```

```cpp
#include <hip/hip_runtime.h>
#include <cstdio>
#include <cstdint>

#define GAS __attribute__((address_space(1)))
#define LAS __attribute__((address_space(3)))
typedef unsigned short bf16_t;
typedef short bf16x8 __attribute__((ext_vector_type(8)));
typedef float f32x4 __attribute__((ext_vector_type(4)));
typedef float f32x2 __attribute__((ext_vector_type(2)));
typedef unsigned u32x4 __attribute__((ext_vector_type(4)));
typedef unsigned u32x2 __attribute__((ext_vector_type(2)));

constexpr int NTOK = 16384, DM = 2048, SEQ = 4096, NBATCH = 4, NH = 8, DH = 128, INW = 6144, NE = 32, EPG = 8, NGRP = 4, DE = 1024, NL = 2;
constexpr int GG = 8, GBLK = 128;
constexpr int SLOTS = 40960;
constexpr float EPS = 1e-6f;
constexpr int COL_Q = 0, COL_K = 1024, COL_V = 2048, COL_G = 3072, COL_U = 4096, COL_VS = 5120;

constexpr size_t MiB = 1u << 20;
constexpr size_t WS_CTL = 0, CTL_BYTES = 1 * MiB;
constexpr size_t WS_ROPE = 1 * MiB;
constexpr size_t WS_WINT = 3 * MiB;
constexpr size_t WS_WOUT = WS_WINT + 48 * MiB;
constexpr size_t WS_WGU = WS_WOUT + 16 * MiB;
constexpr size_t WS_WD = WS_WGU + 512 * MiB;
constexpr size_t WS_WR = WS_WD + 256 * MiB;
constexpr size_t WS_WSB = WS_WR + 1 * MiB;
constexpr size_t WS_XB = WS_WSB + 1 * MiB;
constexpr size_t WS_P = WS_XB + 64 * MiB;
constexpr size_t WS_SSUP = WS_P + 192 * MiB;
constexpr size_t WS_MIX = WS_SSUP + 16 * MiB;
constexpr size_t WS_X1 = WS_MIX + 64 * MiB;
constexpr size_t WS_X0B = WS_X1 + 64 * MiB;
constexpr size_t WS_H2B = WS_X1 + 128 * MiB;
constexpr size_t WS_REC = WS_H2B + 64 * MiB;
constexpr size_t WS_TOK = WS_REC + 1 * MiB;
constexpr size_t WS_RSE = WS_TOK + 2 * MiB;
constexpr size_t WS_HE = WS_RSE + 2 * MiB;
constexpr size_t WS_Y = WS_HE + 80 * MiB;
constexpr size_t WS_X2 = WS_Y + 160 * MiB;
constexpr size_t WS_END = WS_X2 + 128 * MiB;
constexpr int CW_TMO = 0, CW_BAR = 4096, CW_CNT = 8192;

struct Rec { int e0, s0; float w0; int e1, s1; float w1; int pad0, pad1; };

__device__ __forceinline__ unsigned f2bf(float f) { unsigned u = __builtin_bit_cast(unsigned, f); return (u + 0x7fffu + ((u >> 16) & 1u)) >> 16; }
__device__ __forceinline__ float bf2f(unsigned b) { return __builtin_bit_cast(float, b << 16); }
__device__ __forceinline__ unsigned pk2(float lo, float hi) { return f2bf(lo) | (f2bf(hi) << 16); }
__device__ __forceinline__ float wave_sum(float v) {
#pragma unroll
    for (int o = 1; o < 64; o <<= 1) v += __shfl_xor(v, o);
    return v;
}
__device__ __forceinline__ float shx(float v, int lane, int m) { return __builtin_bit_cast(float, __builtin_amdgcn_ds_bpermute((lane ^ m) << 2, __builtin_bit_cast(int, v))); }
__device__ __forceinline__ float wave_sum_l(float v, int lane) {
#pragma unroll
    for (int o = 1; o < 64; o <<= 1) v += shx(v, lane, o);
    return v;
}
__device__ __forceinline__ float gelu_tanh(float x) {
    const float u = x * (-2.302208198f) * (1.0f + 0.044715f * x * x);
    return x * __builtin_amdgcn_rcpf(1.0f + __builtin_amdgcn_exp2f(u));
}
__device__ __forceinline__ float silu(float x) { return x * __builtin_amdgcn_rcpf(1.0f + __builtin_amdgcn_exp2f(x * -1.4426950408889634f)); }
__device__ __forceinline__ float log2_gamma(int h) { return log2f(1.0f - exp2f(-5.0f - (float)h)); }

struct Ptrs {
    const float *x, *norm1_w, *w_in, *ret_gn_w, *gmlp_norm_w, *w_s, *b_s, *w_out, *norm2_w, *rg_w, *rg_b, *re_w, *re_b, *w_gate, *w_up, *w_down, *final_w;
    float* out; unsigned char* ws;
};

template <int MODE, class EB>
__device__ __forceinline__ void row_phase(const Ptrs& p, const float* src, float* x2, bf16_t* xb, const Rec* rec, const bf16_t* y, EB ebase  , int gw, int ngw, int lane) {
    for (int row = gw; row < NTOK; row += ngw) {
        const f32x4* xr = (const f32x4*)(src + (size_t)row * DM) + lane;
        f32x4 v[8];
#pragma unroll
        for (int j = 0; j < 8; ++j) v[j] = xr[64 * j];
        if (MODE >= 1) {
            const Rec r = rec[row];
            const size_t r0 = (size_t)(ebase[r.e0] + r.s0), r1 = (size_t)(ebase[r.e1] + r.s1);
            const u32x2* y0 = (const u32x2*)(y + r0 * DM) + lane; const u32x2* y1 = (const u32x2*)(y + r1 * DM) + lane;
#pragma unroll
            for (int j = 0; j < 8; ++j) {
                const u32x2 a = y0[64 * j], b = y1[64 * j];
                v[j].x += r.w0 * bf2f(a.x & 0xffffu) + r.w1 * bf2f(b.x & 0xffffu);
                v[j].y += r.w0 * bf2f(a.x >> 16) + r.w1 * bf2f(b.x >> 16);
                v[j].z += r.w0 * bf2f(a.y & 0xffffu) + r.w1 * bf2f(b.y & 0xffffu);
                v[j].w += r.w0 * bf2f(a.y >> 16) + r.w1 * bf2f(b.y >> 16);
            }
        }
        float s = 0.f;
#pragma unroll
        for (int j = 0; j < 8; ++j) s += (v[j].x * v[j].x + v[j].y * v[j].y) + (v[j].z * v[j].z + v[j].w * v[j].w);
        const float rstd = 1.0f / sqrtf(wave_sum_l(s, lane) * (1.0f / DM) + EPS);
        if (MODE == 1) { f32x4* o = (f32x4*)(x2 + (size_t)row * DM) + lane;
#pragma unroll
            for (int j = 0; j < 8; ++j) o[64 * j] = v[j]; }
        if (MODE <= 1) { u32x2* o = (u32x2*)(xb + (size_t)row * DM) + lane;
#pragma unroll
            for (int j = 0; j < 8; ++j) { u32x2 w; w.x = pk2(v[j].x * rstd, v[j].y * rstd); w.y = pk2(v[j].z * rstd, v[j].w * rstd); o[64 * j] = w; } }
        if (MODE == 2) { f32x4* o = (f32x4*)(p.out + (size_t)row * DM) + lane; const f32x4* fw = (const f32x4*)p.final_w + lane;
#pragma unroll
            for (int j = 0; j < 8; ++j) o[64 * j] = v[j] * rstd * fw[64 * j]; }
    }
}
__device__ __forceinline__ void compute_ebase(const unsigned* ctl, int l, int* ebase  ) {
    int acc = 0;
    for (int e = 0; e < NE; ++e) { ebase[e] = acc; const int c = (int)ctl[CW_CNT + (l * NE + e) * 16]; acc += ((c + 255) >> 8) << 8; }
    ebase[NE] = acc;
}
template <int MODE>
__global__ void __launch_bounds__(512) k_row(Ptrs p, int l) {
    __shared__ int ebase[NE + 1];
    const unsigned* ctl = (const unsigned*)(p.ws + WS_CTL);
    if (MODE >= 1) { if (threadIdx.x == 0) compute_ebase(ctl, l - 1, ebase); __syncthreads(); }
    const int lane = threadIdx.x & 63, gw = blockIdx.x * 8 + (threadIdx.x >> 6), ngw = gridDim.x * 8;
    const float* src = (MODE == 0) ? p.x : (const float*)(p.ws + WS_X1);
    row_phase<MODE>(p, src, (float*)(p.ws + WS_X2), (bf16_t*)(p.ws + WS_XB), (const Rec*)(p.ws + WS_REC), (const bf16_t*)(p.ws + WS_Y), (const int*)ebase, gw, ngw, lane);
}

enum { NV_G1 = 0, NV_G2 = 1, NV_G3 = 2, NV_G4 = 3 };
template <int MODE>
__global__ void __launch_bounds__(256) nv_gemm(Ptrs p, int l) {
    __shared__ float As[16][68], Bs[16][68], Bs2[16][68];
    __shared__ int s_ebase[NE + 1];
    const unsigned* ctl = (const unsigned*)(p.ws + WS_CTL);
    const int tid = threadIdx.x, tx = tid & 15, ty = tid >> 4;
    int M, N, K, lda, ldb; const bf16_t* A; const float *B, *B2 = nullptr, *kscale = nullptr; const int* arow = nullptr; int e = 0, rbase = 0;
    if (MODE == NV_G1) { M = NTOK; N = INW; K = DM; A = (const bf16_t*)(p.ws + WS_XB); lda = DM; B = p.w_in + (size_t)l * DM * INW; ldb = INW; kscale = p.norm1_w + l * DM; }
    else if (MODE == NV_G2) { M = NTOK; N = DM; K = DM; A = (const bf16_t*)(p.ws + WS_MIX); lda = DM; B = p.w_out + (size_t)l * DM * DM; ldb = DM; }
    else {
        e = blockIdx.z;
        if (tid == 0) compute_ebase(ctl, l, s_ebase);
        __syncthreads();
        M = (int)ctl[CW_CNT + (l * NE + e) * 16]; rbase = s_ebase[e];
        if (MODE == NV_G3) { N = DE; K = DM; A = (const bf16_t*)(p.ws + WS_H2B); lda = DM; arow = (const int*)(p.ws + WS_TOK) + (size_t)e * NTOK;
            B = p.w_gate + ((size_t)l * NE + e) * DM * DE; B2 = p.w_up + ((size_t)l * NE + e) * DM * DE; ldb = DE; kscale = p.norm2_w + l * DM; }
        else { N = DM; K = DE; A = (const bf16_t*)(p.ws + WS_HE) + (size_t)rbase * DE; lda = DE; B = p.w_down + ((size_t)l * NE + e) * DE * DM; ldb = DM; }
    }
    const int m0 = blockIdx.y * 64, n0 = blockIdx.x * 64;
    if (m0 >= M) return;
    float acc[4][4], acc2[4][4];
#pragma unroll
    for (int i = 0; i < 4; ++i)
#pragma unroll
        for (int j = 0; j < 4; ++j) { acc[i][j] = 0.f; acc2[i][j] = 0.f; }
    int ar = m0 + (tid >> 2); if (ar >= M) ar = M - 1;
    const size_t arow_g = (MODE == NV_G3) ? (size_t)arow[ar] : (size_t)ar;
    const bf16_t* ap = A + arow_g * lda + (tid & 3) * 4;
    const int bk = tid >> 4, bn = (tid & 15) * 4;
    for (int k0 = 0; k0 < K; k0 += 16) {
        const u32x2 av = *(const u32x2*)(ap + k0);
        float a0 = bf2f(av.x & 0xffffu), a1 = bf2f(av.x >> 16), a2 = bf2f(av.y & 0xffffu), a3 = bf2f(av.y >> 16);
        if (kscale) { const int kk = k0 + (tid & 3) * 4; a0 *= kscale[kk]; a1 *= kscale[kk + 1]; a2 *= kscale[kk + 2]; a3 *= kscale[kk + 3]; }
        const int kr = (tid & 3) * 4, rr = tid >> 2;
        As[kr][rr] = a0; As[kr + 1][rr] = a1; As[kr + 2][rr] = a2; As[kr + 3][rr] = a3;
        const f32x4 bv = *(const f32x4*)(B + (size_t)(k0 + bk) * ldb + n0 + bn);
        Bs[bk][bn] = bv.x; Bs[bk][bn + 1] = bv.y; Bs[bk][bn + 2] = bv.z; Bs[bk][bn + 3] = bv.w;
        if (MODE == NV_G3) { const f32x4 b2 = *(const f32x4*)(B2 + (size_t)(k0 + bk) * ldb + n0 + bn);
            Bs2[bk][bn] = b2.x; Bs2[bk][bn + 1] = b2.y; Bs2[bk][bn + 2] = b2.z; Bs2[bk][bn + 3] = b2.w; }
        __syncthreads();
#pragma unroll
        for (int kk = 0; kk < 16; ++kk) {
            float a[4], b[4], c[4];
#pragma unroll
            for (int i = 0; i < 4; ++i) { a[i] = As[kk][ty * 4 + i]; b[i] = Bs[kk][tx * 4 + i]; c[i] = (MODE == NV_G3) ? Bs2[kk][tx * 4 + i] : 0.f; }
#pragma unroll
            for (int i = 0; i < 4; ++i)
#pragma unroll
                for (int j = 0; j < 4; ++j) { acc[i][j] += a[i] * b[j]; if (MODE == NV_G3) acc2[i][j] += a[i] * c[j]; }
        }
        __syncthreads();
    }
#pragma unroll
    for (int i = 0; i < 4; ++i) {
        const int r = m0 + ty * 4 + i; if (r >= M) continue;
        const int c0 = n0 + tx * 4;
        if (MODE == NV_G1) {
            bf16_t* o = (bf16_t*)(p.ws + WS_P) + (size_t)r * INW + c0;
            const float sc = (c0 >= COL_K && c0 < COL_V) ? 0.08838834764831845f : 1.0f;
            u32x2 w; w.x = pk2(acc[i][0] * sc, acc[i][1] * sc); w.y = pk2(acc[i][2] * sc, acc[i][3] * sc); *(u32x2*)o = w;
        } else if (MODE == NV_G2) {
            const float* xin = (l == 0) ? p.x : (const float*)(p.ws + WS_X2);
            const f32x4 xv = *(const f32x4*)(xin + (size_t)r * DM + c0);
            *(f32x4*)((float*)(p.ws + WS_X1) + (size_t)r * DM + c0) = (f32x4){xv.x + acc[i][0], xv.y + acc[i][1], xv.z + acc[i][2], xv.w + acc[i][3]};
        } else if (MODE == NV_G3) {
            const float rs = ((const float*)(p.ws + WS_RSE))[(size_t)e * NTOK + r];
            float h[4];
#pragma unroll
            for (int j = 0; j < 4; ++j) h[j] = silu(acc[i][j] * rs) * (acc2[i][j] * rs);
            u32x2 w; w.x = pk2(h[0], h[1]); w.y = pk2(h[2], h[3]);
            *(u32x2*)((bf16_t*)(p.ws + WS_HE) + (size_t)(rbase + r) * DE + c0) = w;
        } else {
            u32x2 w; w.x = pk2(acc[i][0], acc[i][1]); w.y = pk2(acc[i][2], acc[i][3]);
            *(u32x2*)((bf16_t*)(p.ws + WS_Y) + (size_t)(rbase + r) * DM + c0) = w;
        }
    }
}

__global__ void __launch_bounds__(256) nv_rope_act(Ptrs p) {
    bf16_t* P = (bf16_t*)(p.ws + WS_P);
    const size_t total = (size_t)NTOK * (16 * 64 + 2048);
    for (size_t i = (size_t)blockIdx.x * 256 + threadIdx.x; i < total; i += (size_t)gridDim.x * 256) {
        const int row = (int)(i / 3072), c = (int)(i % 3072);
        bf16_t* pr = P + (size_t)row * INW;
        if (c < 1024) {
            const int hd = c >> 6, ii = c & 63; const int col = hd * 128 + ii;
            const float pos = (float)(row & (SEQ - 1));
            const float freq = powf(10000.0f, -(float)ii / 64.0f);
            const float ang = pos * freq; const float cs = cosf(ang), sn = sinf(ang);
            const float x1 = bf2f(pr[col]), x2 = bf2f(pr[col + 64]);
            pr[col] = (bf16_t)f2bf(x1 * cs - x2 * sn); pr[col + 64] = (bf16_t)f2bf(x1 * sn + x2 * cs);
        } else {
            const int col = COL_U + (c - 1024);
            pr[col] = (bf16_t)f2bf(gelu_tanh(bf2f(pr[col])));
        }
    }
}

__global__ void __launch_bounds__(256) nv_retention(Ptrs p, int l) {
    extern __shared__ float sm[];
    float* qs = sm; float* ks = qs + 64 * 129; float* vs = ks + 64 * 129; float* sc = vs + 64 * 129;
    const bf16_t* P = (const bf16_t*)(p.ws + WS_P);
    const int ti = blockIdx.x, h = blockIdx.y, b = blockIdx.z, tid = threadIdx.x;
    const float lg = log2_gamma(h);
    const int row0 = b * SEQ + ti * 64;
    for (int i = tid; i < 64 * 128; i += 256) { const int r = i >> 7, d = i & 127; qs[r * 129 + d] = bf2f(P[(size_t)(row0 + r) * INW + COL_Q + h * 128 + d]); }
    const int t = tid >> 2, part = tid & 3;
    float o[32];
#pragma unroll
    for (int j = 0; j < 32; ++j) o[j] = 0.f;
    for (int sj = 0; sj <= ti; ++sj) {
        __syncthreads();
        const int srow0 = b * SEQ + sj * 64;
        for (int i = tid; i < 64 * 128; i += 256) { const int r = i >> 7, d = i & 127;
            ks[r * 129 + d] = bf2f(P[(size_t)(srow0 + r) * INW + COL_K + h * 128 + d]); vs[r * 129 + d] = bf2f(P[(size_t)(srow0 + r) * INW + COL_V + h * 128 + d]); }
        __syncthreads();
#pragma unroll 4
        for (int si = 0; si < 16; ++si) {
            const int s = part * 16 + si; float a = 0.f;
            for (int d = 0; d < 128; ++d) a += qs[t * 129 + d] * ks[s * 129 + d];
            const int dt = (ti * 64 + t) - (sj * 64 + s);
            sc[t * 65 + s] = (dt >= 0) ? a * exp2f(lg * (float)dt) : 0.f;
        }
        __syncthreads();
        for (int s = 0; s < 64; ++s) { const float w = sc[t * 65 + s];
#pragma unroll
            for (int j = 0; j < 32; ++j) o[j] += w * vs[s * 129 + part * 32 + j]; }
    }
    float sum = 0.f;
#pragma unroll
    for (int j = 0; j < 32; ++j) sum += o[j];
    sum += __shfl_xor(sum, 1); sum += __shfl_xor(sum, 2);
    const float mu = sum * (1.0f / 128.0f); float q = 0.f;
#pragma unroll
    for (int j = 0; j < 32; ++j) { const float d = o[j] - mu; q += d * d; }
    q += __shfl_xor(q, 1); q += __shfl_xor(q, 2);
    const float rs = 1.0f / sqrtf(q * (1.0f / 128.0f) + EPS);
    const size_t row = (size_t)(row0 + t);
    bf16_t* mix = (bf16_t*)(p.ws + WS_MIX);
#pragma unroll
    for (int j = 0; j < 32; ++j) { const int e = part * 32 + j;
        const float g = bf2f(P[row * INW + COL_G + h * 128 + e]);
        mix[row * DM + h * 128 + e] = (bf16_t)f2bf(silu(g) * ((o[j] - mu) * rs * p.ret_gn_w[l * 1024 + h * 128 + e])); }
}
__global__ void __launch_bounds__(256) nv_gmlp(Ptrs p, int l) {
    extern __shared__ float sm[];
    float* vn = sm;
    const bf16_t* P = (const bf16_t*)(p.ws + WS_P);
    const int nb = blockIdx.x, g = blockIdx.y, b = blockIdx.z, tid = threadIdx.x;
    const int row0 = b * SEQ + nb * 128;
    { const int s = tid >> 1, half = tid & 1; float v[64]; float sum = 0.f;
#pragma unroll
      for (int j = 0; j < 64; ++j) { v[j] = bf2f(P[(size_t)(row0 + s) * INW + COL_VS + g * 128 + half * 64 + j]); sum += v[j]; }
      sum += __shfl_xor(sum, 1); const float mu = sum * (1.0f / 128.0f); float q = 0.f;
#pragma unroll
      for (int j = 0; j < 64; ++j) { const float d = v[j] - mu; q += d * d; }
      q += __shfl_xor(q, 1); const float rs = 1.0f / sqrtf(q * (1.0f / 128.0f) + EPS);
#pragma unroll
      for (int j = 0; j < 64; ++j) vn[s * 129 + half * 64 + j] = (v[j] - mu) * rs * p.gmlp_norm_w[l * 1024 + g * 128 + half * 64 + j]; }
    __syncthreads();
    const int t = tid >> 1, half = tid & 1;
    float z[64];
#pragma unroll
    for (int j = 0; j < 64; ++j) z[j] = 0.f;
    const float* W = p.w_s + (((size_t)l * GG + g) * 128 + t) * 128;
    const int smax = (t < 64) ? 64 : 128;
    for (int s = 0; s < smax; ++s) { const float w = W[s];
#pragma unroll
        for (int j = 0; j < 64; ++j) z[j] += w * vn[s * 129 + half * 64 + j]; }
    const float bs = p.b_s[((size_t)l * GG + g) * 128 + t];
    const size_t row = (size_t)(row0 + t);
    bf16_t* mix = (bf16_t*)(p.ws + WS_MIX);
#pragma unroll
    for (int j = 0; j < 64; ++j) { const int c = g * 128 + half * 64 + j;
        mix[row * DM + 1024 + c] = (bf16_t)f2bf(bf2f(P[row * INW + COL_U + c]) * (z[j] + bs)); }
}
template <class LP>
__device__ __forceinline__ void route_token(LP lg  , int& e0, int& e1, float& w0, float& w1) {
    int gs = 0; float gm = lg[0];
#pragma unroll
    for (int j = 1; j < NGRP; ++j) { const float v = lg[j]; if (v > gm) { gm = v; gs = j; } }
    float den = 0.f;
#pragma unroll
    for (int j = 0; j < NGRP; ++j) den += __expf(lg[j] - gm);
    const float psel = 1.0f / den;
    const int eb = 4 + 8 * gs;
    int i0 = 0; float v0 = lg[eb];
#pragma unroll
    for (int i = 1; i < EPG; ++i) { const float v = lg[eb + i]; if (v > v0) { v0 = v; i0 = i; } }
    int i1 = -1; float v1 = -3.0e38f;
#pragma unroll
    for (int i = 0; i < EPG; ++i) { const float v = lg[eb + i]; if (i != i0 && v > v1) { v1 = v; i1 = i; } }
    const float a = 1.0f / (1.0f + __expf(v1 - v0));
    e0 = gs * 8 + i0; e1 = gs * 8 + i1; w0 = a * psel; w1 = (1.0f - a) * psel;
}
__global__ void __launch_bounds__(256) nv_r2(Ptrs p, int l) {
    __shared__ float red[8][40]; __shared__ float lgs[40];
    unsigned* ctl = (unsigned*)(p.ws + WS_CTL);
    const int row = blockIdx.x, tid = threadIdx.x, lane = tid & 63, w = tid >> 6;
    const float* xr = (const float*)(p.ws + WS_X1) + (size_t)row * DM;
    float v[8]; float s = 0.f;
#pragma unroll
    for (int j = 0; j < 8; ++j) { v[j] = xr[tid + 256 * j]; s += v[j] * v[j]; }
    bf16_t* hb = (bf16_t*)(p.ws + WS_H2B) + (size_t)row * DM;
#pragma unroll
    for (int j = 0; j < 8; ++j) hb[tid + 256 * j] = (bf16_t)f2bf(v[j]);
    s = wave_sum(s); if (lane == 0) red[w][36] = s;
    float part[36];
#pragma unroll
    for (int o = 0; o < 36; ++o) part[o] = 0.f;
#pragma unroll
    for (int j = 0; j < 8; ++j) { const int k = tid + 256 * j; const float a = v[j] * p.norm2_w[l * DM + k];
#pragma unroll
        for (int o = 0; o < 4; ++o) part[o] += a * p.rg_w[((size_t)l * DM + k) * NGRP + o];
#pragma unroll
        for (int o = 0; o < 32; ++o) part[4 + o] += a * p.re_w[((size_t)l * DM + k) * NE + o]; }
#pragma unroll
    for (int o = 0; o < 36; ++o) { const float t = wave_sum(part[o]); if (lane == 0) red[w][o] = t; }
    __syncthreads();
    if (tid < 37) lgs[tid] = red[0][tid] + red[1][tid] + red[2][tid] + red[3][tid];
    __syncthreads();
    const float rstd = 1.0f / sqrtf(lgs[36] * (1.0f / DM) + EPS);
    __syncthreads();
    if (tid < 36) lgs[tid] = lgs[tid] * rstd + (tid < 4 ? p.rg_b[l * NGRP + tid] : p.re_b[l * NE + tid - 4]);
    __syncthreads();
    if (tid == 0) {
        int e0, e1; float w0, w1; route_token((const float*)lgs, e0, e1, w0, w1);
        const int s0 = (int)atomicAdd(&ctl[CW_CNT + (l * NE + e0) * 16], 1u), s1 = (int)atomicAdd(&ctl[CW_CNT + (l * NE + e1) * 16], 1u);
        int* tok = (int*)(p.ws + WS_TOK); float* rse = (float*)(p.ws + WS_RSE);
        tok[(size_t)e0 * NTOK + s0] = row; rse[(size_t)e0 * NTOK + s0] = rstd; tok[(size_t)e1 * NTOK + s1] = row; rse[(size_t)e1 * NTOK + s1] = rstd;
        Rec r; r.e0 = e0; r.s0 = s0; r.w0 = w0; r.e1 = e1; r.s1 = s1; r.w1 = w1; r.pad0 = 0; r.pad1 = 0;
        ((Rec*)(p.ws + WS_REC))[row] = r;
    }
}

#define XB_TMO      128
#define XB_XCNT(j)  (256  + 64 * (j))
#define XB_XSUB(j)  (1280 + 64 * (j))
#define XB_XGEN(j)  (2304 + 64 * (j))
#define XB_TOP      3328
#define XB_TOPGEN   3392
#define XCD_BAR_WORDS 3456
#define XB_SPIN_CAP (1u << 18)

__device__ __forceinline__ unsigned xb_ld(unsigned* p)              { return __hip_atomic_load(p, __ATOMIC_RELAXED, __HIP_MEMORY_SCOPE_AGENT); }
__device__ __forceinline__ unsigned xb_add(unsigned* p, unsigned v) { return __hip_atomic_fetch_add(p, v, __ATOMIC_RELAXED, __HIP_MEMORY_SCOPE_AGENT); }
__device__ __forceinline__ unsigned xb_xcc_id() { return (unsigned)__builtin_amdgcn_s_getreg((3 << 11) | 20) & 0xFu; }
#define XB_SPIN(cond, bar) do { unsigned _sp = 0; while (cond) { __builtin_amdgcn_s_sleep(1); \
    if ((++_sp & 255u) == 0u) { if (xb_ld(&(bar)[XB_TMO])) break; if (_sp > XB_SPIN_CAP) { atomicAdd(&(bar)[XB_TMO], 1u); break; } } } } while (0)

struct XcdBarrier {
    unsigned* bar; unsigned x;
    volatile LAS unsigned* st;
};

__device__ __forceinline__ XcdBarrier xcd_barrier_post(unsigned* bar, volatile LAS unsigned* st) {
    XcdBarrier b; b.bar = bar; b.x = xb_xcc_id(); b.st = st;
    if (threadIdx.x == 0) (void)xb_add(&bar[XB_XCNT(b.x)], 1u);
    return b;
}
__device__ __forceinline__ void xcd_barrier_complete(unsigned* bar, unsigned x, unsigned& nloc, unsigned& nx) {
    const unsigned G = gridDim.x * gridDim.y * gridDim.z;
    unsigned sum, cnt, mine, sp = 0u;
    for (;;) {
        sum = 0u; cnt = 0u; mine = 0u;
#pragma unroll
        for (unsigned j = 0; j < 16; ++j) { const unsigned c = xb_ld(&bar[XB_XCNT(j)]); sum += c; cnt += (c > 0u) ? 1u : 0u; mine = (j == x) ? c : mine; }
        if (sum == G) break;
        __builtin_amdgcn_s_sleep(1);
        if ((++sp & 255u) == 0u) { if (xb_ld(&bar[XB_TMO])) break; if (sp > XB_SPIN_CAP) { atomicAdd(&bar[XB_TMO], 1u); break; } }
    }
    nloc = mine > 0u ? mine : 1u; nx = cnt > 0u ? cnt : 1u;
}

__device__ __forceinline__ void xcd_barrier(const XcdBarrier& b) {
    asm volatile("s_waitcnt vmcnt(0)" ::: "memory");
    __syncthreads();
    if (threadIdx.x == 0) {
        unsigned* bar = b.bar;
        __builtin_amdgcn_s_waitcnt(0);
        unsigned nloc = b.st[0], nx = b.st[1];
        if (nloc == 0u) { xcd_barrier_complete(bar, b.x, nloc, nx); b.st[0] = nloc; b.st[1] = nx; }
        const unsigned old = xb_add(&bar[XB_XSUB(b.x)], 1u);
        const unsigned gen = old / nloc;
        if (old + 1u == (gen + 1u) * nloc) {
            __builtin_amdgcn_fence(__ATOMIC_RELEASE, "agent");
            asm volatile("s_waitcnt vmcnt(0)" ::: "memory");
            const unsigned og = xb_add(&bar[XB_TOP], 1u);
            const unsigned tg = og / nx;
            if (og + 1u == (tg + 1u) * nx) xb_add(&bar[XB_TOPGEN], 1u);
            else XB_SPIN(xb_ld(&bar[XB_TOPGEN]) == tg, bar);
            __builtin_amdgcn_fence(__ATOMIC_ACQUIRE, "agent");
            xb_add(&bar[XB_XGEN(b.x)], 1u);
            asm volatile("s_waitcnt vmcnt(0)" ::: "memory");
        } else {
            XB_SPIN(xb_ld(&bar[XB_XGEN(b.x)]) == gen, bar);
            __builtin_amdgcn_fence(__ATOMIC_ACQUIRE, "agent");
            asm volatile("s_waitcnt vmcnt(0)" ::: "memory");
        }
    }
    __syncthreads();
}

__device__ __forceinline__ int hidden_tid() { int t = threadIdx.x; asm volatile("" : "+v"(t)); return t; }
__device__ __forceinline__ void unpack8(const u32x4 v, float (&f)[8]) { f[0] = bf2f(v.x & 0xffffu); f[1] = bf2f(v.x >> 16); f[2] = bf2f(v.y & 0xffffu); f[3] = bf2f(v.y >> 16); f[4] = bf2f(v.z & 0xffffu); f[5] = bf2f(v.z >> 16); f[6] = bf2f(v.w & 0xffffu); f[7] = bf2f(v.w >> 16); }
__device__ __forceinline__ u32x4 pack8(const float (&f)[8]) { u32x4 w; w.x = pk2(f[0], f[1]); w.y = pk2(f[2], f[3]); w.z = pk2(f[4], f[5]); w.w = pk2(f[6], f[7]); return w; }
__device__ __forceinline__ void unpack8_fp8(const u32x2 v, float (&f)[8]) {
    const f32x2 a = __builtin_amdgcn_cvt_pk_f32_fp8((int)v.x, false), b = __builtin_amdgcn_cvt_pk_f32_fp8((int)v.x, true), c = __builtin_amdgcn_cvt_pk_f32_fp8((int)v.y, false), d = __builtin_amdgcn_cvt_pk_f32_fp8((int)v.y, true);
    f[0] = a.x; f[1] = a.y; f[2] = b.x; f[3] = b.y; f[4] = c.x; f[5] = c.y; f[6] = d.x; f[7] = d.y; }
constexpr int LDS_STAGE = 0;
constexpr int LDS_TAB = 131072;
constexpr int LDS_UL = LDS_TAB + 8192;
constexpr int LDS_EB = LDS_UL + 256;
constexpr int LDS_MISC = LDS_EB + 256;
constexpr int LDS_BYTES = 147456;
constexpr int NWAVES = 8;

__device__ __forceinline__ unsigned cvt_pk_bf16(float lo, float hi) { unsigned r; asm volatile("v_cvt_pk_bf16_f32 %0, %1, %2" : "=v"(r) : "v"(lo), "v"(hi)); return r; }

#ifndef FP8MOE
#define FP8MOE 1
#endif
typedef int i32x8 __attribute__((ext_vector_type(8)));
typedef int i32x4 __attribute__((ext_vector_type(4)));
__device__ __forceinline__ unsigned pk4_fp8(float a, float b, float c, float d) { int w = 0; w = __builtin_amdgcn_cvt_pk_fp8_f32(a, b, w, false); w = __builtin_amdgcn_cvt_pk_fp8_f32(c, d, w, true); return (unsigned)w; }
namespace pg8 {
constexpr int BM = 256, BK = 64, HALF = 128, HTB = HALF * BK * 2, STAGE_BYTES = 8 * HTB, NXCD = 8, WGM = 8;
__host__ __device__ __forceinline__ int lds_byte(int r, int c) { const int st = (r >> 4) * 2 + (c >> 5), rr = r & 15, cc = c & 31, ob = rr * 64 + cc * 2; return st * 1024 + (ob ^ (((ob >> 9) & 1) << 5)); }
__host__ __device__ __forceinline__ void stage_rc(int b, int& R, int& C) { const int st = b / 1024, sb = b % 1024, swz = sb ^ (((sb >> 9) & 1) << 5); R = (st >> 1) * 16 + swz / 64; C = (st & 1) * 32 + (swz % 64) / 2; }
__host__ __device__ __forceinline__ int perm32(int rho) { const int n = rho >> 4, i = rho & 15; return 8 * (i >> 2) + 4 * n + (i & 3); }

struct Unit { int pm, pn, e, pnl; };

struct DenseOrder {
    int nM, nN, nwg, G, c;
    __device__ void init(int M, int N, int G_, int c_) { nM = M / BM; nN = N / BM; nwg = nM * nN; G = G_; c = c_; }
    __device__ __forceinline__ bool next(int i, Unit& u) const {
        const long L = (long)i * G + c; if (L >= nwg) return false;
        int wgid = (int)L; { const int q = nwg / NXCD, r = nwg % NXCD, xcd = wgid % NXCD, off = wgid / NXCD; wgid = (xcd < r ? xcd * (q + 1) : r * (q + 1) + (xcd - r) * q) + off; }
        const int nig = WGM * nN, gid = wgid / nig, fm = gid * WGM, gsz = (nM - fm) < WGM ? (nM - fm) : WGM;
        u.pm = fm + ((wgid % nig) % gsz); u.pn = (wgid % nig) / gsz; u.e = 0; u.pnl = u.pn; return true;
    }
    __device__ __forceinline__ int arow(int, const Unit& u, int r) const { return u.pm * BM + r; }
};
template <bool GATHER> struct MoeOrder {
    const LAS int* ul; const LAS int* tab; int nu;
    __device__ __forceinline__ bool next(int i, Unit& u) const {
        if (i >= nu) return false;
        u.pm = __builtin_amdgcn_readfirstlane(ul[4 * i + 0]); u.pn = __builtin_amdgcn_readfirstlane(ul[4 * i + 1]);
        u.e = __builtin_amdgcn_readfirstlane(ul[4 * i + 2]); u.pnl = __builtin_amdgcn_readfirstlane(ul[4 * i + 3]); return true;
    }
    __device__ __forceinline__ int arow(int ui, const Unit& u, int r) const { return GATHER ? tab[ui * 256 + r] : u.pm * BM + r; }
};

template <bool FP8, class Epi, class Sched>
__device__ __forceinline__ void gemm_phase(LAS unsigned char* lds, const bf16_t* A, const bf16_t* Bt, const int K, const Sched& S, const Epi& E) {
    const int tid = hidden_tid(), wid = __builtin_amdgcn_readfirstlane(tid >> 6), lane = tid & 63, wr = wid >> 2, wc = wid & 3, fr = lane & 15, fq = lane >> 4;
    const int nt = K / BK;
    unsigned voffB[2];
#pragma unroll
    for (int i = 0; i < 2; ++i) { int R_, C_; stage_rc(tid * 16 + i * 8192, R_, C_); const int Rb = Epi::PERM ? ((R_ & ~31) + perm32(R_ & 31)) : R_; voffB[i] = (unsigned)(Rb * K + C_) * 2u; }
    const size_t kstep = (size_t)(BK * 2);
    const size_t hstep = (size_t)HALF * K * 2;
    const size_t tstep = 2 * hstep;
    const unsigned ldsw = (unsigned)wid * 1024u;
    const int aoff = lds_byte(wr * 64 + fr, fq * 8), boff = lds_byte(wc * 32 + fr, fq * 8);
#define PG8_SA(b, h) (((b) * 2 + (h)) * HTB)
#define PG8_SB(b, h) ((4 + (b) * 2 + (h)) * HTB)
#define PG8_STAGE(bufoff, gbase, voff) do { _Pragma("unroll") for (int _i = 0; _i < 2; ++_i) \
        __builtin_amdgcn_global_load_lds((const unsigned*)((const char*)(gbase) + (voff)[_i]), (LAS unsigned*)(lds + (bufoff) + ldsw + _i * 8192), 16, 0, 0); } while (0)
#define PG8_LDA(dst, b, h) do { _Pragma("unroll") for (int m = 0; m < 4; ++m) _Pragma("unroll") for (int k = 0; k < 2; ++k) dst[m][k] = *(const LAS bf16x8*)(lds + PG8_SA(b, h) + aoff + m * 2048 + k * 1024); } while (0)
#define PG8_LDB(dst, b, h) do { _Pragma("unroll") for (int n = 0; n < 2; ++n) _Pragma("unroll") for (int k = 0; k < 2; ++k) dst[n][k] = *(const LAS bf16x8*)(lds + PG8_SB(b, h) + boff + n * 2048 + k * 1024); } while (0)
#define PG8_CAT(x0, x1) __builtin_shufflevector(__builtin_bit_cast(i32x4, x0), __builtin_bit_cast(i32x4, x1), 0, 1, 2, 3, 4, 5, 6, 7)
#define PG8_MMA(ai, bj, At, Bt_) do { __builtin_amdgcn_s_setprio(1); _Pragma("unroll") for (int m = 0; m < 4; ++m) _Pragma("unroll") for (int n = 0; n < 2; ++n) { \
        if constexpr (FP8) acc[ai][bj][m][n] = __builtin_amdgcn_mfma_scale_f32_16x16x128_f8f6f4(PG8_CAT(Bt_[n][0], Bt_[n][1]), PG8_CAT(At[m][0], At[m][1]), acc[ai][bj][m][n], 0, 0, 0, 0x7f7f7f7f, 0, 0x7f7f7f7f); \
        else { _Pragma("unroll") for (int k = 0; k < 2; ++k) acc[ai][bj][m][n] = __builtin_amdgcn_mfma_f32_16x16x32_bf16(Bt_[n][k], At[m][k], acc[ai][bj][m][n], 0, 0, 0); } } \
        __builtin_amdgcn_s_setprio(0); } while (0)
#define PG8_WAIT_V(n) asm volatile("s_waitcnt vmcnt(" #n ")" ::: "memory")
#define PG8_WAIT_L(n) asm volatile("s_waitcnt lgkmcnt(" #n ")" ::: "memory")
#define PG8_BAR __builtin_amdgcn_s_barrier()
#define PG8_SCHED __builtin_amdgcn_sched_barrier(0)
#define PG8_AOFF(dst, ui_, u_, h) do { int _tz = threadIdx.x; asm volatile("" : "+v"(_tz)); _Pragma("unroll") for (int _i = 0; _i < 2; ++_i) { int _R, _C; stage_rc(_tz * 16 + _i * 8192, _R, _C); \
        dst[_i] = (unsigned)(S.arow(ui_, u_, (h) * HALF + _R) * K + _C) * 2u; } } while (0)
    Unit cur, nxt; int ui = 0;
    if (!S.next(0, cur)) return;
    f32x4 acc[2][2][4][2];
#pragma unroll
    for (int a = 0; a < 2; ++a)
#pragma unroll
        for (int b = 0; b < 2; ++b)
#pragma unroll
            for (int m = 0; m < 4; ++m)
#pragma unroll
                for (int n = 0; n < 2; ++n) acc[a][b][m][n] = (f32x4){0.f, 0.f, 0.f, 0.f};
    bf16x8 At[4][2], B0[2][2], B1[2][2];
    unsigned vA0[2], vA1[2];
    PG8_AOFF(vA0, 0, cur, 0); PG8_AOFF(vA1, 0, cur, 1);
    const char* cA = (const char*)A; const char* cB = (const char*)Bt + (size_t)cur.pn * tstep;
    PG8_STAGE(PG8_SB(0, 0), cB, voffB); PG8_STAGE(PG8_SB(0, 1), cB + hstep, voffB); PG8_STAGE(PG8_SA(0, 0), cA, vA0); PG8_STAGE(PG8_SA(0, 1), cA, vA1);
    if (wr == 1) PG8_BAR;
    PG8_WAIT_V(2); PG8_BAR;
    PG8_STAGE(PG8_SB(1, 0), cB + kstep, voffB); PG8_STAGE(PG8_SA(1, 0), cA + kstep, vA0); PG8_STAGE(PG8_SB(1, 1), cB + hstep + kstep, voffB);
    PG8_WAIT_V(6); PG8_BAR;
    for (;;) {
        const bool has_next = S.next(ui + 1, nxt);
        const char* nB = has_next ? (const char*)Bt + (size_t)nxt.pn * tstep : cB;
        for (int t = 0; t < nt; t += 2) {
            const bool last = (t == nt - 2);
            const char* a1 = cA + (size_t)(t + 1) * kstep;
            const char* a2 = last ? cA : cA + (size_t)(t + 2) * kstep; const char* b2 = last ? nB : cB + (size_t)(t + 2) * kstep;
            const char* a3 = a2 + kstep; const char* b3 = b2 + kstep;
            if (last && has_next) { PG8_AOFF(vA0, ui + 1, nxt, 0); }
            PG8_LDB(B0, 0, 0); PG8_LDB(B1, 0, 1); PG8_SCHED; PG8_LDA(At, 0, 0); PG8_STAGE(PG8_SA(1, 1), a1, vA1);
            PG8_WAIT_V(8); PG8_WAIT_L(0); PG8_BAR; PG8_MMA(0, 0, At, B0); PG8_MMA(0, 1, At, B1); PG8_BAR; PG8_SCHED;
            if (last && has_next) { PG8_AOFF(vA1, ui + 1, nxt, 1); }
            PG8_LDA(At, 0, 1); PG8_STAGE(PG8_SB(0, 0), b2, voffB); PG8_STAGE(PG8_SB(0, 1), b2 + hstep, voffB); PG8_STAGE(PG8_SA(0, 0), a2, vA0);
            PG8_WAIT_V(8); PG8_WAIT_L(0); PG8_BAR; PG8_MMA(1, 0, At, B0); PG8_MMA(1, 1, At, B1); PG8_BAR; PG8_SCHED;
            PG8_LDB(B0, 1, 0); PG8_LDB(B1, 1, 1); PG8_SCHED; PG8_LDA(At, 1, 0); PG8_STAGE(PG8_SA(0, 1), a2, vA1);
            PG8_WAIT_V(8); PG8_WAIT_L(0); PG8_BAR; PG8_MMA(0, 0, At, B0); PG8_MMA(0, 1, At, B1); PG8_BAR; PG8_SCHED;
            PG8_LDA(At, 1, 1); PG8_STAGE(PG8_SB(1, 0), b3, voffB); PG8_STAGE(PG8_SB(1, 1), b3 + hstep, voffB); PG8_STAGE(PG8_SA(1, 0), a3, vA0);
            PG8_WAIT_V(8); PG8_WAIT_L(0); PG8_BAR; PG8_MMA(1, 0, At, B0); PG8_MMA(1, 1, At, B1); PG8_BAR; PG8_SCHED;
        }
        if (wr == 0) PG8_BAR;
        E(acc, cur, wr, wc, fr, fq);
        if (!has_next) break;
#pragma unroll
        for (int a = 0; a < 2; ++a)
#pragma unroll
            for (int b = 0; b < 2; ++b)
#pragma unroll
                for (int m = 0; m < 4; ++m)
#pragma unroll
                    for (int n = 0; n < 2; ++n) acc[a][b][m][n] = (f32x4){0.f, 0.f, 0.f, 0.f};
        cur = nxt; cB = nB; ++ui;
        if (wr == 1) PG8_BAR;
    }
    PG8_WAIT_V(0);
    PG8_BAR;
#undef PG8_SA
#undef PG8_SB
#undef PG8_STAGE
#undef PG8_LDA
#undef PG8_LDB
#undef PG8_MMA
#undef PG8_CAT
#undef PG8_WAIT_V
#undef PG8_WAIT_L
#undef PG8_BAR
#undef PG8_SCHED
#undef PG8_AOFF
}

struct EpiG1 {
    static constexpr bool PERM = true;
    bf16_t* P; const float* cosT; const float* sinT; int skip;
    __device__ __forceinline__ void operator()(const f32x4 (&acc)[2][2][4][2], const Unit& u, int wr, int wc, int fr, int fq) const {
        const int row0 = u.pm * BM + wr * 64 + fr;
#ifdef PROBE_NULL_EPI
        if (skip) return;
#endif
        if (u.pn < 8) {
            const int i0 = (32 * wc + 8 * fq) & 63, hl = wc >> 1, colb = u.pn * 256 + hl * 128 + i0;
#pragma unroll
            for (int ai = 0; ai < 2; ++ai) {
                f32x4 cs[4][4];
#pragma unroll
                for (int m = 0; m < 4; ++m) { const int pos = (row0 + ai * HALF + m * 16) & (SEQ - 1);
                    cs[m][0] = *(const f32x4*)(cosT + pos * 64 + i0); cs[m][1] = *(const f32x4*)(cosT + pos * 64 + i0 + 4); cs[m][2] = *(const f32x4*)(sinT + pos * 64 + i0); cs[m][3] = *(const f32x4*)(sinT + pos * 64 + i0 + 4); }
                asm volatile("" ::: "memory");
#pragma unroll
                for (int m = 0; m < 4; ++m) { const int row = row0 + ai * HALF + m * 16;
                    const f32x4 c0 = cs[m][0], c1 = cs[m][1], s0 = cs[m][2], s1 = cs[m][3];
                    const f32x4 a0 = acc[ai][0][m][0], a1 = acc[ai][0][m][1], b0 = acc[ai][1][m][0], b1 = acc[ai][1][m][1];
                    const f32x4 o10 = a0 * c0 - b0 * s0, o11 = a1 * c1 - b1 * s1, o20 = a0 * s0 + b0 * c0, o21 = a1 * s1 + b1 * c1;
                    u32x4 w1, w2; w1.x = cvt_pk_bf16(o10[0], o10[1]); w1.y = cvt_pk_bf16(o10[2], o10[3]); w1.z = cvt_pk_bf16(o11[0], o11[1]); w1.w = cvt_pk_bf16(o11[2], o11[3]);
                    w2.x = cvt_pk_bf16(o20[0], o20[1]); w2.y = cvt_pk_bf16(o20[2], o20[3]); w2.z = cvt_pk_bf16(o21[0], o21[1]); w2.w = cvt_pk_bf16(o21[2], o21[3]);
                    bf16_t* rp = P + (size_t)row * INW + colb; *(u32x4*)rp = w1; *(u32x4*)(rp + 64) = w2; }
                asm volatile("" ::: "memory");
            }
        } else {
            const bool act = (u.pn >= 16);
            const int colb = u.pn * 256 + wc * 32 + 8 * fq;
#pragma unroll
            for (int ai = 0; ai < 2; ++ai)
#pragma unroll
                for (int m = 0; m < 4; ++m) { bf16_t* rp = P + (size_t)(row0 + ai * HALF + m * 16) * INW + colb;
#pragma unroll
                    for (int bj = 0; bj < 2; ++bj) { f32x4 v0 = acc[ai][bj][m][0], v1 = acc[ai][bj][m][1];
                        if (act) {
#pragma unroll
                            for (int j = 0; j < 4; ++j) { v0[j] = gelu_tanh(v0[j]); v1[j] = gelu_tanh(v1[j]); } }
                        u32x4 w; w.x = cvt_pk_bf16(v0[0], v0[1]); w.y = cvt_pk_bf16(v0[2], v0[3]); w.z = cvt_pk_bf16(v1[0], v1[1]); w.w = cvt_pk_bf16(v1[2], v1[3]);
                        *(u32x4*)(rp + bj * HALF) = w; } }
        }
    }
};
struct EpiNull {
    static constexpr bool PERM = true;
    __device__ __forceinline__ void operator()(const f32x4 (&acc)[2][2][4][2], const Unit& u, int wr, int wc, int fr, int fq) const {
#pragma unroll
        for (int ai = 0; ai < 2; ++ai)
#pragma unroll
            for (int bj = 0; bj < 2; ++bj)
#pragma unroll
                for (int m = 0; m < 4; ++m)
#pragma unroll
                    for (int n = 0; n < 2; ++n) asm volatile("" :: "v"(acc[ai][bj][m][n]));
    }
};
struct EpiG2 {
    static constexpr bool PERM = true;
    const bf16_t* xin; bf16_t* x1;
    __device__ __forceinline__ void operator()(const f32x4 (&acc)[2][2][4][2], const Unit& u, int wr, int wc, int fr, int fq) const {
        const int row0 = u.pm * BM + wr * 64 + fr, col0 = u.pn * BM + wc * 32 + 8 * fq;
        u32x4 xv[2][4][2];
#pragma unroll
        for (int ai = 0; ai < 2; ++ai)
#pragma unroll
            for (int m = 0; m < 4; ++m) { const size_t off = (size_t)(row0 + ai * HALF + m * 16) * DM + col0;
#pragma unroll
                for (int bj = 0; bj < 2; ++bj) xv[ai][m][bj] = *(const u32x4*)(xin + off + bj * HALF); }
        asm volatile("" ::: "memory");
#pragma unroll
        for (int ai = 0; ai < 2; ++ai)
#pragma unroll
            for (int m = 0; m < 4; ++m) { const size_t off = (size_t)(row0 + ai * HALF + m * 16) * DM + col0;
#pragma unroll
                for (int bj = 0; bj < 2; ++bj) { const u32x4 x = xv[ai][m][bj]; const f32x4 a0 = acc[ai][bj][m][0], a1 = acc[ai][bj][m][1];
                    u32x4 w; w.x = cvt_pk_bf16(bf2f(x.x & 0xffffu) + a0[0], bf2f(x.x >> 16) + a0[1]); w.y = cvt_pk_bf16(bf2f(x.y & 0xffffu) + a0[2], bf2f(x.y >> 16) + a0[3]);
                    w.z = cvt_pk_bf16(bf2f(x.z & 0xffffu) + a1[0], bf2f(x.z >> 16) + a1[1]); w.w = cvt_pk_bf16(bf2f(x.w & 0xffffu) + a1[2], bf2f(x.w >> 16) + a1[3]);
                    *(u32x4*)(x1 + off + bj * HALF) = w; } }
    }
};
struct EpiG3 {
    static constexpr bool PERM = true;
    bf16_t* he; const float* rse; const LAS int* etb;
    __device__ __forceinline__ void operator()(const f32x4 (&acc)[2][2][4][2], const Unit& u, int wr, int wc, int fr, int fq) const {
        const int rl0 = wr * 64 + fr, mt = u.pm - etb[u.e];
        const float* rsp = rse + (size_t)u.e * NTOK + mt * 256;
        const int colb = u.pnl * 128 + wc * 32 + 8 * fq;
        float rsv[2][4];
#pragma unroll
        for (int ai = 0; ai < 2; ++ai)
#pragma unroll
            for (int m = 0; m < 4; ++m) rsv[ai][m] = rsp[rl0 + ai * HALF + m * 16];
        asm volatile("" ::: "memory");
#pragma unroll
        for (int ai = 0; ai < 2; ++ai)
#pragma unroll
            for (int m = 0; m < 4; ++m) { const int rl = rl0 + ai * HALF + m * 16; const float rs = rsv[ai][m] * (FP8MOE ? (1.0f / 256.0f) : 1.0f);
                const f32x4 g0 = acc[ai][0][m][0] * rs, g1 = acc[ai][0][m][1] * rs, u0 = acc[ai][1][m][0] * rs, u1 = acc[ai][1][m][1] * rs;
                f32x4 h0, h1;
#pragma unroll
                for (int j = 0; j < 4; ++j) { h0[j] = silu(g0[j]) * u0[j]; h1[j] = silu(g1[j]) * u1[j]; }
                if (FP8MOE) { u32x2 w; w.x = pk4_fp8(h0[0] * 16.f, h0[1] * 16.f, h0[2] * 16.f, h0[3] * 16.f); w.y = pk4_fp8(h1[0] * 16.f, h1[1] * 16.f, h1[2] * 16.f, h1[3] * 16.f);
                    *(u32x2*)((unsigned char*)he + (size_t)(u.pm * BM + rl) * DE + colb) = w; }
                else { u32x4 w; w.x = cvt_pk_bf16(h0[0], h0[1]); w.y = cvt_pk_bf16(h0[2], h0[3]); w.z = cvt_pk_bf16(h1[0], h1[1]); w.w = cvt_pk_bf16(h1[2], h1[3]);
                    *(u32x4*)(he + (size_t)(u.pm * BM + rl) * DE + colb) = w; } }
    }
};
struct EpiG4 {
    static constexpr bool PERM = true;
    bf16_t* y;
    __device__ __forceinline__ void operator()(const f32x4 (&acc)[2][2][4][2], const Unit& u, int wr, int wc, int fr, int fq) const {
        const int row0 = u.pm * BM + wr * 64 + fr, colb = u.pnl * 256 + wc * 32 + 8 * fq;
#pragma unroll
        for (int ai = 0; ai < 2; ++ai)
#pragma unroll
            for (int m = 0; m < 4; ++m) {
#pragma unroll
                for (int bj = 0; bj < 2; ++bj) {
                    if (FP8MOE) { const f32x4 v0 = acc[ai][bj][m][0] * (1.0f / 256.0f), v1 = acc[ai][bj][m][1] * (1.0f / 256.0f);
                        u32x2 w; w.x = pk4_fp8(v0[0], v0[1], v0[2], v0[3]); w.y = pk4_fp8(v1[0], v1[1], v1[2], v1[3]);
                        *(u32x2*)((unsigned char*)y + (size_t)(row0 + ai * HALF + m * 16) * DM + colb + bj * HALF) = w; }
                    else { const f32x4 v0 = acc[ai][bj][m][0], v1 = acc[ai][bj][m][1];
                        u32x4 w; w.x = cvt_pk_bf16(v0[0], v0[1]); w.y = cvt_pk_bf16(v0[2], v0[3]); w.z = cvt_pk_bf16(v1[0], v1[1]); w.w = cvt_pk_bf16(v1[2], v1[3]);
                        *(u32x4*)(y + (size_t)(row0 + ai * HALF + m * 16) * DM + colb + bj * HALF) = w; } } }
    }
};
}

__device__ __forceinline__ int moe_units(const unsigned* ctl, int l, LAS unsigned char* lds, bool gather, const int* tokg) {
    LAS int* etb = (LAS int*)(lds + LDS_EB); LAS int* ul = (LAS int*)(lds + LDS_UL); LAS int* tab = (LAS int*)(lds + LDS_TAB);
    LAS int* nup = (LAS int*)(lds + LDS_UL + 192);
    const int tid = hidden_tid(), G = gridDim.x;
    __syncthreads();
    if (tid == 0) { int acc = 0; for (int e = 0; e < NE; ++e) { etb[e] = acc; acc += ((int)ctl[CW_CNT + (l * NE + e) * 16] + 255) >> 8; } etb[NE] = acc; }
    __syncthreads();
    const int T = etb[NE];
    const int nx = (G % 8 == 0) ? 8 : 1, x = (int)blockIdx.x % nx, rank = (int)blockIdx.x / nx, nrank = G / nx;
    const int lo = (int)((long)x * T / nx), hi = (int)((long)(x + 1) * T / nx), nun = (hi - lo) * 8;
    int nu = 0; for (int v = rank; v < nun && nu < 8; v += nrank) ++nu;
    if (tid < nu) { const int v = rank + tid * nrank, mtg = lo + (v >> 3), pnl = v & 7; int e = 0; while (etb[e + 1] <= mtg) ++e;
        ul[4 * tid + 0] = mtg; ul[4 * tid + 1] = e * 8 + pnl; ul[4 * tid + 2] = e; ul[4 * tid + 3] = pnl; }
    if (tid == 0) nup[0] = nu;
    __syncthreads();
    if (gather) {
        for (int idx = tid; idx < nu * 256; idx += 512) { const int i = idx >> 8, r = idx & 255; const int mtg = ul[4 * i + 0], e = ul[4 * i + 2], mt = mtg - etb[e]; const int cnt = (int)ctl[CW_CNT + (l * NE + e) * 16];
            int s = mt * 256 + r; if (s >= cnt) s = cnt - 1; tab[idx] = tokg[(size_t)e * NTOK + s]; }
        __syncthreads();
    }
    return nu;
}

struct CvItem { const float* sa; const float* sb; const float* ks; unsigned char* dst; int o0, o1, o2, o3, ld, K, k0, f8; float cmul; };
constexpr int IT_WIN = NL * 32 * 24, IT_WOUT = NL * 32 * 8, IT_WGU = NL * NE * 32 * 8, IT_WD = NL * NE * 16 * 8, IT_ALL = IT_WIN + IT_WOUT + IT_WGU + IT_WD;
__device__ __forceinline__ void cv_decode(const Ptrs& p, int it, CvItem& c) {
    int r = it;
    if (r < IT_WIN) { const int l = r / (32 * 24), q = r % (32 * 24), kt = q / 24, pn = q % 24; const bool qk = pn < 8;
        c.sa = c.sb = p.w_in + (size_t)l * DM * INW + pn * 256; c.o0 = 0; c.o1 = qk ? 128 : 64; c.o2 = qk ? 64 : 128; c.o3 = 192; c.ld = INW; c.K = DM; c.k0 = kt * 64; c.f8 = 0;
        c.dst = p.ws + WS_WINT + (((size_t)l * INW + pn * 256) * DM) * 2; c.ks = p.norm1_w + l * DM; c.cmul = (pn >= 4 && pn < 8) ? 0.08838834764831845f : 1.0f;
    } else if ((r -= IT_WIN) < IT_WOUT) { const int l = r / (32 * 8), q = r % (32 * 8), kt = q / 8, pn = q % 8;
        c.sa = c.sb = p.w_out + (size_t)l * DM * DM + pn * 256; c.o0 = 0; c.o1 = 64; c.o2 = 128; c.o3 = 192; c.ld = DM; c.K = DM; c.k0 = kt * 64; c.f8 = 0;
        c.dst = p.ws + WS_WOUT + (((size_t)l * DM + pn * 256) * DM) * 2; c.ks = nullptr; c.cmul = 1.0f;
    } else if ((r -= IT_WOUT) < IT_WGU) { const int le = r / (32 * 8), q = r % (32 * 8), kt = q / 8, pn = q % 8, l = le / NE;
        c.sa = p.w_gate + (size_t)le * DM * DE + pn * 128; c.sb = p.w_up + (size_t)le * DM * DE + pn * 128; c.o0 = 0; c.o1 = 64; c.o2 = 0; c.o3 = 64; c.ld = DE; c.K = DM; c.k0 = kt * 64; c.f8 = FP8MOE;
        c.dst = p.ws + WS_WGU + (((size_t)le * 2048 + pn * 256) * DM) * (FP8MOE ? 1 : 2); c.ks = p.norm2_w + l * DM; c.cmul = FP8MOE ? 256.0f : 1.0f;
    } else { r -= IT_WGU; const int le = r / (16 * 8), q = r % (16 * 8), kt = q / 8, pn = q % 8;
        c.sa = c.sb = p.w_down + (size_t)le * DE * DM + pn * 256; c.o0 = 0; c.o1 = 64; c.o2 = 128; c.o3 = 192; c.ld = DM; c.K = DE; c.k0 = kt * 64; c.f8 = FP8MOE;
        c.dst = p.ws + WS_WD + (((size_t)le * 2048 + pn * 256) * DE) * (FP8MOE ? 1 : 2); c.ks = nullptr; c.cmul = FP8MOE ? 256.0f : 1.0f;
    }
}
__device__ __forceinline__ void cv_load(const CvItem& c, int tid, f32x4 (&v)[8], float (&sc)[8]) {
    const int lane = tid & 63, w = tid >> 6, run = lane >> 4, rc = (lane & 15) * 4;
    const float* sp = (run < 2 ? c.sa : c.sb) + (run == 0 ? c.o0 : run == 1 ? c.o1 : run == 2 ? c.o2 : c.o3) + rc;
#pragma unroll
    for (int i = 0; i < 8; ++i) { const int k = c.k0 + w + 8 * i; v[i] = *(const f32x4*)(sp + (size_t)k * c.ld); sc[i] = (c.ks ? c.ks[k] : 1.0f) * c.cmul; }
}
__device__ __forceinline__ void cv_store(const CvItem& c, LAS unsigned char* lds, int tid, const f32x4 (&v)[8], const float (&sc)[8]) {
    const int lane = tid & 63, w = tid >> 6;
    if (c.f8) {
#pragma unroll
        for (int i = 0; i < 8; ++i) { const int kk = w + 8 * i; *(LAS unsigned*)(lds + kk * 260 + lane * 4) = pk4_fp8(v[i].x * sc[i], v[i].y * sc[i], v[i].z * sc[i], v[i].w * sc[i]); }
        __syncthreads();
#pragma unroll
        for (int pss = 0; pss < 2; ++pss) { const int idx = tid + 512 * pss, tl = idx >> 2, ko = idx & 3;
            unsigned wd[4];
#pragma unroll
            for (int j = 0; j < 4; ++j) { const LAS unsigned char* bp = lds + (16 * ko + 4 * j) * 260 + tl;
                wd[j] = (unsigned)bp[0] | ((unsigned)bp[260] << 8) | ((unsigned)bp[520] << 16) | ((unsigned)bp[780] << 24); }
            u32x4 o; o.x = wd[0]; o.y = wd[1]; o.z = wd[2]; o.w = wd[3];
            *(u32x4*)(c.dst + (size_t)tl * c.K + c.k0 + 16 * ko) = o; }
    } else {
#pragma unroll
        for (int i = 0; i < 8; ++i) { const int kk = w + 8 * i; LAS unsigned* d = (LAS unsigned*)(lds + kk * 516 + lane * 8);
            d[0] = pk2(v[i].x * sc[i], v[i].y * sc[i]); d[1] = pk2(v[i].z * sc[i], v[i].w * sc[i]); }
        __syncthreads();
#pragma unroll
        for (int pss = 0; pss < 4; ++pss) { const int idx = tid + 512 * pss, tl = idx >> 3, ko = idx & 7;
            const LAS unsigned short* bp = (const LAS unsigned short*)(lds + (8 * ko) * 516 + tl * 2);
            u32x4 o; o.x = (unsigned)bp[0] | ((unsigned)bp[258] << 16); o.y = (unsigned)bp[516] | ((unsigned)bp[774] << 16); o.z = (unsigned)bp[1032] | ((unsigned)bp[1290] << 16); o.w = (unsigned)bp[1548] | ((unsigned)bp[1806] << 16);
            *(u32x4*)(c.dst + ((size_t)tl * c.K + c.k0 + 8 * ko) * 2) = o; }
    }
    __syncthreads();
}
__device__ __forceinline__ void prologue_phase(const Ptrs& p, LAS unsigned char* lds, int vcu, int G) {
    const int tid = hidden_tid();
    {
        CvItem ca, cb; f32x4 va[8], vb[8]; float sa[8], sb[8];
        int it = vcu;
        if (it < IT_ALL) { cv_decode(p, it, ca); cv_load(ca, tid, va, sa); }
        while (it < IT_ALL) {
            const int itb = it + G; const bool hb = itb < IT_ALL;
            if (hb) { cv_decode(p, itb, cb); cv_load(cb, tid, vb, sb); }
            cv_store(ca, lds, tid, va, sa);
            if (!hb) break;
            const int ita = itb + G; const bool ha = ita < IT_ALL;
            if (ha) { cv_decode(p, ita, ca); cv_load(ca, tid, va, sa); }
            cv_store(cb, lds, tid, vb, sb);
            if (!ha) break;
            it = ita;
        }
    }
    const size_t gt = (size_t)vcu * 512 + tid, gn = (size_t)G * 512;
    bf16_t* wr = (bf16_t*)(p.ws + WS_WR);
    for (size_t i = gt; i < (size_t)NL * 48 * DM; i += gn) { const int l = (int)(i / (48 * DM)), o = (int)(i / DM) % 48, k = (int)(i % DM);
        float w = 0.f; if (o < 4) w = p.rg_w[((size_t)l * DM + k) * NGRP + o]; else if (o < 36) w = p.re_w[((size_t)l * DM + k) * NE + (o - 4)];
        w *= p.norm2_w[l * DM + k];
        const unsigned hi = f2bf(w); const unsigned lo = f2bf(w - bf2f(hi));
        wr[((size_t)(l * 2 + 0) * 48 + o) * DM + k] = (bf16_t)hi; wr[((size_t)(l * 2 + 1) * 48 + o) * DM + k] = (bf16_t)lo; }
    bf16_t* wsb = (bf16_t*)(p.ws + WS_WSB);
    for (size_t i = gt; i < (size_t)NL * GG * 128 * 128; i += gn) wsb[i] = (bf16_t)f2bf(p.w_s[i]);
    float* cosT = (float*)(p.ws + WS_ROPE); float* sinT = cosT + SEQ * 64;
    for (size_t i = gt; i < (size_t)SEQ * 64; i += gn) { const int pos = (int)(i >> 6), ii = (int)(i & 63);
        const float ang = (float)pos * powf(10000.0f, -(float)ii / 64.0f); cosT[i] = cosf(ang); sinT[i] = sinf(ang); }
}

__device__ __forceinline__ void r2_phase(const Ptrs& p, int l, LAS unsigned char* lds, int G) {
    unsigned* ctl = (unsigned*)(p.ws + WS_CTL);
    const int tid = hidden_tid(), lane = tid & 63, w = __builtin_amdgcn_readfirstlane(tid >> 6), r = lane & 15, q4 = lane >> 4, tp = w >> 1, kh = w & 1;
    LAS float* lgp = (LAS float*)lds;
    LAS float* ssq = (LAS float*)(lds + 8 * 16 * 48 * 4);
    LAS int* lcnt = (LAS int*)(lds + 8 * 16 * 48 * 4 + 512);
    LAS int* gbase = lcnt + 32;
    const bf16_t* x1 = (const bf16_t*)(p.ws + WS_X1); bf16_t* h2b = (bf16_t*)(p.ws + WS_H2B);
    const bf16_t* whi = (const bf16_t*)(p.ws + WS_WR) + (size_t)(l * 2 + 0) * 48 * DM; const bf16_t* wlo = (const bf16_t*)(p.ws + WS_WR) + (size_t)(l * 2 + 1) * 48 * DM;
    for (int base = (int)blockIdx.x * 64; base < NTOK; base += G * 64) {
        const int row = base + 16 * tp + r;
        f32x4 acc[3]; acc[0] = acc[1] = acc[2] = (f32x4){0.f, 0.f, 0.f, 0.f}; float ss = 0.f;
        const bf16_t* xr = x1 + (size_t)row * DM + kh * 1024 + 8 * q4; bf16_t* hr = h2b + (size_t)row * DM + kh * 1024 + 8 * q4;
        const bf16_t* bh = whi + (size_t)r * DM + kh * 1024 + 8 * q4; const bf16_t* bl = wlo + (size_t)r * DM + kh * 1024 + 8 * q4;
        for (int s0 = 0; s0 < 32; s0 += 4) {
            u32x4 xq[4]; u32x2 h8[4];
#pragma unroll
            for (int j = 0; j < 4; ++j) xq[j] = *(const u32x4*)(xr + 32 * (s0 + j));
#pragma unroll
            for (int j = 0; j < 4; ++j) { const int s = s0 + j;
                float xv[8]; unpack8(xq[j], xv);
#pragma unroll
                for (int i = 0; i < 8; ++i) ss += xv[i] * xv[i];
                h8[j].x = pk4_fp8(xv[0], xv[1], xv[2], xv[3]); h8[j].y = pk4_fp8(xv[4], xv[5], xv[6], xv[7]);
                const bf16x8 ahi = __builtin_bit_cast(bf16x8, xq[j]);
#pragma unroll
                for (int nt = 0; nt < 3; ++nt) {
                    const bf16x8 bhi = *(const bf16x8*)(bh + (size_t)nt * 16 * DM + 32 * s), blo = *(const bf16x8*)(bl + (size_t)nt * 16 * DM + 32 * s);
                    acc[nt] = __builtin_amdgcn_mfma_f32_16x16x32_bf16(ahi, bhi, acc[nt], 0, 0, 0);
                    acc[nt] = __builtin_amdgcn_mfma_f32_16x16x32_bf16(ahi, blo, acc[nt], 0, 0, 0);
                }
            }
            asm volatile("" ::: "memory");
#pragma unroll
            for (int j = 0; j < 4; ++j) { if (FP8MOE) *(u32x2*)((unsigned char*)h2b + (size_t)row * DM + kh * 1024 + 8 * q4 + 32 * (s0 + j)) = h8[j]; else *(u32x4*)(hr + 32 * (s0 + j)) = xq[j]; }
            asm volatile("" ::: "memory");
        }
#pragma unroll
        for (int nt = 0; nt < 3; ++nt)
#pragma unroll
            for (int rr = 0; rr < 4; ++rr) lgp[(w * 16 + 4 * q4 + rr) * 48 + 16 * nt + r] = acc[nt][rr];
        ss += shx(ss, lane, 16); ss += shx(ss, lane, 32);
        if (q4 == 0) ssq[w * 16 + r] = ss;
        if (tid < 32) lcnt[tid] = 0;
        __syncthreads();
        int e0 = 0, e1 = 0, lp0 = 0, lp1 = 0; float w0 = 0.f, w1 = 0.f, rstd = 0.f;
        const bool router = (kh == 0 && lane < 16);
        const int tokn = base + 16 * tp + lane;
        if (router) {
            rstd = 1.0f / sqrtf((ssq[w * 16 + lane] + ssq[(w + 1) * 16 + lane]) * (1.0f / DM) + EPS);
            LAS float* mine = lgp + (w * 16 + lane) * 48; const LAS float* oth = lgp + ((w + 1) * 16 + lane) * 48;
            for (int o = 0; o < 36; ++o) mine[o] = (mine[o] + oth[o]) * rstd + (o < 4 ? p.rg_b[l * NGRP + o] : p.re_b[l * NE + o - 4]);
            route_token((const LAS float*)mine, e0, e1, w0, w1);
            lp0 = __hip_atomic_fetch_add(&lcnt[e0], 1, __ATOMIC_RELAXED, __HIP_MEMORY_SCOPE_WORKGROUP); lp1 = __hip_atomic_fetch_add(&lcnt[e1], 1, __ATOMIC_RELAXED, __HIP_MEMORY_SCOPE_WORKGROUP);
        }
        __syncthreads();
        if (tid < 32) { const int c = lcnt[tid]; gbase[tid] = c ? (int)__hip_atomic_fetch_add(&ctl[CW_CNT + (l * NE + tid) * 16], (unsigned)c, __ATOMIC_RELAXED, __HIP_MEMORY_SCOPE_AGENT) : 0; }
        __syncthreads();
        if (router) {
            const int s0 = gbase[e0] + lp0, s1 = gbase[e1] + lp1;
            int* tok = (int*)(p.ws + WS_TOK); float* rse = (float*)(p.ws + WS_RSE);
            tok[(size_t)e0 * NTOK + s0] = tokn; rse[(size_t)e0 * NTOK + s0] = rstd; tok[(size_t)e1 * NTOK + s1] = tokn; rse[(size_t)e1 * NTOK + s1] = rstd;
            Rec rc; rc.e0 = e0; rc.s0 = s0; rc.w0 = w0; rc.e1 = e1; rc.s1 = s1; rc.w1 = w1; rc.pad0 = 0; rc.pad1 = 0;
            ((Rec*)(p.ws + WS_REC))[tokn] = rc;
        }
        __syncthreads();
    }
}

typedef short s16x4 __attribute__((ext_vector_type(4)));
__device__ __forceinline__ unsigned off_b(unsigned row, unsigned ch) { return 256u * row + 16u * (ch ^ (((row & 3u) << 2) | ((row >> 2) & 3u))); }
__device__ __forceinline__ unsigned tr_addr(unsigned r0, unsigned c, unsigned lane) { const unsigned q = (lane & 15u) >> 2, pp = lane & 3u; return off_b(r0 + q, 2u * c + (pp >> 1)) + 8u * (pp & 1u); }
__device__ __forceinline__ s16x4 trd(const LAS unsigned char* p) { return __builtin_amdgcn_ds_read_tr16_b64_v4i16((LAS s16x4*)p); }
__device__ __forceinline__ bf16x8 mk8(s16x4 a, s16x4 b) { return __builtin_shufflevector(a, b, 0, 1, 2, 3, 4, 5, 6, 7); }
constexpr unsigned IMG_K = 0, IMG_V = 32768, IMG_S = 65536;
constexpr unsigned BUF_K0 = 0, BUF_V0 = 32768, BUF_K1 = 65536, BUF_V1 = 98304;

__device__ __forceinline__ void load_image(LAS unsigned char* lds, unsigned img, const bf16_t* src, int tid) {
#pragma unroll
    for (int i = 0; i < 4; ++i) { const int idx = tid + 512 * i, row = idx >> 4, ch = idx & 15;
        const u32x4 v = *(const u32x4*)(src + (size_t)row * INW + ch * 8);
        *(LAS u32x4*)(lds + img + off_b(row, ch)) = v; }
}
__device__ __forceinline__ void dma_image(LAS unsigned char* lds, unsigned img, const bf16_t* src, int tid, int wv) {
#pragma unroll
    for (int j = 0; j < 4; ++j) { const unsigned row = 32u * j + ((unsigned)tid >> 4), cp = (unsigned)tid & 15u, cl = cp ^ (((row & 3u) << 2) | ((row >> 2) & 3u));
        __builtin_amdgcn_global_load_lds((const unsigned*)(src + (size_t)row * INW + cl * 8), (LAS unsigned*)(lds + img + (unsigned)(j * 512 + wv * 64) * 16u), 16, 0, 0); }
}
#define MIX_BAR() do { asm volatile("s_waitcnt lgkmcnt(0)" ::: "memory"); __builtin_amdgcn_s_barrier(); asm volatile("" ::: "memory"); } while (0)
struct TrBases { unsigned k0, v0[8], dv; };
__device__ __forceinline__ void make_bases(TrBases& B, int w, int lane) {
    const unsigned q4 = lane >> 4;
    B.k0 = tr_addr(8 * q4, w, lane); B.dv = tr_addr(8 * q4 + 4, 0, lane) - tr_addr(8 * q4, 0, lane);
#pragma unroll
    for (int c = 0; c < 8; ++c) B.v0[c] = tr_addr(8 * q4, c, lane);
}
__device__ __forceinline__ void kv_chunk(const LAS unsigned char* kimg, const LAS unsigned char* vimg, const TrBases& B, const float (&f0)[8], float g32i, f32x4 (&D)[8]) {
    float sk = 1.0f; unsigned dv = B.dv; asm volatile("" : "+v"(dv));
#pragma unroll
    for (int ks = 0; ks < 4; ++ks) {
        const s16x4 ka = trd(kimg + B.k0 + 8192 * ks), kb = trd(kimg + (B.k0 + dv) + 8192 * ks);
        u32x4 kk;
        kk.x = pk2(bf2f((unsigned short)ka[0]) * (f0[0] * sk), bf2f((unsigned short)ka[1]) * (f0[1] * sk)); kk.y = pk2(bf2f((unsigned short)ka[2]) * (f0[2] * sk), bf2f((unsigned short)ka[3]) * (f0[3] * sk));
        kk.z = pk2(bf2f((unsigned short)kb[0]) * (f0[4] * sk), bf2f((unsigned short)kb[1]) * (f0[5] * sk)); kk.w = pk2(bf2f((unsigned short)kb[2]) * (f0[6] * sk), bf2f((unsigned short)kb[3]) * (f0[7] * sk));
        const bf16x8 af = __builtin_bit_cast(bf16x8, kk);
#pragma unroll
        for (int c = 0; c < 8; ++c) { const s16x4 va = trd(vimg + B.v0[c] + 8192 * ks), vb = trd(vimg + (B.v0[c] + dv) + 8192 * ks); D[c] = __builtin_amdgcn_mfma_f32_16x16x32_bf16(af, mk8(va, vb), D[c], 0, 0, 0); }
        sk *= g32i;
    }
}
__device__ __forceinline__ void kv_item(const Ptrs& p, LAS unsigned char* lds, int wg) {
    const int tid = hidden_tid(), lane = tid & 63, w = __builtin_amdgcn_readfirstlane(tid >> 6), q4 = lane >> 4;
    const int b = wg >> 6, h = (wg >> 3) & 7, q8 = wg & 7;
    const float lg = log2_gamma(h), g128 = exp2f(lg * 128.0f), g32i = exp2f(-lg * 32.0f);
    const bf16_t* P = (const bf16_t*)(p.ws + WS_P);
    const bf16_t* srcK = P + ((size_t)b * SEQ + q8 * 512) * INW + COL_K + h * 128; const bf16_t* srcV = srcK + (COL_V - COL_K);
    TrBases B; make_bases(B, w, lane);
    float f0[8];
#pragma unroll
    for (int j = 0; j < 8; ++j) f0[j] = exp2f(lg * (float)(127 - 8 * q4 - j));
    f32x4 st[8];
#pragma unroll
    for (int c = 0; c < 8; ++c) st[c] = (f32x4){0.f, 0.f, 0.f, 0.f};
    __syncthreads();
    dma_image(lds, BUF_K0, srcK, tid, w); dma_image(lds, BUF_V0, srcV, tid, w);
    for (int ch = 0; ch < 4; ++ch) {
        const unsigned cur = (ch & 1) ? BUF_K1 : BUF_K0, oth = (ch & 1) ? BUF_K0 : BUF_K1;
        if (ch < 3) { dma_image(lds, oth, srcK + (size_t)(ch + 1) * 128 * INW, tid, w); dma_image(lds, oth + 32768, srcV + (size_t)(ch + 1) * 128 * INW, tid, w);
            asm volatile("s_waitcnt vmcnt(8)" ::: "memory"); }
        else asm volatile("s_waitcnt vmcnt(0)" ::: "memory");
        MIX_BAR();
#pragma unroll
        for (int c = 0; c < 8; ++c) st[c] = st[c] * g128;
        kv_chunk(lds + cur, lds + cur + 32768, B, f0, g32i, st);
        MIX_BAR();
    }
    f32x4* dump = (f32x4*)(p.ws + WS_SSUP) + (size_t)wg * 4096;
#pragma unroll
    for (int c = 0; c < 8; ++c) dump[c * 512 + tid] = st[c];
}
__device__ __forceinline__ void ret_item(const Ptrs& p, int l, LAS unsigned char* lds, int wg) {
    const int tid = hidden_tid(), lane = tid & 63, w = __builtin_amdgcn_readfirstlane(tid >> 6), q4 = lane >> 4, fr = lane & 15;
    const int b = wg >> 6, h = (wg >> 3) & 7, q8 = wg & 7;
    const float lg = log2_gamma(h), g128 = exp2f(lg * 128.0f), g512 = exp2f(lg * 512.0f), g32i = exp2f(-lg * 32.0f);
    const bf16_t* P = (const bf16_t*)(p.ws + WS_P); bf16_t* mix = (bf16_t*)(p.ws + WS_MIX);
    const size_t rowb = (size_t)b * SEQ + q8 * 512;
    const bf16_t* srcK = P + rowb * INW + COL_K + h * 128; const bf16_t* srcV = srcK + (COL_V - COL_K);
    __syncthreads();
    dma_image(lds, BUF_K0, srcK, tid, w); dma_image(lds, BUF_V0, srcV, tid, w);
    TrBases B; make_bases(B, w, lane);
    float f0[8];
#pragma unroll
    for (int j = 0; j < 8; ++j) f0[j] = exp2f(lg * (float)(127 - 8 * q4 - j));
    unsigned kb0[4], sb[4];
    const unsigned kr = 8 * (fr >> 2) + (fr & 3);
#pragma unroll
    for (int ks = 0; ks < 4; ++ks) { kb0[ks] = off_b(kr, 4 * ks + q4); sb[ks] = off_b(fr, 4 * ks + q4); }
    const unsigned dk = off_b(kr + 4, q4) - off_b(kr, q4);
    const unsigned stw = off_b(fr, 2 * w + (q4 >> 1)) + 8 * (q4 & 1);
    const int t = 16 * w + fr;
    const float gq = exp2f(lg * (float)(t + 1));
    bf16x8 qf[4];
#pragma unroll
    for (int ks = 0; ks < 4; ++ks) qf[ks] = *(const bf16x8*)(P + (rowb + t) * INW + COL_Q + h * 128 + 32 * ks + 8 * q4);
    LAS float* gnw = (LAS float*)(lds + LDS_TAB);
    if (tid < 128) gnw[tid] = p.ret_gn_w[l * 1024 + h * 128 + tid];
    f32x4 st[8];
#pragma unroll
    for (int c = 0; c < 8; ++c) st[c] = (f32x4){0.f, 0.f, 0.f, 0.f};
    for (int q0 = 0; q0 < q8; q0 += 4) {
        const f32x4* dump = (const f32x4*)(p.ws + WS_SSUP) + (size_t)(wg - q8 + q0) * 4096 + tid;
        f32x4 dv[4][8]; const int nq = q8 - q0;
#pragma unroll
        for (int i = 0; i < 4; ++i) if (i < nq) {
#pragma unroll
            for (int c = 0; c < 8; ++c) dv[i][c] = dump[(size_t)i * 4096 + c * 512]; }
#pragma unroll
        for (int i = 0; i < 4; ++i) if (i < nq) {
#pragma unroll
            for (int c = 0; c < 8; ++c) st[c] = st[c] * g512 + dv[i][c]; }
    }
    for (int ch = 0; ch < 4; ++ch) {
        const size_t row0 = rowb + ch * 128;
        const unsigned cur = (ch & 1) ? BUF_K1 : BUF_K0, oth = (ch & 1) ? BUF_K0 : BUF_K1;
        const LAS unsigned char* kimg = lds + cur; const LAS unsigned char* vimg = lds + cur + 32768; LAS unsigned char* simg = lds + oth + 32768;
        asm volatile("s_waitcnt vmcnt(0)" ::: "memory");
        MIX_BAR();
#pragma unroll
        for (int c = 0; c < 8; ++c) { u32x2 wv; wv.x = pk2(st[c][0], st[c][1]); wv.y = pk2(st[c][2], st[c][3]); *(LAS u32x2*)(simg + stw + 4096 * c) = wv; }
        if (ch < 3) dma_image(lds, oth, srcK + (size_t)(ch + 1) * 128 * INW, tid, w);
        u32x2 gv8[8];
#pragma unroll
        for (int c = 0; c < 8; ++c) gv8[c] = *(const u32x2*)(P + (row0 + t) * INW + COL_G + h * 128 + 16 * c + 4 * q4);
        MIX_BAR();
        f32x4 O[8];
#pragma unroll
        for (int c = 0; c < 8; ++c) { O[c] = (f32x4){0.f, 0.f, 0.f, 0.f};
#pragma unroll
            for (int ks = 0; ks < 4; ++ks) { const bf16x8 a = *(const LAS bf16x8*)(simg + sb[ks] + 4096 * c); O[c] = __builtin_amdgcn_mfma_f32_16x16x32_bf16(a, qf[ks], O[c], 0, 0, 0); }
            O[c] = O[c] * gq; }
        MIX_BAR();
        if (ch < 3) dma_image(lds, oth + 32768, srcV + (size_t)(ch + 1) * 128 * INW, tid, w);
        for (int stp = 0; stp <= (w >> 1); ++stp) {
            f32x4 T0 = (f32x4){0.f, 0.f, 0.f, 0.f}, T1 = T0;
            const LAS unsigned char* kst = kimg + 8192 * stp; const LAS unsigned char* vst = vimg + 8192 * stp; unsigned dvl = B.dv, dkl = dk; asm volatile("" : "+v"(dvl), "+v"(dkl));
#pragma unroll
            for (int ks = 0; ks < 4; ++ks) { const bf16x8 a0 = *(const LAS bf16x8*)(kst + kb0[ks]), a1 = *(const LAS bf16x8*)(kst + (kb0[ks] + dkl));
                T0 = __builtin_amdgcn_mfma_f32_16x16x32_bf16(a0, qf[ks], T0, 0, 0, 0); T1 = __builtin_amdgcn_mfma_f32_16x16x32_bf16(a1, qf[ks], T1, 0, 0, 0); }
            float pv[8];
#pragma unroll
            for (int r = 0; r < 4; ++r) { const int s0 = 32 * stp + 8 * q4 + r, s1 = s0 + 4;
                pv[r] = (t >= s0) ? T0[r] * exp2f(lg * (float)(t - s0)) : 0.f; pv[4 + r] = (t >= s1) ? T1[r] * exp2f(lg * (float)(t - s1)) : 0.f; }
            u32x4 pk; pk.x = pk2(pv[0], pv[1]); pk.y = pk2(pv[2], pv[3]); pk.z = pk2(pv[4], pv[5]); pk.w = pk2(pv[6], pv[7]);
            const bf16x8 pf = __builtin_bit_cast(bf16x8, pk);
#pragma unroll
            for (int c = 0; c < 8; ++c) { const s16x4 va = trd(vst + B.v0[c]), vb = trd(vst + (B.v0[c] + dvl)); O[c] = __builtin_amdgcn_mfma_f32_16x16x32_bf16(mk8(va, vb), pf, O[c], 0, 0, 0); }
        }
        if (ch < 3) {
#pragma unroll
            for (int ks = 0; ks < 4; ++ks) qf[ks] = *(const bf16x8*)(P + (row0 + 128 + t) * INW + COL_Q + h * 128 + 32 * ks + 8 * q4); }
        { float s = 0.f;
#pragma unroll
          for (int c = 0; c < 8; ++c) s += (O[c][0] + O[c][1]) + (O[c][2] + O[c][3]);
          s += shx(s, lane, 16); s += shx(s, lane, 32);
          const float mu = s * (1.0f / 128.0f); float qv = 0.f;
#pragma unroll
          for (int c = 0; c < 8; ++c) { const f32x4 d = O[c] - mu; qv += (d[0] * d[0] + d[1] * d[1]) + (d[2] * d[2] + d[3] * d[3]); }
          qv += shx(qv, lane, 16); qv += shx(qv, lane, 32);
          const float rs = 1.0f / sqrtf(qv * (1.0f / 128.0f) + EPS);
          const size_t row = row0 + t;
#pragma unroll
          for (int c = 0; c < 8; ++c) { const int e0 = h * 128 + 16 * c + 4 * q4;
              const u32x2 gv = gv8[c]; const f32x4 gw = *(const LAS f32x4*)(gnw + 16 * c + 4 * q4);
              const float g0 = bf2f(gv.x & 0xffffu), g1 = bf2f(gv.x >> 16), g2 = bf2f(gv.y & 0xffffu), g3 = bf2f(gv.y >> 16);
              u32x2 o; o.x = pk2(silu(g0) * ((O[c][0] - mu) * rs * gw[0]), silu(g1) * ((O[c][1] - mu) * rs * gw[1])); o.y = pk2(silu(g2) * ((O[c][2] - mu) * rs * gw[2]), silu(g3) * ((O[c][3] - mu) * rs * gw[3]));
              *(u32x2*)(mix + row * DM + e0) = o; } }
#pragma unroll
        for (int c = 0; c < 8; ++c) st[c] = st[c] * g128;
        kv_chunk(kimg, vimg, B, f0, g32i, st);
    }
    MIX_BAR();
}
__device__ __forceinline__ float dpp_sum16(float v) {
    int x;
    x = __builtin_amdgcn_update_dpp(0, __builtin_bit_cast(int, v), 0xB1, 0xF, 0xF, true); v += __builtin_bit_cast(float, x);
    x = __builtin_amdgcn_update_dpp(0, __builtin_bit_cast(int, v), 0x4E, 0xF, 0xF, true); v += __builtin_bit_cast(float, x);
    x = __builtin_amdgcn_update_dpp(0, __builtin_bit_cast(int, v), 0x141, 0xF, 0xF, true); v += __builtin_bit_cast(float, x);
    x = __builtin_amdgcn_update_dpp(0, __builtin_bit_cast(int, v), 0x140, 0xF, 0xF, true); v += __builtin_bit_cast(float, x);
    return v;
}
__device__ __forceinline__ void gmlp_fetch(const Ptrs& p, int it, int tid, u32x4 (&vq)[4]) {
    const int b = it >> 8, nb = (it >> 3) & 31, g = it & 7;
    const bf16_t* src = (const bf16_t*)(p.ws + WS_P) + ((size_t)b * SEQ + nb * 128) * INW;
#pragma unroll
    for (int i = 0; i < 4; ++i) { const int idx = tid + 512 * i, row = idx >> 4, ch = idx & 15; vq[i] = *(const u32x4*)(src + (size_t)row * INW + COL_VS + g * 128 + ch * 8); }
}
__device__ __forceinline__ void gmlp_items(const Ptrs& p, int l, LAS unsigned char* lds, int first, int G) {
    const int tid = hidden_tid(), lane = tid & 63, w = __builtin_amdgcn_readfirstlane(tid >> 6), q4 = lane >> 4, fr = lane & 15;
    bf16_t* mix = (bf16_t*)(p.ws + WS_MIX);
    const int ucol = 16 * w + 4 * q4;
    u32x4 vq[4];
    if (first < 1024) gmlp_fetch(p, first, tid, vq);
    int gcur = -1; float bs[8]; f32x4 n0, n1;
    for (int it = first; it < 1024; it += G) {
        const int b = it >> 8, nb = (it >> 3) & 31, g = it & 7;
        const size_t row0 = (size_t)b * SEQ + nb * 128;
        if (g != gcur) {
            gcur = g;
            const bf16_t* Wm = (const bf16_t*)(p.ws + WS_WSB) + ((size_t)l * GG + g) * 128 * 128;
            __syncthreads();
#pragma unroll
            for (int i = 0; i < 4; ++i) { const int idx = tid + 512 * i, row = idx >> 4, ch = idx & 15; *(LAS u32x4*)(lds + IMG_V + off_b(row, ch)) = *(const u32x4*)(Wm + (size_t)row * 128 + ch * 8); }
#pragma unroll
            for (int tt = 0; tt < 8; ++tt) bs[tt] = p.b_s[((size_t)l * GG + g) * 128 + 16 * tt + fr];
            n0 = *(const f32x4*)(p.gmlp_norm_w + l * 1024 + g * 128 + (tid & 15) * 8); n1 = *(const f32x4*)(p.gmlp_norm_w + l * 1024 + g * 128 + (tid & 15) * 8 + 4);
        }
        __syncthreads();
#pragma unroll
        for (int i = 0; i < 4; ++i) { const int idx = tid + 512 * i, row = idx >> 4, ch = idx & 15;
            float x[8]; unpack8(vq[i], x);
            float s = 0.f;
#pragma unroll
            for (int j = 0; j < 8; ++j) s += x[j];
            s = dpp_sum16(s);
            const float mu = s * (1.0f / 128.0f); float qv = 0.f;
#pragma unroll
            for (int j = 0; j < 8; ++j) { x[j] -= mu; qv += x[j] * x[j]; }
            qv = dpp_sum16(qv);
            const float rs = __builtin_amdgcn_rsqf(qv * (1.0f / 128.0f) + EPS);
            u32x4 o; o.x = pk2(x[0] * rs * n0[0], x[1] * rs * n0[1]); o.y = pk2(x[2] * rs * n0[2], x[3] * rs * n0[3]); o.z = pk2(x[4] * rs * n1[0], x[5] * rs * n1[1]); o.w = pk2(x[6] * rs * n1[2], x[7] * rs * n1[3]);
            *(LAS u32x4*)(lds + IMG_K + off_b(row, ch)) = o; }
        u32x2 uv[8];
#pragma unroll
        for (int tt = 0; tt < 8; ++tt) uv[tt] = *(const u32x2*)((const bf16_t*)(p.ws + WS_P) + (row0 + 16 * tt + fr) * INW + COL_U + g * 128 + ucol);
        if (it + G < 1024) gmlp_fetch(p, it + G, tid, vq);
        __syncthreads();
        const unsigned tb0 = IMG_K + tr_addr(8 * q4, w, lane), tb1 = IMG_K + tr_addr(8 * q4 + 4, w, lane);
        bf16x8 af[4];
#pragma unroll
        for (int ks = 0; ks < 4; ++ks) af[ks] = mk8(trd(lds + tb0 + 8192 * ks), trd(lds + tb1 + 8192 * ks));
        unsigned wmb[4];
#pragma unroll
        for (int ks = 0; ks < 4; ++ks) wmb[ks] = off_b(fr, 4 * ks + q4);
        f32x4 Z[8];
#pragma unroll
        for (int tt = 0; tt < 8; ++tt) {
            Z[tt] = (f32x4){0.f, 0.f, 0.f, 0.f};
#pragma unroll
            for (int ks = 0; ks < 4; ++ks) { if (tt < 4 && ks >= 2) continue;
                const bf16x8 bw = *(const LAS bf16x8*)(lds + IMG_V + wmb[ks] + 4096 * tt);
                Z[tt] = __builtin_amdgcn_mfma_f32_16x16x32_bf16(af[ks], bw, Z[tt], 0, 0, 0); }
        }
        const int c0 = g * 128 + ucol;
#pragma unroll
        for (int tt = 0; tt < 8; ++tt) { const size_t row = row0 + 16 * tt + fr;
            u32x2 o; o.x = pk2(bf2f(uv[tt].x & 0xffffu) * (Z[tt][0] + bs[tt]), bf2f(uv[tt].x >> 16) * (Z[tt][1] + bs[tt])); o.y = pk2(bf2f(uv[tt].y & 0xffffu) * (Z[tt][2] + bs[tt]), bf2f(uv[tt].y >> 16) * (Z[tt][3] + bs[tt]));
            *(u32x2*)(mix + row * DM + 1024 + c0) = o; }
    }
}

template <int MODE, class EB>
__device__ __forceinline__ void row_phase2(const Ptrs& p, const void* srcv, bf16_t* xres  , bf16_t* xb, const Rec* rec, const bf16_t* y, EB ebase, int gw, int ngw, int lane) {
    for (int row = gw; row < NTOK; row += ngw) {
        float v[4][8];
        if (MODE == 0) { const f32x4* xr = (const f32x4*)((const float*)srcv + (size_t)row * DM) + 2 * lane;
#pragma unroll
            for (int j = 0; j < 4; ++j) { const f32x4 a = xr[128 * j], b = xr[128 * j + 1]; v[j][0] = a.x; v[j][1] = a.y; v[j][2] = a.z; v[j][3] = a.w; v[j][4] = b.x; v[j][5] = b.y; v[j][6] = b.z; v[j][7] = b.w; }
        } else {
            const Rec r = rec[row];
            const size_t r0 = (size_t)(ebase[r.e0] + r.s0), r1 = (size_t)(ebase[r.e1] + r.s1);
            const u32x4* xr = (const u32x4*)((const bf16_t*)srcv + (size_t)row * DM) + lane;
            u32x4 xv[4];
#pragma unroll
            for (int j = 0; j < 4; ++j) xv[j] = xr[64 * j];
            if (FP8MOE) {
                const u32x2* y0 = (const u32x2*)((const unsigned char*)y + r0 * DM) + lane; const u32x2* y1 = (const u32x2*)((const unsigned char*)y + r1 * DM) + lane;
                u32x2 av[4], bv[4]; const float w0 = r.w0 * (1.0f / 16.0f), w1 = r.w1 * (1.0f / 16.0f);
#pragma unroll
                for (int j = 0; j < 4; ++j) { av[j] = y0[64 * j]; bv[j] = y1[64 * j]; }
#pragma unroll
                for (int j = 0; j < 4; ++j) { float a[8], b[8]; unpack8(xv[j], v[j]); unpack8_fp8(av[j], a); unpack8_fp8(bv[j], b);
#pragma unroll
                    for (int i = 0; i < 8; ++i) v[j][i] += w0 * a[i] + w1 * b[i]; }
            } else {
                const u32x4* y0 = (const u32x4*)(y + r0 * DM) + lane; const u32x4* y1 = (const u32x4*)(y + r1 * DM) + lane;
                u32x4 av[4], bv[4];
#pragma unroll
                for (int j = 0; j < 4; ++j) { av[j] = y0[64 * j]; bv[j] = y1[64 * j]; }
#pragma unroll
                for (int j = 0; j < 4; ++j) { float a[8], b[8]; unpack8(xv[j], v[j]); unpack8(av[j], a); unpack8(bv[j], b);
#pragma unroll
                    for (int i = 0; i < 8; ++i) v[j][i] += r.w0 * a[i] + r.w1 * b[i]; }
            }
        }
        float s = 0.f;
#pragma unroll
        for (int j = 0; j < 4; ++j)
#pragma unroll
            for (int i = 0; i < 8; ++i) s += v[j][i] * v[j][i];
        const float rstd = 1.0f / sqrtf(wave_sum_l(s, lane) * (1.0f / DM) + EPS);
        if (MODE <= 1) { u32x4* o = (u32x4*)(xres + (size_t)row * DM) + lane; u32x4* o2 = (u32x4*)(xb + (size_t)row * DM) + lane;
#pragma unroll
            for (int j = 0; j < 4; ++j) { o[64 * j] = pack8(v[j]); float n[8];
#pragma unroll
                for (int i = 0; i < 8; ++i) n[i] = v[j][i] * rstd;
                o2[64 * j] = pack8(n); } }
        if (MODE == 2) { f32x4* o = (f32x4*)(p.out + (size_t)row * DM) + 2 * lane; const f32x4* fw = (const f32x4*)p.final_w + 2 * lane;
#pragma unroll
            for (int j = 0; j < 4; ++j) { const f32x4 f0 = fw[128 * j], f1 = fw[128 * j + 1];
                o[128 * j] = (f32x4){v[j][0] * rstd * f0.x, v[j][1] * rstd * f0.y, v[j][2] * rstd * f0.z, v[j][3] * rstd * f0.w};
                o[128 * j + 1] = (f32x4){v[j][4] * rstd * f1.x, v[j][5] * rstd * f1.y, v[j][6] * rstd * f1.z, v[j][7] * rstd * f1.w}; } }
    }
}

constexpr int NPH = 1 + 8 * NL;
struct MegaArgs { Ptrs p; int ph_lo, ph_hi, use_bar, pad; };
__global__ void __launch_bounds__(NWAVES * 64, 2) k_mega(MegaArgs a) {
    extern __shared__ __attribute__((aligned(16))) unsigned char lds_raw[];
    LAS unsigned char* lds = (LAS unsigned char*)lds_raw;
    const Ptrs& p = a.p;
    const int tid = threadIdx.x;
    const int G = gridDim.x; const int bx = blockIdx.x; const int vcu = (G % 8 == 0) ? (bx % 8) * (G / 8) + bx / 8 : bx;
    unsigned* ctl = (unsigned*)(p.ws + WS_CTL);
    volatile LAS unsigned* MISC = (volatile LAS unsigned*)(lds + LDS_MISC);
    if (tid < 32) MISC[tid] = 0u;
    __syncthreads();
    XcdBarrier bar; bar.bar = ctl + CW_BAR; bar.x = 0; bar.st = MISC + 8;
    if (a.use_bar) bar = xcd_barrier_post(ctl + CW_BAR, MISC + 8);
    const int lo = a.ph_lo, hi = a.ph_hi;
#ifndef PHSEL
#define PHSEL 0xff
#endif
#define IN(k) (lo <= (k) && (k) < hi)
#define SEL(j) ((PHSEL >> (j)) & 1)
#ifndef REPEAT_MASK
#define REPEAT_MASK 0
#endif
#define NREP(j) (((REPEAT_MASK >> (j)) & 1) ? 2 : 1)
#define SEAM(k) do { if (IN((k) + 1)) xcd_barrier(bar); } while (0)
    const int ngw = G * NWAVES;
#define ROWIDS() const int _ht = hidden_tid(); const int lane_ = _ht & 63, gw_ = vcu * NWAVES + (_ht >> 6)
    if (IN(0)) for (int rep = 0; rep < NREP(8); ++rep) {
        prologue_phase(p, lds, vcu, G);
        { ROWIDS(); row_phase2<0>(p, p.x, (bf16_t*)(p.ws + WS_X0B), (bf16_t*)(p.ws + WS_XB), nullptr, nullptr, (const int*)nullptr, gw_, ngw, lane_); }
        SEAM(0);
    }
    for (int l = 0; l < NL; ++l) {
        const int pb = 1 + 8 * l;
        if (SEL(0) && IN(pb + 0)) for (int rep = 0; rep < NREP(0); ++rep) {
            pg8::DenseOrder S; S.init(NTOK, INW, G, bx);
            pg8::EpiG1 E{(bf16_t*)(p.ws + WS_P), (const float*)(p.ws + WS_ROPE), (const float*)(p.ws + WS_ROPE) + SEQ * 64, rep};
            pg8::gemm_phase<false>(lds, (const bf16_t*)(p.ws + WS_XB), (const bf16_t*)(p.ws + WS_WINT) + (size_t)l * INW * DM, DM, S, E);
            SEAM(pb + 0);
        }
        if (SEL(1) && IN(pb + 1)) for (int rep = 0; rep < NREP(1); ++rep) {
            for (int it = bx; it < 256; it += G) kv_item(p, lds, it);
            gmlp_items(p, l, lds, bx, G);
            SEAM(pb + 1);
        }
        if (SEL(2) && IN(pb + 2)) for (int rep = 0; rep < NREP(2); ++rep) {
            for (int it = bx; it < 256; it += G) ret_item(p, l, lds, it);
            SEAM(pb + 2);
        }
        if (SEL(3) && IN(pb + 3)) for (int rep = 0; rep < NREP(3); ++rep) {
            pg8::DenseOrder S; S.init(NTOK, DM, G, bx);
            pg8::EpiG2 E{(const bf16_t*)(p.ws + ((l == 0) ? WS_X0B : WS_X2)), (bf16_t*)(p.ws + WS_X1)};
            pg8::gemm_phase<false>(lds, (const bf16_t*)(p.ws + WS_MIX), (const bf16_t*)(p.ws + WS_WOUT) + (size_t)l * DM * DM, DM, S, E);
            SEAM(pb + 3);
        }
        if (SEL(4) && IN(pb + 4)) {
            __syncthreads();
            r2_phase(p, l, lds, G);
            SEAM(pb + 4);
        }
        if (SEL(5) && IN(pb + 5)) for (int rep = 0; rep < NREP(5); ++rep) {
            const int nu = moe_units(ctl, l, lds, true, (const int*)(p.ws + WS_TOK));
            pg8::MoeOrder<true> S{(const LAS int*)(lds + LDS_UL), (const LAS int*)(lds + LDS_TAB), nu};
            pg8::EpiG3 E{(bf16_t*)(p.ws + WS_HE), (const float*)(p.ws + WS_RSE), (const LAS int*)(lds + LDS_EB)};
            if (FP8MOE) pg8::gemm_phase<true>(lds, (const bf16_t*)(p.ws + WS_H2B), (const bf16_t*)(p.ws + WS_WGU) + (size_t)l * NE * 2048 * (DM / 2), DM / 2, S, E);
            else pg8::gemm_phase<false>(lds, (const bf16_t*)(p.ws + WS_H2B), (const bf16_t*)(p.ws + WS_WGU) + (size_t)l * NE * 2048 * DM, DM, S, E);
            SEAM(pb + 5);
        }
        if (SEL(6) && IN(pb + 6)) for (int rep = 0; rep < NREP(6); ++rep) {
            const int nu = moe_units(ctl, l, lds, false, nullptr);
            pg8::MoeOrder<false> S{(const LAS int*)(lds + LDS_UL), (const LAS int*)(lds + LDS_TAB), nu};
            pg8::EpiG4 E{(bf16_t*)(p.ws + WS_Y)};
            if (FP8MOE) pg8::gemm_phase<true>(lds, (const bf16_t*)(p.ws + WS_HE), (const bf16_t*)(p.ws + WS_WD) + (size_t)l * NE * 2048 * (DE / 2), DE / 2, S, E);
            else pg8::gemm_phase<false>(lds, (const bf16_t*)(p.ws + WS_HE), (const bf16_t*)(p.ws + WS_WD) + (size_t)l * NE * 2048 * DE, DE, S, E);
            SEAM(pb + 6);
        }
        if (SEL(7) && IN(pb + 7)) {
            LAS int* eb = (LAS int*)(lds + LDS_EB);
            __syncthreads();
            if (tid == 0) { int acc = 0; for (int e = 0; e < NE; ++e) { eb[e] = acc; acc += (((int)ctl[CW_CNT + (l * NE + e) * 16] + 255) >> 8) << 8; } }
            __syncthreads();
            ROWIDS();
            if (l + 1 < NL) { row_phase2<1>(p, p.ws + WS_X1, (bf16_t*)(p.ws + WS_X2), (bf16_t*)(p.ws + WS_XB), (const Rec*)(p.ws + WS_REC), (const bf16_t*)(p.ws + WS_Y), (const LAS int*)eb, gw_, ngw, lane_); SEAM(pb + 7); }
            else row_phase2<2>(p, p.ws + WS_X1, nullptr, nullptr, (const Rec*)(p.ws + WS_REC), (const bf16_t*)(p.ws + WS_Y), (const LAS int*)eb, gw_, ngw, lane_);
        }
    }
#undef IN
#undef SEAM
}


#ifndef FAST_MASK
#define FAST_MASK 0x3f
#endif
#ifndef ONE_LAUNCH
#define ONE_LAUNCH 1
#endif
extern "C" void kernel_launch(void* const* d_in, const int* in_sizes, int n_in, void* d_out, int out_size, void* d_ws, size_t ws_size, hipStream_t stream) {
    static int init = 0; static int grid = 0;
    if (!init) {
        if (n_in != 17 || ws_size < WS_END) { fprintf(stderr, "kernel_launch: unexpected n_in %d or ws %zu < %zu\n", n_in, ws_size, (size_t)WS_END); init = -1; return; }
        (void)hipFuncSetAttribute((const void*)nv_retention, hipFuncAttributeMaxDynamicSharedMemorySize, (3 * 64 * 129 + 64 * 65) * 4);
        (void)hipFuncSetAttribute((const void*)nv_gmlp, hipFuncAttributeMaxDynamicSharedMemorySize, 128 * 129 * 4);
        if (hipFuncSetAttribute((const void*)k_mega, hipFuncAttributeMaxDynamicSharedMemorySize, LDS_BYTES) != hipSuccess) { fprintf(stderr, "kernel_launch: hipFuncSetAttribute(k_mega) failed\n"); init = -1; return; }
        int dev = 0, cus = 0, per_cu = 0;
        (void)hipGetDevice(&dev); (void)hipDeviceGetAttribute(&cus, hipDeviceAttributeMultiprocessorCount, dev);
        if (hipOccupancyMaxActiveBlocksPerMultiprocessor(&per_cu, (const void*)k_mega, NWAVES * 64, LDS_BYTES) != hipSuccess || per_cu < 1) fprintf(stderr, "kernel_launch: occupancy query reports %d blocks per CU\n", per_cu);
        (void)hipGetLastError();
        grid = cus > 0 ? cus : 256;
        init = 1;
    }
    if (init < 0) return;
    Ptrs p{};
    p.x = (const float*)d_in[0]; p.norm1_w = (const float*)d_in[1]; p.w_in = (const float*)d_in[2]; p.ret_gn_w = (const float*)d_in[3]; p.gmlp_norm_w = (const float*)d_in[4];
    p.w_s = (const float*)d_in[5]; p.b_s = (const float*)d_in[6]; p.w_out = (const float*)d_in[7]; p.norm2_w = (const float*)d_in[8]; p.rg_w = (const float*)d_in[9]; p.rg_b = (const float*)d_in[10];
    p.re_w = (const float*)d_in[11]; p.re_b = (const float*)d_in[12]; p.w_gate = (const float*)d_in[13]; p.w_up = (const float*)d_in[14]; p.w_down = (const float*)d_in[15]; p.final_w = (const float*)d_in[16];
    p.out = (float*)d_out; p.ws = (unsigned char*)d_ws;
    (void)hipMemsetAsync((char*)d_ws + WS_CTL, 0, CTL_BYTES, stream);
    MegaArgs a{}; a.p = p; a.pad = 0;
#if ONE_LAUNCH
    a.ph_lo = 0; a.ph_hi = NPH; a.use_bar = 1;
    hipLaunchKernelGGL(k_mega, dim3(grid), dim3(NWAVES * 64), LDS_BYTES, stream, a);
#else
    a.use_bar = 0;
    auto mega = [&](int ph) { a.ph_lo = ph; a.ph_hi = ph + 1; hipLaunchKernelGGL(k_mega, dim3(grid), dim3(NWAVES * 64), LDS_BYTES, stream, a); };
    mega(0);
    for (int l = 0; l < NL; ++l) {
        const int pb = 1 + 8 * l;
        if (FAST_MASK & 1) mega(pb + 0); else { hipLaunchKernelGGL(nv_gemm<NV_G1>, dim3(INW / 64, NTOK / 64, 1), dim3(256), 0, stream, p, l); hipLaunchKernelGGL(nv_rope_act, dim3(4096), dim3(256), 0, stream, p); }
        if (FAST_MASK & 2) { mega(pb + 1); mega(pb + 2); }
        else { hipLaunchKernelGGL(nv_retention, dim3(SEQ / 64, NH, NBATCH), dim3(256), (3 * 64 * 129 + 64 * 65) * 4, stream, p, l); hipLaunchKernelGGL(nv_gmlp, dim3(SEQ / 128, GG, NBATCH), dim3(256), 128 * 129 * 4, stream, p, l); }
        if (FAST_MASK & 4) mega(pb + 3); else hipLaunchKernelGGL(nv_gemm<NV_G2>, dim3(DM / 64, NTOK / 64, 1), dim3(256), 0, stream, p, l);
        if (FAST_MASK & 8) mega(pb + 4); else hipLaunchKernelGGL(nv_r2, dim3(NTOK), dim3(256), 0, stream, p, l);
        if (FAST_MASK & 16) mega(pb + 5); else hipLaunchKernelGGL(nv_gemm<NV_G3>, dim3(DE / 64, NTOK / 64, NE), dim3(256), 0, stream, p, l);
        if (FAST_MASK & 32) mega(pb + 6); else hipLaunchKernelGGL(nv_gemm<NV_G4>, dim3(DM / 64, NTOK / 64, NE), dim3(256), 0, stream, p, l);
        mega(pb + 7);
    }
#endif
}
```

```cpp
#include <hip/hip_runtime.h>
#include <cstdio>
#include <cstdint>

#define GAS __attribute__((address_space(1)))
#define LAS __attribute__((address_space(3)))
typedef unsigned short bf16_t;
typedef short bf16x8 __attribute__((ext_vector_type(8)));
typedef float f32x4 __attribute__((ext_vector_type(4)));
typedef float f32x2 __attribute__((ext_vector_type(2)));
typedef unsigned u32x4 __attribute__((ext_vector_type(4)));
typedef unsigned u32x2 __attribute__((ext_vector_type(2)));

constexpr int NTOK = 16384, DM = 2048, SEQ = 4096, NBATCH = 4, NH = 8, DH = 128, INW = 6144, NE = 32, EPG = 8, NGRP = 4, DE = 1024, NL = 2;
constexpr int GG = 8, GBLK = 128;
constexpr int SLOTS = 40960;
constexpr float EPS = 1e-6f;
constexpr int COL_Q = 0, COL_K = 1024, COL_V = 2048, COL_G = 3072, COL_U = 4096, COL_VS = 5120;

constexpr size_t MiB = 1u << 20;
constexpr size_t WS_CTL = 0, CTL_BYTES = 1 * MiB;
constexpr size_t WS_ROPE = 1 * MiB;
constexpr size_t WS_WINT = 3 * MiB;
constexpr size_t WS_WOUT = WS_WINT + 48 * MiB;
constexpr size_t WS_WGU = WS_WOUT + 16 * MiB;
constexpr size_t WS_WD = WS_WGU + 512 * MiB;
constexpr size_t WS_WR = WS_WD + 256 * MiB;
constexpr size_t WS_WSB = WS_WR + 1 * MiB;
constexpr size_t WS_XB = WS_WSB + 1 * MiB;
constexpr size_t WS_P = WS_XB + 64 * MiB;
constexpr size_t WS_SSUP = WS_P + 192 * MiB;
constexpr size_t WS_MIX = WS_SSUP + 16 * MiB;
constexpr size_t WS_X1 = WS_MIX + 64 * MiB;
constexpr size_t WS_X0B = WS_X1 + 64 * MiB;
constexpr size_t WS_H2B = WS_X1 + 128 * MiB;
constexpr size_t WS_REC = WS_H2B + 64 * MiB;
constexpr size_t WS_TOK = WS_REC + 1 * MiB;
constexpr size_t WS_RSE = WS_TOK + 2 * MiB;
constexpr size_t WS_HE = WS_RSE + 2 * MiB;
constexpr size_t WS_Y = WS_HE + 80 * MiB;
constexpr size_t WS_X2 = WS_Y + 160 * MiB;
constexpr size_t WS_END = WS_X2 + 128 * MiB;
constexpr int CW_TMO = 0, CW_BAR = 4096, CW_CNT = 8192;

struct Rec { int e0, s0; float w0; int e1, s1; float w1; int pad0, pad1; };

__device__ __forceinline__ unsigned f2bf(float f) { unsigned u = __builtin_bit_cast(unsigned, f); return (u + 0x7fffu + ((u >> 16) & 1u)) >> 16; }
__device__ __forceinline__ float bf2f(unsigned b) { return __builtin_bit_cast(float, b << 16); }
__device__ __forceinline__ unsigned pk2(float lo, float hi) { return f2bf(lo) | (f2bf(hi) << 16); }
__device__ __forceinline__ float wave_sum(float v) {
#pragma unroll
    for (int o = 1; o < 64; o <<= 1) v += __shfl_xor(v, o);
    return v;
}
__device__ __forceinline__ float shx(float v, int lane, int m) { return __builtin_bit_cast(float, __builtin_amdgcn_ds_bpermute((lane ^ m) << 2, __builtin_bit_cast(int, v))); }
__device__ __forceinline__ float wave_sum_l(float v, int lane) {
#pragma unroll
    for (int o = 1; o < 64; o <<= 1) v += shx(v, lane, o);
    return v;
}
__device__ __forceinline__ float gelu_tanh(float x) {
    const float u = x * (-2.302208198f) * (1.0f + 0.044715f * x * x);
    return x * __builtin_amdgcn_rcpf(1.0f + __builtin_amdgcn_exp2f(u));
}
__device__ __forceinline__ float silu(float x) { return x * __builtin_amdgcn_rcpf(1.0f + __builtin_amdgcn_exp2f(x * -1.4426950408889634f)); }
__device__ __forceinline__ float log2_gamma(int h) { return log2f(1.0f - exp2f(-5.0f - (float)h)); }

struct Ptrs {
    const float *x, *norm1_w, *w_in, *ret_gn_w, *gmlp_norm_w, *w_s, *b_s, *w_out, *norm2_w, *rg_w, *rg_b, *re_w, *re_b, *w_gate, *w_up, *w_down, *final_w;
    float* out; unsigned char* ws;
};

template <class LP>
__device__ __forceinline__ void route_token(LP lg  , int& e0, int& e1, float& w0, float& w1) {
    int gs = 0; float gm = lg[0];
#pragma unroll
    for (int j = 1; j < NGRP; ++j) { const float v = lg[j]; if (v > gm) { gm = v; gs = j; } }
    float den = 0.f;
#pragma unroll
    for (int j = 0; j < NGRP; ++j) den += __expf(lg[j] - gm);
    const float psel = 1.0f / den;
    const int eb = 4 + 8 * gs;
    int i0 = 0; float v0 = lg[eb];
#pragma unroll
    for (int i = 1; i < EPG; ++i) { const float v = lg[eb + i]; if (v > v0) { v0 = v; i0 = i; } }
    int i1 = -1; float v1 = -3.0e38f;
#pragma unroll
    for (int i = 0; i < EPG; ++i) { const float v = lg[eb + i]; if (i != i0 && v > v1) { v1 = v; i1 = i; } }
    const float a = 1.0f / (1.0f + __expf(v1 - v0));
    e0 = gs * 8 + i0; e1 = gs * 8 + i1; w0 = a * psel; w1 = (1.0f - a) * psel;
}
#define XB_TMO      128
#define XB_XCNT(j)  (256  + 64 * (j))
#define XB_XSUB(j)  (1280 + 64 * (j))
#define XB_XGEN(j)  (2304 + 64 * (j))
#define XB_TOP      3328
#define XB_TOPGEN   3392
#define XCD_BAR_WORDS 3456
#define XB_SPIN_CAP (1u << 18)

__device__ __forceinline__ unsigned xb_ld(unsigned* p)              { return __hip_atomic_load(p, __ATOMIC_RELAXED, __HIP_MEMORY_SCOPE_AGENT); }
__device__ __forceinline__ unsigned xb_add(unsigned* p, unsigned v) { return __hip_atomic_fetch_add(p, v, __ATOMIC_RELAXED, __HIP_MEMORY_SCOPE_AGENT); }
__device__ __forceinline__ unsigned xb_xcc_id() { return (unsigned)__builtin_amdgcn_s_getreg((3 << 11) | 20) & 0xFu; }
#define XB_SPIN(cond, bar) do { unsigned _sp = 0; while (cond) { __builtin_amdgcn_s_sleep(1); \
    if ((++_sp & 255u) == 0u) { if (xb_ld(&(bar)[XB_TMO])) break; if (_sp > XB_SPIN_CAP) { atomicAdd(&(bar)[XB_TMO], 1u); break; } } } } while (0)

struct XcdBarrier {
    unsigned* bar; unsigned x;
    volatile LAS unsigned* st;
};

__device__ __forceinline__ XcdBarrier xcd_barrier_post(unsigned* bar, volatile LAS unsigned* st) {
    XcdBarrier b; b.bar = bar; b.x = xb_xcc_id(); b.st = st;
    if (threadIdx.x == 0) (void)xb_add(&bar[XB_XCNT(b.x)], 1u);
    return b;
}
__device__ __forceinline__ void xcd_barrier_complete(unsigned* bar, unsigned x, unsigned& nloc, unsigned& nx) {
    const unsigned G = gridDim.x * gridDim.y * gridDim.z;
    unsigned sum, cnt, mine, sp = 0u;
    for (;;) {
        sum = 0u; cnt = 0u; mine = 0u;
#pragma unroll
        for (unsigned j = 0; j < 16; ++j) { const unsigned c = xb_ld(&bar[XB_XCNT(j)]); sum += c; cnt += (c > 0u) ? 1u : 0u; mine = (j == x) ? c : mine; }
        if (sum == G) break;
        __builtin_amdgcn_s_sleep(1);
        if ((++sp & 255u) == 0u) { if (xb_ld(&bar[XB_TMO])) break; if (sp > XB_SPIN_CAP) { atomicAdd(&bar[XB_TMO], 1u); break; } }
    }
    nloc = mine > 0u ? mine : 1u; nx = cnt > 0u ? cnt : 1u;
}

__device__ __forceinline__ void xcd_barrier(const XcdBarrier& b) {
    asm volatile("s_waitcnt vmcnt(0)" ::: "memory");
    __syncthreads();
    if (threadIdx.x == 0) {
        unsigned* bar = b.bar;
        __builtin_amdgcn_s_waitcnt(0);
        unsigned nloc = b.st[0], nx = b.st[1];
        if (nloc == 0u) { xcd_barrier_complete(bar, b.x, nloc, nx); b.st[0] = nloc; b.st[1] = nx; }
        const unsigned old = xb_add(&bar[XB_XSUB(b.x)], 1u);
        const unsigned gen = old / nloc;
        if (old + 1u == (gen + 1u) * nloc) {
            __builtin_amdgcn_fence(__ATOMIC_RELEASE, "agent");
            asm volatile("s_waitcnt vmcnt(0)" ::: "memory");
            const unsigned og = xb_add(&bar[XB_TOP], 1u);
            const unsigned tg = og / nx;
            if (og + 1u == (tg + 1u) * nx) xb_add(&bar[XB_TOPGEN], 1u);
            else XB_SPIN(xb_ld(&bar[XB_TOPGEN]) == tg, bar);
            __builtin_amdgcn_fence(__ATOMIC_ACQUIRE, "agent");
            xb_add(&bar[XB_XGEN(b.x)], 1u);
            asm volatile("s_waitcnt vmcnt(0)" ::: "memory");
        } else {
            XB_SPIN(xb_ld(&bar[XB_XGEN(b.x)]) == gen, bar);
            __builtin_amdgcn_fence(__ATOMIC_ACQUIRE, "agent");
            asm volatile("s_waitcnt vmcnt(0)" ::: "memory");
        }
    }
    __syncthreads();
}

__device__ __forceinline__ int hidden_tid() { int t = threadIdx.x; asm volatile("" : "+v"(t)); return t; }
__device__ __forceinline__ void unpack8(const u32x4 v, float (&f)[8]) { f[0] = bf2f(v.x & 0xffffu); f[1] = bf2f(v.x >> 16); f[2] = bf2f(v.y & 0xffffu); f[3] = bf2f(v.y >> 16); f[4] = bf2f(v.z & 0xffffu); f[5] = bf2f(v.z >> 16); f[6] = bf2f(v.w & 0xffffu); f[7] = bf2f(v.w >> 16); }
__device__ __forceinline__ u32x4 pack8(const float (&f)[8]) { u32x4 w; w.x = pk2(f[0], f[1]); w.y = pk2(f[2], f[3]); w.z = pk2(f[4], f[5]); w.w = pk2(f[6], f[7]); return w; }
__device__ __forceinline__ void unpack8_fp8(const u32x2 v, float (&f)[8]) {
    const f32x2 a = __builtin_amdgcn_cvt_pk_f32_fp8((int)v.x, false), b = __builtin_amdgcn_cvt_pk_f32_fp8((int)v.x, true), c = __builtin_amdgcn_cvt_pk_f32_fp8((int)v.y, false), d = __builtin_amdgcn_cvt_pk_f32_fp8((int)v.y, true);
    f[0] = a.x; f[1] = a.y; f[2] = b.x; f[3] = b.y; f[4] = c.x; f[5] = c.y; f[6] = d.x; f[7] = d.y; }
constexpr int CW_TA = 16, CW_TB = 17;
#if defined(TIMER_PROBE) && defined(GMLP_TIMER)
#define TP_NOW() __builtin_amdgcn_s_memrealtime()
#define TP_ADD(word, t0) do { if (blockIdx.x == 0 && threadIdx.x == 0) atomicAdd((unsigned*)(p.ws + WS_CTL) + (word), (unsigned)(__builtin_amdgcn_s_memrealtime() - (t0))); } while (0)
#else
#define TP_NOW() 0ull
#define TP_ADD(word, t0) do { (void)(t0); } while (0)
#endif
constexpr int LDS_STAGE = 0;
constexpr int LDS_TAB = 131072;
constexpr int LDS_UL = LDS_TAB + 8192;
constexpr int LDS_EB = LDS_UL + 256;
constexpr int LDS_MISC = LDS_EB + 256;
constexpr int LDS_BYTES = 147456;
constexpr int NWAVES = 8;

__device__ __forceinline__ unsigned cvt_pk_bf16(float lo, float hi) { unsigned r; asm volatile("v_cvt_pk_bf16_f32 %0, %1, %2" : "=v"(r) : "v"(lo), "v"(hi)); return r; }

#ifndef FP8G2
#define FP8G2 1
#endif
#ifndef FP8G1
#define FP8G1 0
#endif
#ifndef FP8MOE
#define FP8MOE 1
#endif
typedef int i32x8 __attribute__((ext_vector_type(8)));
typedef int i32x4 __attribute__((ext_vector_type(4)));
#ifdef FP8_SW
__device__ __forceinline__ unsigned f2e4m3_sw(float x) {
    unsigned u = __builtin_bit_cast(unsigned, x); const unsigned sgn = (u >> 24) & 0x80u; u &= 0x7fffffffu;
    const float a = __builtin_bit_cast(float, u); unsigned code;
    if (a >= 0.015625f) { u += 0x7ffffu + ((u >> 20) & 1u); u &= 0xfff00000u; const float r = __builtin_bit_cast(float, u);
        if (r >= 448.0f) code = 0x7eu; else code = ((((u >> 23) - 120u) & 0xfu) << 3) | ((u >> 20) & 7u); }
    else code = (unsigned)__builtin_rintf(a * 512.0f);
    return sgn | code;
}
__device__ __forceinline__ unsigned pk4_fp8(float a, float b, float c, float d) { return f2e4m3_sw(a) | (f2e4m3_sw(b) << 8) | (f2e4m3_sw(c) << 16) | (f2e4m3_sw(d) << 24); }
#else
__device__ __forceinline__ unsigned pk4_fp8(float a, float b, float c, float d) { int w = 0; w = __builtin_amdgcn_cvt_pk_fp8_f32(a, b, w, false); w = __builtin_amdgcn_cvt_pk_fp8_f32(c, d, w, true); return (unsigned)w; }
#endif
namespace pg8 {
constexpr int BM = 256, BK = 64, HALF = 128, HTB = HALF * BK * 2, STAGE_BYTES = 8 * HTB, NXCD = 8, WGM = 8;
__host__ __device__ __forceinline__ int lds_byte(int r, int c) { const int st = (r >> 4) * 2 + (c >> 5), rr = r & 15, cc = c & 31, ob = rr * 64 + cc * 2; return st * 1024 + (ob ^ (((ob >> 9) & 1) << 5)); }
__host__ __device__ __forceinline__ void stage_rc(int b, int& R, int& C) { const int st = b / 1024, sb = b % 1024, swz = sb ^ (((sb >> 9) & 1) << 5); R = (st >> 1) * 16 + swz / 64; C = (st & 1) * 32 + (swz % 64) / 2; }
__host__ __device__ __forceinline__ int perm32(int rho) { const int n = rho >> 4, i = rho & 15; return 8 * (i >> 2) + 4 * n + (i & 3); }

struct Unit { int pm, pn, e, pnl, hm; };

struct DenseOrder {
    static constexpr bool HALVES = false;
    int nM, nN, nwg, G, c;
    __device__ void init(int M, int N, int G_, int c_) { nM = M / BM; nN = N / BM; nwg = nM * nN; G = G_; c = c_; }
    __device__ __forceinline__ bool next(int i, Unit& u) const {
        const long L = (long)i * G + c; if (L >= nwg) return false;
        int wgid = (int)L; { const int q = nwg / NXCD, r = nwg % NXCD, xcd = wgid % NXCD, off = wgid / NXCD; wgid = (xcd < r ? xcd * (q + 1) : r * (q + 1) + (xcd - r) * q) + off; }
        const int nig = WGM * nN, gid = wgid / nig, fm = gid * WGM, gsz = (nM - fm) < WGM ? (nM - fm) : WGM;
        u.pm = fm + ((wgid % nig) % gsz); u.pn = (wgid % nig) / gsz; u.e = 0; u.pnl = u.pn; u.hm = 0; return true;
    }
    __device__ __forceinline__ int arow(int, const Unit& u, int r) const { return u.pm * BM + r; }
};
template <bool GATHER> struct MoeOrder {
    static constexpr bool HALVES = true;
    const LAS int* ul; const LAS int* tab; int nu;
    __device__ __forceinline__ bool next(int i, Unit& u) const {
        if (i >= nu) return false;
        u.pm = __builtin_amdgcn_readfirstlane(ul[4 * i + 0]); u.pn = __builtin_amdgcn_readfirstlane(ul[4 * i + 1]);
        const int ev = __builtin_amdgcn_readfirstlane(ul[4 * i + 2]); u.e = ev & 255; u.hm = ev >> 8; u.pnl = __builtin_amdgcn_readfirstlane(ul[4 * i + 3]); return true;
    }
    __device__ __forceinline__ int arow(int ui, const Unit& u, int r) const { const int rr = u.hm ? ((u.hm == 2 ? HALF : 0) + (r & (HALF - 1))) : r; return GATHER ? tab[ui * 256 + rr] : u.pm * BM + rr; }
};

template <bool FP8, class Epi, class Sched>
__device__ __forceinline__ void gemm_phase(LAS unsigned char* lds, const bf16_t* A, const bf16_t* Bt, const int K, const Sched& S, const Epi& E) {
    const int tid = hidden_tid(), wid = __builtin_amdgcn_readfirstlane(tid >> 6), lane = tid & 63, wr = wid >> 2, wc = wid & 3, fr = lane & 15, fq = lane >> 4;
    const int nt = K / BK;
    unsigned voffB[2];
#pragma unroll
    for (int i = 0; i < 2; ++i) { int R_, C_; stage_rc(tid * 16 + i * 8192, R_, C_); const int Rb = Epi::PERM ? ((R_ & ~31) + perm32(R_ & 31)) : R_; voffB[i] = (unsigned)(Rb * K + C_) * 2u; }
    const size_t kstep = (size_t)(BK * 2);
    const size_t hstep = (size_t)HALF * K * 2;
    const size_t tstep = 2 * hstep;
    const unsigned ldsw = (unsigned)wid * 1024u;
    const int aoff = lds_byte(wr * 64 + fr, fq * 8), boff = lds_byte(wc * 32 + fr, fq * 8);
#define PG8_SA(b, h) (((b) * 2 + (h)) * HTB)
#define PG8_SB(b, h) ((4 + (b) * 2 + (h)) * HTB)
#define PG8_STAGE(bufoff, gbase, voff) do { const char* _gb = (const char*)(gbase); asm volatile("" : "+s"(_gb));     \
        _Pragma("unroll") for (int _i = 0; _i < 2; ++_i) { unsigned _vo = (voff)[_i]; asm volatile("" : "+v"(_vo)); \
        __builtin_amdgcn_global_load_lds((const unsigned*)(_gb + _vo), (LAS unsigned*)(lds + (bufoff) + ldsw + _i * 8192), 16, 0, 0); } } while (0)
#define PG8_LDA(dst, b, h) do { _Pragma("unroll") for (int m = 0; m < 4; ++m) _Pragma("unroll") for (int k = 0; k < 2; ++k) dst[m][k] = *(const LAS bf16x8*)(lds + PG8_SA(b, h) + aoff + m * 2048 + k * 1024); } while (0)
#define PG8_LDB(dst, b, h) do { _Pragma("unroll") for (int n = 0; n < 2; ++n) _Pragma("unroll") for (int k = 0; k < 2; ++k) dst[n][k] = *(const LAS bf16x8*)(lds + PG8_SB(b, h) + boff + n * 2048 + k * 1024); } while (0)
#define PG8_CAT(x0, x1) __builtin_shufflevector(__builtin_bit_cast(i32x4, x0), __builtin_bit_cast(i32x4, x1), 0, 1, 2, 3, 4, 5, 6, 7)
#define PG8_MMA(ai, bj, At, Bt_) do { __builtin_amdgcn_s_setprio(1); _Pragma("unroll") for (int m = 0; m < 4; ++m) _Pragma("unroll") for (int n = 0; n < 2; ++n) { \
        if constexpr (FP8) acc[ai][bj][m][n] = __builtin_amdgcn_mfma_scale_f32_16x16x128_f8f6f4(PG8_CAT(Bt_[n][0], Bt_[n][1]), PG8_CAT(At[m][0], At[m][1]), acc[ai][bj][m][n], 0, 0, 0, 0x7f7f7f7f, 0, 0x7f7f7f7f); \
        else { _Pragma("unroll") for (int k = 0; k < 2; ++k) acc[ai][bj][m][n] = __builtin_amdgcn_mfma_f32_16x16x32_bf16(Bt_[n][k], At[m][k], acc[ai][bj][m][n], 0, 0, 0); } } \
        __builtin_amdgcn_s_setprio(0); } while (0)
#define PG8_WAIT_V(n) asm volatile("s_waitcnt vmcnt(" #n ")" ::: "memory")
#define PG8_WAIT_L(n) asm volatile("s_waitcnt lgkmcnt(" #n ")" ::: "memory")
#define PG8_BAR __builtin_amdgcn_s_barrier()
#define PG8_SCHED __builtin_amdgcn_sched_barrier(0)
#define PG8_SKIP_IF(flag) do { if constexpr (Sched::HALVES) { PG8_SCHED; asm volatile("s_cmp_lg_u32 %0, 0\n\ts_cbranch_scc1 1f" :: "s"(flag) : "scc", "memory"); PG8_SCHED; } } while (0)
#define PG8_SKIP_END do { if constexpr (Sched::HALVES) { PG8_SCHED; asm volatile("1:" ::: "memory"); PG8_SCHED; } } while (0)
#define PG8_AOFF(dst, ui_, u_, h) do { int _tz = threadIdx.x; asm volatile("" : "+v"(_tz)); _Pragma("unroll") for (int _i = 0; _i < 2; ++_i) { int _R, _C; stage_rc(_tz * 16 + _i * 8192, _R, _C); \
        dst[_i] = (unsigned)(S.arow(ui_, u_, (h) * HALF + _R) * K + _C) * 2u; } } while (0)
    Unit cur, nxt; int ui = 0;
    if (!S.next(0, cur)) return;
    f32x4 acc[2][2][4][2];
#pragma unroll
    for (int a = 0; a < 2; ++a)
#pragma unroll
        for (int b = 0; b < 2; ++b)
#pragma unroll
            for (int m = 0; m < 4; ++m)
#pragma unroll
                for (int n = 0; n < 2; ++n) acc[a][b][m][n] = (f32x4){0.f, 0.f, 0.f, 0.f};
    bf16x8 At[4][2], B0[2][2], B1[2][2];
    unsigned vA0[2], vA1[2];
    PG8_AOFF(vA0, 0, cur, 0); PG8_AOFF(vA1, 0, cur, 1);
    const char* cA = (const char*)A; const char* cB = (const char*)Bt + (size_t)cur.pn * tstep;
    PG8_STAGE(PG8_SB(0, 0), cB, voffB); PG8_STAGE(PG8_SB(0, 1), cB + hstep, voffB); PG8_STAGE(PG8_SA(0, 0), cA, vA0); PG8_STAGE(PG8_SA(0, 1), cA, vA1);
    if (wr == 1) PG8_BAR;
    PG8_WAIT_V(2); PG8_BAR;
    PG8_STAGE(PG8_SB(1, 0), cB + kstep, voffB); PG8_STAGE(PG8_SA(1, 0), cA + kstep, vA0); PG8_STAGE(PG8_SB(1, 1), cB + hstep + kstep, voffB);
    PG8_WAIT_V(6); PG8_BAR;
    for (;;) {
        const bool has_next = S.next(ui + 1, nxt);
        const char* nB = has_next ? (const char*)Bt + (size_t)nxt.pn * tstep : cB;
        const int chm = Sched::HALVES ? cur.hm : 0;
        asm volatile(".p2align 8" ::: "memory");
        for (int t = 0; t < nt; t += 2) {
            const bool last = (t == nt - 2);
            const char* a1 = cA + (size_t)(t + 1) * kstep;
            const char* a2 = last ? cA : cA + (size_t)(t + 2) * kstep; const char* b2 = last ? nB : cB + (size_t)(t + 2) * kstep;
            const char* a3 = a2 + kstep; const char* b3 = b2 + kstep;
            if (last && has_next) { PG8_AOFF(vA0, ui + 1, nxt, 0); }
            PG8_LDB(B0, 0, 0); PG8_LDB(B1, 0, 1); PG8_SCHED; PG8_LDA(At, 0, 0); PG8_STAGE(PG8_SA(1, 1), a1, vA1);
            PG8_WAIT_V(8); PG8_WAIT_L(0); PG8_BAR; PG8_MMA(0, 0, At, B0); PG8_MMA(0, 1, At, B1); PG8_BAR; PG8_SCHED;
            if (last && has_next) { PG8_AOFF(vA1, ui + 1, nxt, 1); }
            PG8_LDA(At, 0, 1); PG8_STAGE(PG8_SB(0, 0), b2, voffB); PG8_STAGE(PG8_SB(0, 1), b2 + hstep, voffB); PG8_STAGE(PG8_SA(0, 0), a2, vA0);
            PG8_WAIT_V(8); PG8_WAIT_L(0); PG8_BAR; PG8_SKIP_IF(chm); PG8_MMA(1, 0, At, B0); PG8_MMA(1, 1, At, B1); PG8_SKIP_END; PG8_BAR; PG8_SCHED;
            PG8_LDB(B0, 1, 0); PG8_LDB(B1, 1, 1); PG8_SCHED; PG8_LDA(At, 1, 0); PG8_STAGE(PG8_SA(0, 1), a2, vA1);
            PG8_WAIT_V(8); PG8_WAIT_L(0); PG8_BAR; PG8_MMA(0, 0, At, B0); PG8_MMA(0, 1, At, B1); PG8_BAR; PG8_SCHED;
            PG8_LDA(At, 1, 1); PG8_STAGE(PG8_SB(1, 0), b3, voffB); PG8_STAGE(PG8_SB(1, 1), b3 + hstep, voffB); PG8_STAGE(PG8_SA(1, 0), a3, vA0);
            PG8_WAIT_V(8); PG8_WAIT_L(0); PG8_BAR; PG8_SKIP_IF(chm); PG8_MMA(1, 0, At, B0); PG8_MMA(1, 1, At, B1); PG8_SKIP_END; PG8_BAR; PG8_SCHED;
        }
#ifndef NO_ALIGN_EPI
        if (wr == 0) PG8_BAR;
#endif
        E(acc, cur, wr, wc, fr, fq);
        if (!has_next) break;
#pragma unroll
        for (int a = 0; a < 2; ++a)
#pragma unroll
            for (int b = 0; b < 2; ++b)
#pragma unroll
                for (int m = 0; m < 4; ++m)
#pragma unroll
                    for (int n = 0; n < 2; ++n) acc[a][b][m][n] = (f32x4){0.f, 0.f, 0.f, 0.f};
        cur = nxt; cB = nB; ++ui;
#ifndef NO_ALIGN_EPI
        if (wr == 1) PG8_BAR;
#endif
    }
    PG8_WAIT_V(0);
#ifdef NO_ALIGN_EPI
    if (wr == 0) PG8_BAR;
#endif
    PG8_BAR;
#undef PG8_SA
#undef PG8_SB
#undef PG8_STAGE
#undef PG8_LDA
#undef PG8_LDB
#undef PG8_MMA
#undef PG8_CAT
#undef PG8_WAIT_V
#undef PG8_WAIT_L
#undef PG8_BAR
#undef PG8_SCHED
#undef PG8_SKIP_IF
#undef PG8_SKIP_END
#undef PG8_AOFF
}

struct EpiG1 {
    static constexpr bool PERM = true;
    bf16_t* P; const float* cosT; const float* sinT; int skip;
    __device__ __forceinline__ void operator()(const f32x4 (&acc)[2][2][4][2], const Unit& u, int wr, int wc, int fr, int fq) const {
        const int row0 = u.pm * BM + wr * 64 + fr;
#ifdef PROBE_NULL_EPI
        if (skip) return;
#endif
        if (u.pn < 8) {
            const int i0 = (32 * wc + 8 * fq) & 63, hl = wc >> 1, colb = u.pn * 256 + hl * 128 + i0;
#pragma unroll
            for (int ai = 0; ai < 2; ++ai) {
                f32x4 cs[4][4];
#pragma unroll
                for (int m = 0; m < 4; ++m) { const int pos = (row0 + ai * HALF + m * 16) & (SEQ - 1);
                    cs[m][0] = *(const f32x4*)(cosT + pos * 64 + i0); cs[m][1] = *(const f32x4*)(cosT + pos * 64 + i0 + 4); cs[m][2] = *(const f32x4*)(sinT + pos * 64 + i0); cs[m][3] = *(const f32x4*)(sinT + pos * 64 + i0 + 4); }
                asm volatile("" ::: "memory");
#pragma unroll
                for (int m = 0; m < 4; ++m) { const int row = row0 + ai * HALF + m * 16;
                    const f32x4 c0 = cs[m][0], c1 = cs[m][1], s0 = cs[m][2], s1 = cs[m][3];
                    const float sc = FP8G1 ? (1.0f / 256.0f) : 1.0f; const f32x4 a0 = acc[ai][0][m][0] * sc, a1 = acc[ai][0][m][1] * sc, b0 = acc[ai][1][m][0] * sc, b1 = acc[ai][1][m][1] * sc;
                    const f32x4 o10 = a0 * c0 - b0 * s0, o11 = a1 * c1 - b1 * s1, o20 = a0 * s0 + b0 * c0, o21 = a1 * s1 + b1 * c1;
                    u32x4 w1, w2; w1.x = cvt_pk_bf16(o10[0], o10[1]); w1.y = cvt_pk_bf16(o10[2], o10[3]); w1.z = cvt_pk_bf16(o11[0], o11[1]); w1.w = cvt_pk_bf16(o11[2], o11[3]);
                    w2.x = cvt_pk_bf16(o20[0], o20[1]); w2.y = cvt_pk_bf16(o20[2], o20[3]); w2.z = cvt_pk_bf16(o21[0], o21[1]); w2.w = cvt_pk_bf16(o21[2], o21[3]);
                    bf16_t* rp = P + (size_t)row * INW + colb; *(u32x4*)rp = w1; *(u32x4*)(rp + 64) = w2; }
                asm volatile("" ::: "memory");
            }
        } else {
            const bool act = (u.pn >= 16);
            const int colb = u.pn * 256 + wc * 32 + 8 * fq;
#pragma unroll
            for (int ai = 0; ai < 2; ++ai)
#pragma unroll
                for (int m = 0; m < 4; ++m) { bf16_t* rp = P + (size_t)(row0 + ai * HALF + m * 16) * INW + colb;
#pragma unroll
                    for (int bj = 0; bj < 2; ++bj) { const float sc = FP8G1 ? (1.0f / 256.0f) : 1.0f; f32x4 v0 = acc[ai][bj][m][0] * sc, v1 = acc[ai][bj][m][1] * sc;
                        if (act) {
#pragma unroll
                            for (int j = 0; j < 4; ++j) { v0[j] = gelu_tanh(v0[j]); v1[j] = gelu_tanh(v1[j]); } }
                        u32x4 w; w.x = cvt_pk_bf16(v0[0], v0[1]); w.y = cvt_pk_bf16(v0[2], v0[3]); w.z = cvt_pk_bf16(v1[0], v1[1]); w.w = cvt_pk_bf16(v1[2], v1[3]);
                        *(u32x4*)(rp + bj * HALF) = w; } }
        }
    }
};
struct EpiNull {
    static constexpr bool PERM = true;
    __device__ __forceinline__ void operator()(const f32x4 (&acc)[2][2][4][2], const Unit& u, int wr, int wc, int fr, int fq) const {
#pragma unroll
        for (int ai = 0; ai < 2; ++ai)
#pragma unroll
            for (int bj = 0; bj < 2; ++bj)
#pragma unroll
                for (int m = 0; m < 4; ++m)
#pragma unroll
                    for (int n = 0; n < 2; ++n) asm volatile("" :: "v"(acc[ai][bj][m][n]));
    }
};
struct EpiG2 {
    static constexpr bool PERM = true;
    const bf16_t* xin; bf16_t* x1;
    __device__ __forceinline__ void operator()(const f32x4 (&acc)[2][2][4][2], const Unit& u, int wr, int wc, int fr, int fq) const {
        const int row0 = u.pm * BM + wr * 64 + fr, col0 = u.pn * BM + wc * 32 + 8 * fq;
        u32x4 xv[2][4][2];
#pragma unroll
        for (int ai = 0; ai < 2; ++ai)
#pragma unroll
            for (int m = 0; m < 4; ++m) { const size_t off = (size_t)(row0 + ai * HALF + m * 16) * DM + col0;
#pragma unroll
                for (int bj = 0; bj < 2; ++bj) xv[ai][m][bj] = *(const u32x4*)(xin + off + bj * HALF); }
        asm volatile("" ::: "memory");
#pragma unroll
        for (int ai = 0; ai < 2; ++ai)
#pragma unroll
            for (int m = 0; m < 4; ++m) { const size_t off = (size_t)(row0 + ai * HALF + m * 16) * DM + col0;
#pragma unroll
                for (int bj = 0; bj < 2; ++bj) { const u32x4 x = xv[ai][m][bj]; const float sc = FP8G2 ? (1.0f / 1024.0f) : 1.0f; const f32x4 a0 = acc[ai][bj][m][0] * sc, a1 = acc[ai][bj][m][1] * sc;
                    u32x4 w; w.x = cvt_pk_bf16(bf2f(x.x & 0xffffu) + a0[0], bf2f(x.x >> 16) + a0[1]); w.y = cvt_pk_bf16(bf2f(x.y & 0xffffu) + a0[2], bf2f(x.y >> 16) + a0[3]);
                    w.z = cvt_pk_bf16(bf2f(x.z & 0xffffu) + a1[0], bf2f(x.z >> 16) + a1[1]); w.w = cvt_pk_bf16(bf2f(x.w & 0xffffu) + a1[2], bf2f(x.w >> 16) + a1[3]);
                    *(u32x4*)(x1 + off + bj * HALF) = w; } }
    }
};
struct EpiG3 {
    static constexpr bool PERM = true;
    bf16_t* he; const float* rse; const LAS int* etb;
    __device__ __forceinline__ void operator()(const f32x4 (&acc)[2][2][4][2], const Unit& u, int wr, int wc, int fr, int fq) const {
        const int rl0 = wr * 64 + fr + (u.hm == 2 ? HALF : 0), mt = u.pm - etb[u.e];
        const float* rsp = rse + (size_t)u.e * NTOK + mt * 256;
        const int colb = u.pnl * 128 + wc * 32 + 8 * fq;
        float rsv[2][4];
#pragma unroll
        for (int ai = 0; ai < 2; ++ai) if (ai == 0 || u.hm == 0)
#pragma unroll
            for (int m = 0; m < 4; ++m) rsv[ai][m] = rsp[rl0 + ai * HALF + m * 16];
        asm volatile("" ::: "memory");
#pragma unroll
        for (int ai = 0; ai < 2; ++ai) if (ai == 0 || u.hm == 0)
#pragma unroll
            for (int m = 0; m < 4; ++m) { const int rl = rl0 + ai * HALF + m * 16; const float rs = rsv[ai][m] * (FP8MOE ? (1.0f / 256.0f) : 1.0f);
                const f32x4 g0 = acc[ai][0][m][0] * rs, g1 = acc[ai][0][m][1] * rs, u0 = acc[ai][1][m][0] * rs, u1 = acc[ai][1][m][1] * rs;
                f32x4 h0, h1;
#pragma unroll
                for (int j = 0; j < 4; ++j) { h0[j] = silu(g0[j]) * u0[j]; h1[j] = silu(g1[j]) * u1[j]; }
                if (FP8MOE) { u32x2 w; w.x = pk4_fp8(h0[0] * 8.f, h0[1] * 8.f, h0[2] * 8.f, h0[3] * 8.f); w.y = pk4_fp8(h1[0] * 8.f, h1[1] * 8.f, h1[2] * 8.f, h1[3] * 8.f);
                    *(u32x2*)((unsigned char*)he + (size_t)(u.pm * BM + rl) * DE + colb) = w; }
                else { u32x4 w; w.x = cvt_pk_bf16(h0[0], h0[1]); w.y = cvt_pk_bf16(h0[2], h0[3]); w.z = cvt_pk_bf16(h1[0], h1[1]); w.w = cvt_pk_bf16(h1[2], h1[3]);
                    *(u32x4*)(he + (size_t)(u.pm * BM + rl) * DE + colb) = w; } }
    }
};
struct EpiG4 {
    static constexpr bool PERM = true;
    bf16_t* y;
    __device__ __forceinline__ void operator()(const f32x4 (&acc)[2][2][4][2], const Unit& u, int wr, int wc, int fr, int fq) const {
        const int row0 = u.pm * BM + wr * 64 + fr + (u.hm == 2 ? HALF : 0), colb = u.pnl * 256 + wc * 32 + 8 * fq;
#pragma unroll
        for (int ai = 0; ai < 2; ++ai) if (ai == 0 || u.hm == 0)
#pragma unroll
            for (int m = 0; m < 4; ++m) {
                if (FP8MOE) {
                    const float sc = 1.0f / 128.0f; const f32x4 a = acc[ai][0][m][0] * sc, b = acc[ai][0][m][1] * sc, c2 = acc[ai][1][m][0] * sc, d = acc[ai][1][m][1] * sc;
                    u32x4 w; w.x = pk4_fp8(a[0], a[1], a[2], a[3]); w.y = pk4_fp8(b[0], b[1], b[2], b[3]); w.z = pk4_fp8(c2[0], c2[1], c2[2], c2[3]); w.w = pk4_fp8(d[0], d[1], d[2], d[3]);
                    *(u32x4*)((unsigned char*)y + (size_t)(row0 + ai * HALF + m * 16) * DM + u.pnl * 256 + 64 * wc + 16 * fq) = w; }
                else {
#pragma unroll
                    for (int bj = 0; bj < 2; ++bj) { const f32x4 v0 = acc[ai][bj][m][0], v1 = acc[ai][bj][m][1];
                        u32x4 w; w.x = cvt_pk_bf16(v0[0], v0[1]); w.y = cvt_pk_bf16(v0[2], v0[3]); w.z = cvt_pk_bf16(v1[0], v1[1]); w.w = cvt_pk_bf16(v1[2], v1[3]);
                        *(u32x4*)(y + (size_t)(row0 + ai * HALF + m * 16) * DM + colb + bj * HALF) = w; } } }
    }
};
}

__device__ __forceinline__ int moe_units(const unsigned* ctl, int l, LAS unsigned char* lds, bool gather, const int* tokg) {
    LAS int* etb = (LAS int*)(lds + LDS_EB); LAS int* ul = (LAS int*)(lds + LDS_UL); LAS int* tab = (LAS int*)(lds + LDS_TAB);
    LAS int* nup = (LAS int*)(lds + LDS_UL + 192); LAS int* tl = (LAS int*)(lds + LDS_MISC + 256);
    const int tid = hidden_tid(), G = gridDim.x;
    __syncthreads();
    if (tid == 0) { int acc = 0; for (int e = 0; e < NE; ++e) { etb[e] = acc; acc += ((int)ctl[CW_CNT + (l * NE + e) * 16] + 255) >> 8; } etb[NE] = acc; }
    __syncthreads();
    const int T = etb[NE];
    const int nx = (G % 8 == 0) ? 8 : 1, x = (int)blockIdx.x % nx, rank = (int)blockIdx.x / nx, nrank = G / nx;
    const int lo = (int)((long)x * T / nx), hi = (int)((long)(x + 1) * T / nx), ntl = hi - lo, nun = ntl * 8;
    if (tid < 64) {
        const unsigned long long below = (1ull << tid) - 1ull;
        int nF = 0;
        for (int c0 = 0; c0 < ntl; c0 += 64) { const int mtg = lo + c0 + tid; const bool in = c0 + tid < ntl; bool isH = false;
            if (in) { int e = 0; while (etb[e + 1] <= mtg) ++e; isH = ((int)ctl[CW_CNT + (l * NE + e) * 16] - (mtg - etb[e]) * 256) <= 128; }
            nF += __popcll(__ballot(in && !isH)); }
        int bF = 0, bH = nF;
        for (int c0 = 0; c0 < ntl; c0 += 64) { const int mtg = lo + c0 + tid; const bool in = c0 + tid < ntl; bool isH = false; int e = 0;
            if (in) { while (etb[e + 1] <= mtg) ++e; isH = ((int)ctl[CW_CNT + (l * NE + e) * 16] - (mtg - etb[e]) * 256) <= 128; }
            const unsigned long long mF = __ballot(in && !isH), mH = __ballot(in && isH);
            if (in) tl[1 + (isH ? bH + __popcll(mH & below) : bF + __popcll(mF & below))] = mtg | (e << 16);
            bF += __popcll(mF); bH += __popcll(mH); }
        if (tid == 0) tl[0] = nF;
    }
    __syncthreads();
    const int nF8 = tl[0] * 8, R = nun / nrank, rem = nun - R * nrank;
    int remF = nF8 - R * nrank; remF = remF < 0 ? 0 : (remF > rem ? rem : remF);
    const int remH = rem - remF;
    int lastv = -1, lasthm = 0;
    if (remF > 0 && 2 * remF + remH <= nrank) {
        if (rank < 2 * remF) { lastv = R * nrank + (rank >> 1); lasthm = 1 + (rank & 1); }
        else if (rank < 2 * remF + remH) { lastv = R * nrank + remF + (rank - 2 * remF); lasthm = 1; }
    } else if (rank < rem) { lastv = R * nrank + rank; lasthm = (lastv >= nF8) ? 1 : 0; }
    int nu = R + (lastv >= 0 ? 1 : 0); if (nu > 8) nu = 8;
    if (tid < nu) { int v, hm; if (tid < R) { v = rank + tid * nrank; hm = (v >= nF8) ? 1 : 0; } else { v = lastv; hm = lasthm; }
        const int te = tl[1 + (v >> 3)], mtg = te & 0xffff, e = te >> 16, pnl = v & 7;
        ul[4 * tid + 0] = mtg; ul[4 * tid + 1] = e * 8 + pnl; ul[4 * tid + 2] = e | (hm << 8); ul[4 * tid + 3] = pnl; }
    if (tid == 0) nup[0] = nu;
    __syncthreads();
    if (gather) {
        for (int idx = tid; idx < nu * 256; idx += 512) { const int i = idx >> 8, r = idx & 255; const int mtg = ul[4 * i + 0], e = ul[4 * i + 2] & 255, mt = mtg - etb[e]; const int cnt = (int)ctl[CW_CNT + (l * NE + e) * 16];
            int s = mt * 256 + r; if (s >= cnt) s = cnt - 1; tab[idx] = tokg[(size_t)e * NTOK + s]; }
        __syncthreads();
    }
    return nu;
}

struct CvItem { const float* sa; const float* sb; const float* ks; unsigned char* dst; int o0, o1, o2, o3, ld, K, k0, f8, y16; float cmul; };
constexpr int IT_WIN = NL * 32 * 24, IT_WOUT = NL * 32 * 8, IT_WGU = NL * NE * 32 * 8, IT_WD = NL * NE * 16 * 8, IT_ALL = IT_WIN + IT_WOUT + IT_WGU + IT_WD;
__device__ __forceinline__ void cv_decode(const Ptrs& p, int it, CvItem& c) {
    int r = it;
    if (r < IT_WIN) { const int l = r / (32 * 24), q = r % (32 * 24), kt = q / 24, pn = q % 24; const bool qk = pn < 8;
        c.sa = c.sb = p.w_in + (size_t)l * DM * INW + pn * 256; c.o0 = 0; c.o1 = qk ? 128 : 64; c.o2 = qk ? 64 : 128; c.o3 = 192; c.ld = INW; c.K = DM; c.k0 = kt * 64; c.f8 = FP8G1; c.y16 = 0;
        c.dst = p.ws + WS_WINT + (((size_t)l * INW + pn * 256) * DM) * (FP8G1 ? 1 : 2); c.ks = p.norm1_w + l * DM; c.cmul = ((pn >= 4 && pn < 8) ? 0.08838834764831845f : 1.0f) * (FP8G1 ? 256.0f : 1.0f);
    } else if ((r -= IT_WIN) < IT_WOUT) { const int l = r / (32 * 8), q = r % (32 * 8), kt = q / 8, pn = q % 8;
        c.sa = c.sb = p.w_out + (size_t)l * DM * DM + pn * 256; c.o0 = 0; c.o1 = 64; c.o2 = 128; c.o3 = 192; c.ld = DM; c.K = DM; c.k0 = kt * 64; c.f8 = FP8G2; c.y16 = 0;
        c.dst = p.ws + WS_WOUT + (((size_t)l * DM + pn * 256) * DM) * (FP8G2 ? 1 : 2); c.ks = nullptr; c.cmul = FP8G2 ? 256.0f : 1.0f;
    } else if ((r -= IT_WOUT) < IT_WGU) { const int le = r / (32 * 8), q = r % (32 * 8), kt = q / 8, pn = q % 8, l = le / NE;
        c.sa = p.w_gate + (size_t)le * DM * DE + pn * 128; c.sb = p.w_up + (size_t)le * DM * DE + pn * 128; c.o0 = 0; c.o1 = 64; c.o2 = 0; c.o3 = 64; c.ld = DE; c.K = DM; c.k0 = kt * 64; c.f8 = FP8MOE; c.y16 = 0;
        c.dst = p.ws + WS_WGU + (((size_t)le * 2048 + pn * 256) * DM) * (FP8MOE ? 1 : 2); c.ks = p.norm2_w + l * DM; c.cmul = FP8MOE ? 256.0f : 1.0f;
    } else { r -= IT_WGU; const int le = r / (16 * 8), q = r % (16 * 8), kt = q / 8, pn = q % 8;
        c.sa = c.sb = p.w_down + (size_t)le * DE * DM + pn * 256; c.o0 = 0; c.o1 = 64; c.o2 = 128; c.o3 = 192; c.ld = DM; c.K = DE; c.k0 = kt * 64; c.f8 = FP8MOE; c.y16 = FP8MOE;
        c.dst = p.ws + WS_WD + (((size_t)le * 2048 + pn * 256) * DE) * (FP8MOE ? 1 : 2); c.ks = nullptr; c.cmul = FP8MOE ? 256.0f : 1.0f;
    }
}
__device__ __forceinline__ void cv_load(const CvItem& c, int tid, f32x4 (&v)[8], float (&sc)[8]) {
    const int lane = tid & 63, w = tid >> 6, run = lane >> 4, rc = (lane & 15) * 4;
    const int y16c = 64 * ((lane >> 3) & 3) + 16 * ((lane >> 1) & 3) + 8 * (lane >> 5) + 4 * (lane & 1);
    const float* sp = c.y16 ? c.sa + y16c : (run < 2 ? c.sa : c.sb) + (run == 0 ? c.o0 : run == 1 ? c.o1 : run == 2 ? c.o2 : c.o3) + rc;
#pragma unroll
    for (int i = 0; i < 8; ++i) { const int k = c.k0 + (c.f8 ? 8 * w + i : w + 8 * i); v[i] = __builtin_nontemporal_load(     (const f32x4*)(sp + (size_t)k * c.ld)); sc[i] = (c.ks ? c.ks[k] : 1.0f) * c.cmul; }
}
__device__ __forceinline__ void cv_store(const CvItem& c, LAS unsigned char* lds, int tid, const f32x4 (&v)[8], const float (&sc)[8]) {
    const int lane = tid & 63, w = tid >> 6;
    if (c.f8) {
        unsigned D[8];
#pragma unroll
        for (int i = 0; i < 8; ++i) D[i] = pk4_fp8(v[i].x * sc[i], v[i].y * sc[i], v[i].z * sc[i], v[i].w * sc[i]);
        unsigned T[4][2];
#pragma unroll
        for (int h = 0; h < 2; ++h) {
            const unsigned l01 = __builtin_amdgcn_perm(D[4 * h + 1], D[4 * h + 0], 0x05010400u), h01 = __builtin_amdgcn_perm(D[4 * h + 1], D[4 * h + 0], 0x07030602u);
            const unsigned l23 = __builtin_amdgcn_perm(D[4 * h + 3], D[4 * h + 2], 0x05010400u), h23 = __builtin_amdgcn_perm(D[4 * h + 3], D[4 * h + 2], 0x07030602u);
            T[0][h] = __builtin_amdgcn_perm(l23, l01, 0x05040100u); T[1][h] = __builtin_amdgcn_perm(l23, l01, 0x07060302u);
            T[2][h] = __builtin_amdgcn_perm(h23, h01, 0x05040100u); T[3][h] = __builtin_amdgcn_perm(h23, h01, 0x07060302u); }
#pragma unroll
        for (int e = 0; e < 4; ++e) { u32x2 t; t.x = T[e][0]; t.y = T[e][1]; *(LAS u32x2*)(lds + (4 * lane + e) * 80 + 8 * w) = t; }
        __syncthreads();
#pragma unroll
        for (int pss = 0; pss < 2; ++pss) { const int idx = tid + 512 * pss, tl = idx >> 2, ko = idx & 3;
            const u32x4 o = *(const LAS u32x4*)(lds + tl * 80 + 16 * ko);
            __builtin_nontemporal_store(o, (u32x4*)(c.dst + (size_t)tl * c.K + c.k0 + 16 * ko)); }
    } else {
#pragma unroll
        for (int i = 0; i < 8; ++i) { const int kk = w + 8 * i; LAS unsigned* d = (LAS unsigned*)(lds + kk * 516 + lane * 8);
            d[0] = pk2(v[i].x * sc[i], v[i].y * sc[i]); d[1] = pk2(v[i].z * sc[i], v[i].w * sc[i]); }
        __syncthreads();
#pragma unroll
        for (int pss = 0; pss < 4; ++pss) { const int idx = tid + 512 * pss, tl = idx >> 3, ko = idx & 7;
            const LAS unsigned short* bp = (const LAS unsigned short*)(lds + (8 * ko) * 516 + tl * 2);
            u32x4 o; o.x = (unsigned)bp[0] | ((unsigned)bp[258] << 16); o.y = (unsigned)bp[516] | ((unsigned)bp[774] << 16); o.z = (unsigned)bp[1032] | ((unsigned)bp[1290] << 16); o.w = (unsigned)bp[1548] | ((unsigned)bp[1806] << 16);
            *(u32x4*)(c.dst + ((size_t)tl * c.K + c.k0 + 8 * ko) * 2) = o; }
    }
    __syncthreads();
}
constexpr int TK_L0 = 256, TK_L1 = TK_L0 + 8192 + 4096, TK_L2 = TK_L1 + 768 + 256, TK_N = TK_L2 + 8192 + 4096;
constexpr int CW_TK = 9280, CW_G1D = 9296, CW_MODE = 9344;
constexpr int G1_WGS = 192;
__device__ __forceinline__ int tk_item(int t) {
    if (t < 256) return IT_WIN + t;
    t -= 256; if (t < 8192) return IT_WIN + IT_WOUT + t;
    t -= 8192; if (t < 4096) return IT_WIN + IT_WOUT + IT_WGU + t;
    t -= 4096; if (t < 768) return 768 + t;
    t -= 768; if (t < 256) return IT_WIN + 256 + t;
    t -= 256; if (t < 8192) return IT_WIN + IT_WOUT + 8192 + t;
    t -= 8192; return IT_WIN + IT_WOUT + IT_WGU + 4096 + t;
}
constexpr int TKB = 4, TKBW = 8;
struct TkClaimer {
    unsigned* ctl; LAS unsigned char* lds; unsigned lim; const unsigned* done_word; int base, left, nb;
    __device__ __forceinline__ int operator()() {
        if (left == 0) {
            volatile LAS int* slot = (volatile LAS int*)(lds + LDS_MISC + 192);
            if (threadIdx.x == 0) { int b = -1;
                if (xb_ld(ctl + CW_TK) < lim && (done_word == nullptr || xb_ld((unsigned*)done_word) < (unsigned)G1_WGS)) { const unsigned t = xb_add(ctl + CW_TK, (unsigned)nb); if (t < (unsigned)TK_N) b = (int)t; }
                *slot = b; }
            __syncthreads();
            const int b = *slot;
            __syncthreads();
            if (b < 0) return -1;
            base = b; left = nb;
        }
        const int t = base++; --left;
        return t < TK_N ? tk_item(t) : -1;
    }
};
template <class Next>
__device__ __forceinline__ void convert_stream(const Ptrs& p, LAS unsigned char* lds, Next next) {
    const int tid = hidden_tid();
    CvItem ca0, ca1, cb0, cb1; f32x4 va0[8], va1[8], vb0[8], vb1[8]; float sa0[8], sa1[8], sb0[8], sb1[8];
    int ia0 = next(), ia1 = ia0 >= 0 ? next() : -1;
    if (ia0 < 0) return;
    cv_decode(p, ia0, ca0); cv_load(ca0, tid, va0, sa0);
    if (ia1 >= 0) { cv_decode(p, ia1, ca1); cv_load(ca1, tid, va1, sa1); }
    for (;;) {
        const int ib0 = ia1 >= 0 ? next() : -1, ib1 = ib0 >= 0 ? next() : -1;
        if (ib0 >= 0) { cv_decode(p, ib0, cb0); cv_load(cb0, tid, vb0, sb0); }
        if (ib1 >= 0) { cv_decode(p, ib1, cb1); cv_load(cb1, tid, vb1, sb1); }
        cv_store(ca0, lds, tid, va0, sa0);
        if (ia1 >= 0) cv_store(ca1, lds, tid, va1, sa1);
        if (ib0 < 0) break;
        ia0 = ib1 >= 0 ? next() : -1; ia1 = ia0 >= 0 ? next() : -1;
        if (ia0 >= 0) { cv_decode(p, ia0, ca0); cv_load(ca0, tid, va0, sa0); }
        if (ia1 >= 0) { cv_decode(p, ia1, ca1); cv_load(ca1, tid, va1, sa1); }
        cv_store(cb0, lds, tid, vb0, sb0);
        if (ib1 >= 0) cv_store(cb1, lds, tid, vb1, sb1);
        if (ia0 < 0) break;
    }
}
__device__ __forceinline__ void convert_drain(const Ptrs& p, LAS unsigned char* lds, unsigned* ctl, unsigned lim) {
    asm volatile("s_waitcnt vmcnt(0)" ::: "memory");
    __syncthreads();
    convert_stream(p, lds, TkClaimer{ctl, lds, lim, nullptr, 0, 0, TKB});
}
__device__ __forceinline__ void prologue_phase(const Ptrs& p, LAS unsigned char* lds, int vcu, int G) {
    const int tid = hidden_tid();
    { int it = vcu;
        convert_stream(p, lds, [&]() { const int r = it < 768 ? it : -1; it += G; return r; }); }
    const size_t gt = (size_t)vcu * 512 + tid, gn = (size_t)G * 512;
    bf16_t* wr = (bf16_t*)(p.ws + WS_WR);
    for (size_t i = gt; i < (size_t)NL * 48 * DM; i += gn) { const int l = (int)(i / (48 * DM)), o = (int)(i / DM) % 48, k = (int)(i % DM);
        float w = 0.f; if (o < 4) w = p.rg_w[((size_t)l * DM + k) * NGRP + o]; else if (o < 36) w = p.re_w[((size_t)l * DM + k) * NE + (o - 4)];
        w *= p.norm2_w[l * DM + k];
        const unsigned hi = f2bf(w); const unsigned lo = f2bf(w - bf2f(hi));
        wr[((size_t)(l * 2 + 0) * 48 + o) * DM + k] = (bf16_t)hi; wr[((size_t)(l * 2 + 1) * 48 + o) * DM + k] = (bf16_t)lo; }
    bf16_t* wsb = (bf16_t*)(p.ws + WS_WSB);
    for (size_t i = gt; i < (size_t)NL * GG * 128 * 128; i += gn) wsb[i] = (bf16_t)f2bf(p.w_s[i]);
    float* cosT = (float*)(p.ws + WS_ROPE); float* sinT = cosT + SEQ * 64;
    for (size_t i = gt; i < (size_t)SEQ * 64; i += gn) { const int pos = (int)(i >> 6), ii = (int)(i & 63);
        const float ang = (float)pos * powf(10000.0f, -(float)ii / 64.0f); cosT[i] = cosf(ang); sinT[i] = sinf(ang); }
}

__device__ __forceinline__ void r2_phase(const Ptrs& p, int l, LAS unsigned char* lds, int G) {
    unsigned* ctl = (unsigned*)(p.ws + WS_CTL);
    const int tid = hidden_tid(), lane = tid & 63, w = __builtin_amdgcn_readfirstlane(tid >> 6), r = lane & 15, q4 = lane >> 4, tp = w >> 1, kh = w & 1;
    LAS float* lgp = (LAS float*)lds;
    LAS float* ssq = (LAS float*)(lds + 8 * 16 * 48 * 4);
    LAS int* lcnt = (LAS int*)(lds + 8 * 16 * 48 * 4 + 512);
    LAS int* gbase = lcnt + 32;
    const bf16_t* x1 = (const bf16_t*)(p.ws + WS_X1); bf16_t* h2b = (bf16_t*)(p.ws + WS_H2B);
    const bf16_t* whi = (const bf16_t*)(p.ws + WS_WR) + (size_t)(l * 2 + 0) * 48 * DM; const bf16_t* wlo = (const bf16_t*)(p.ws + WS_WR) + (size_t)(l * 2 + 1) * 48 * DM;
    for (int base = (int)blockIdx.x * 64; base < NTOK; base += G * 64) {
        const int row = base + 16 * tp + r;
        f32x4 acc[3]; acc[0] = acc[1] = acc[2] = (f32x4){0.f, 0.f, 0.f, 0.f}; float ss = 0.f;
        const bf16_t* xr = x1 + (size_t)row * DM + kh * 1024 + 16 * q4; unsigned char* hr8 = (unsigned char*)h2b + (size_t)row * DM + kh * 1024 + 16 * q4; bf16_t* hr = h2b + (size_t)row * DM + kh * 1024 + 16 * q4;
        const bf16_t* bh = whi + (size_t)r * DM + kh * 1024 + 16 * q4; const bf16_t* bl = wlo + (size_t)r * DM + kh * 1024 + 16 * q4;
        constexpr int NBS = 4;
        for (int S0 = 0; S0 < 16; S0 += NBS) {
            u32x4 xq[2 * NBS]; u32x4 h8[NBS];
#pragma unroll
            for (int j = 0; j < 2 * NBS; ++j) xq[j] = *(const u32x4*)(xr + 64 * (S0 + (j >> 1)) + 8 * (j & 1));
#pragma unroll
            for (int j = 0; j < 2 * NBS; ++j) { const int ko = 64 * (S0 + (j >> 1)) + 8 * (j & 1);
                float xv[8]; unpack8(xq[j], xv);
#pragma unroll
                for (int i = 0; i < 8; ++i) ss += xv[i] * xv[i];
                if (j & 1) { h8[j >> 1].z = pk4_fp8(xv[0], xv[1], xv[2], xv[3]); h8[j >> 1].w = pk4_fp8(xv[4], xv[5], xv[6], xv[7]); } else { h8[j >> 1].x = pk4_fp8(xv[0], xv[1], xv[2], xv[3]); h8[j >> 1].y = pk4_fp8(xv[4], xv[5], xv[6], xv[7]); }
                const bf16x8 ahi = __builtin_bit_cast(bf16x8, xq[j]);
#pragma unroll
                for (int nt = 0; nt < 3; ++nt) {
#ifdef R2_HILO
                    const bf16x8 bhi = *(const bf16x8*)(bh + (size_t)nt * 16 * DM + ko), blo = *(const bf16x8*)(bl + (size_t)nt * 16 * DM + ko);
                    acc[nt] = __builtin_amdgcn_mfma_f32_16x16x32_bf16(ahi, bhi, acc[nt], 0, 0, 0);
                    acc[nt] = __builtin_amdgcn_mfma_f32_16x16x32_bf16(ahi, blo, acc[nt], 0, 0, 0);
#else
                    const bf16x8 bhi = *(const bf16x8*)(bh + (size_t)nt * 16 * DM + ko);
                    acc[nt] = __builtin_amdgcn_mfma_f32_16x16x32_bf16(ahi, bhi, acc[nt], 0, 0, 0);
#endif
                }
            }
            asm volatile("" ::: "memory");
#pragma unroll
            for (int j = 0; j < NBS; ++j) { if (FP8MOE) *(u32x4*)(hr8 + 64 * (S0 + j)) = h8[j]; else { *(u32x4*)(hr + 64 * (S0 + j)) = xq[2 * j]; *(u32x4*)(hr + 64 * (S0 + j) + 8) = xq[2 * j + 1]; } }
            asm volatile("" ::: "memory");
        }
#pragma unroll
        for (int nt = 0; nt < 3; ++nt)
#pragma unroll
            for (int rr = 0; rr < 4; ++rr) lgp[(w * 16 + 4 * q4 + rr) * 48 + 16 * nt + r] = acc[nt][rr];
        ss += shx(ss, lane, 16); ss += shx(ss, lane, 32);
        if (q4 == 0) ssq[w * 16 + r] = ss;
        if (tid < 32) lcnt[tid] = 0;
        __syncthreads();
        int e0 = 0, e1 = 0, lp0 = 0, lp1 = 0; float w0 = 0.f, w1 = 0.f, rstd = 0.f;
        const bool router = (kh == 0 && lane < 16);
        const int tokn = base + 16 * tp + lane;
        if (router) {
            rstd = 1.0f / sqrtf((ssq[w * 16 + lane] + ssq[(w + 1) * 16 + lane]) * (1.0f / DM) + EPS);
            LAS float* mine = lgp + (w * 16 + lane) * 48; const LAS float* oth = lgp + ((w + 1) * 16 + lane) * 48;
            for (int o = 0; o < 36; ++o) mine[o] = (mine[o] + oth[o]) * rstd + (o < 4 ? p.rg_b[l * NGRP + o] : p.re_b[l * NE + o - 4]);
            route_token((const LAS float*)mine, e0, e1, w0, w1);
            lp0 = __hip_atomic_fetch_add(&lcnt[e0], 1, __ATOMIC_RELAXED, __HIP_MEMORY_SCOPE_WORKGROUP); lp1 = __hip_atomic_fetch_add(&lcnt[e1], 1, __ATOMIC_RELAXED, __HIP_MEMORY_SCOPE_WORKGROUP);
        }
        __syncthreads();
        if (tid < 32) { const int c = lcnt[tid]; gbase[tid] = c ? (int)__hip_atomic_fetch_add(&ctl[CW_CNT + (l * NE + tid) * 16], (unsigned)c, __ATOMIC_RELAXED, __HIP_MEMORY_SCOPE_AGENT) : 0; }
        __syncthreads();
        if (router) {
            const int s0 = gbase[e0] + lp0, s1 = gbase[e1] + lp1;
            int* tok = (int*)(p.ws + WS_TOK); float* rse = (float*)(p.ws + WS_RSE);
            tok[(size_t)e0 * NTOK + s0] = tokn; rse[(size_t)e0 * NTOK + s0] = rstd; tok[(size_t)e1 * NTOK + s1] = tokn; rse[(size_t)e1 * NTOK + s1] = rstd;
            Rec rc; rc.e0 = e0; rc.s0 = s0; rc.w0 = w0; rc.e1 = e1; rc.s1 = s1; rc.w1 = w1; rc.pad0 = 0; rc.pad1 = 0;
            ((Rec*)(p.ws + WS_REC))[tokn] = rc;
        }
        __syncthreads();
    }
}

typedef short s16x4 __attribute__((ext_vector_type(4)));
__device__ __forceinline__ unsigned off_b(unsigned row, unsigned ch) { return 256u * row + 16u * (ch ^ (((row & 3u) << 2) | ((row >> 2) & 3u))); }
__device__ __forceinline__ unsigned tr_addr(unsigned r0, unsigned c, unsigned lane) { const unsigned q = (lane & 15u) >> 2, pp = lane & 3u; return off_b(r0 + q, 2u * c + (pp >> 1)) + 8u * (pp & 1u); }
__device__ __forceinline__ s16x4 trd(const LAS unsigned char* p) { return __builtin_amdgcn_ds_read_tr16_b64_v4i16((LAS s16x4*)p); }
__device__ __forceinline__ bf16x8 mk8(s16x4 a, s16x4 b) { return __builtin_shufflevector(a, b, 0, 1, 2, 3, 4, 5, 6, 7); }
constexpr unsigned IMG_K = 0, IMG_V = 32768, IMG_S = 65536;
constexpr unsigned BUF_K0 = 0, BUF_V0 = 32768, BUF_K1 = 65536, BUF_V1 = 98304;

__device__ __forceinline__ void load_image(LAS unsigned char* lds, unsigned img, const bf16_t* src, int tid) {
#pragma unroll
    for (int i = 0; i < 4; ++i) { const int idx = tid + 512 * i, row = idx >> 4, ch = idx & 15;
        const u32x4 v = *(const u32x4*)(src + (size_t)row * INW + ch * 8);
        *(LAS u32x4*)(lds + img + off_b(row, ch)) = v; }
}
__device__ __forceinline__ void dma_image(LAS unsigned char* lds, unsigned img, const bf16_t* src, int tid, int wv) {
#pragma unroll
    for (int j = 0; j < 4; ++j) { const unsigned row = 32u * j + ((unsigned)tid >> 4), cp = (unsigned)tid & 15u, cl = cp ^ (((row & 3u) << 2) | ((row >> 2) & 3u));
        __builtin_amdgcn_global_load_lds((const unsigned*)(src + (size_t)row * INW + cl * 8), (LAS unsigned*)(lds + img + (unsigned)(j * 512 + wv * 64) * 16u), 16, 0, 0); }
}
#define MIX_BAR() do { asm volatile("s_waitcnt lgkmcnt(0)" ::: "memory"); __builtin_amdgcn_s_barrier(); asm volatile("" ::: "memory"); } while (0)
struct TrBases { unsigned k0, v0[8], dv; };
__device__ __forceinline__ void make_bases(TrBases& B, int w, int lane) {
    const unsigned q4 = lane >> 4;
    B.k0 = tr_addr(8 * q4, w, lane); B.dv = tr_addr(8 * q4 + 4, 0, lane) - tr_addr(8 * q4, 0, lane);
#pragma unroll
    for (int c = 0; c < 8; ++c) B.v0[c] = tr_addr(8 * q4, c, lane);
}
template <int CB>
__device__ __forceinline__ void kv_chunk(const LAS unsigned char* kimg, const LAS unsigned char* vimg, const TrBases& B, const float (&f0)[8], float g32i, f32x4 (&D)[8], float sk0 = 1.0f) {
    float sk = sk0; unsigned dv = B.dv; asm volatile("" : "+v"(dv));
#pragma unroll
    for (int ks = 0; ks < 4; ++ks) {
        const s16x4 ka = trd(kimg + B.k0 + 8192 * ks), kb = trd(kimg + (B.k0 + dv) + 8192 * ks);
        u32x4 kk;
        kk.x = pk2(bf2f((unsigned short)ka[0]) * (f0[0] * sk), bf2f((unsigned short)ka[1]) * (f0[1] * sk)); kk.y = pk2(bf2f((unsigned short)ka[2]) * (f0[2] * sk), bf2f((unsigned short)ka[3]) * (f0[3] * sk));
        kk.z = pk2(bf2f((unsigned short)kb[0]) * (f0[4] * sk), bf2f((unsigned short)kb[1]) * (f0[5] * sk)); kk.w = pk2(bf2f((unsigned short)kb[2]) * (f0[6] * sk), bf2f((unsigned short)kb[3]) * (f0[7] * sk));
        const bf16x8 af = __builtin_bit_cast(bf16x8, kk);
#pragma unroll
        for (int c4 = 0; c4 < 8; c4 += CB) {
            s16x4 va[CB], vb[CB];
#pragma unroll
            for (int c = 0; c < CB; ++c) { va[c] = trd(vimg + B.v0[c4 + c] + 8192 * ks); vb[c] = trd(vimg + (B.v0[c4 + c] + dv) + 8192 * ks); }
            __builtin_amdgcn_sched_barrier(0);
#pragma unroll
            for (int c = 0; c < CB; ++c) D[c4 + c] = __builtin_amdgcn_mfma_f32_16x16x32_bf16(af, mk8(va[c], vb[c]), D[c4 + c], 0, 0, 0);
            __builtin_amdgcn_sched_barrier(0);
        }
        sk *= g32i;
    }
}
__device__ __forceinline__ void kv_item(const Ptrs& p, LAS unsigned char* lds, int wg) {
    const int tid = hidden_tid(), lane = tid & 63, w = __builtin_amdgcn_readfirstlane(tid >> 6), q4 = lane >> 4;
    const int b = wg >> 6, h = (wg >> 3) & 7, q8 = wg & 7;
    const float lg = log2_gamma(h), g128 = exp2f(lg * 128.0f), g32i = exp2f(-lg * 32.0f);
    const bf16_t* P = (const bf16_t*)(p.ws + WS_P);
    const bf16_t* srcK = P + ((size_t)b * SEQ + q8 * 512) * INW + COL_K + h * 128; const bf16_t* srcV = srcK + (COL_V - COL_K);
    TrBases B; make_bases(B, w, lane);
    float f0[8];
#pragma unroll
    for (int j = 0; j < 8; ++j) f0[j] = exp2f(lg * (float)(127 - 8 * q4 - j));
    f32x4 st[8];
#pragma unroll
    for (int c = 0; c < 8; ++c) st[c] = (f32x4){0.f, 0.f, 0.f, 0.f};
    __syncthreads();
    dma_image(lds, BUF_K0, srcK, tid, w); dma_image(lds, BUF_V0, srcV, tid, w);
    for (int ch = 0; ch < 4; ++ch) {
        const unsigned cur = (ch & 1) ? BUF_K1 : BUF_K0, oth = (ch & 1) ? BUF_K0 : BUF_K1;
        if (ch < 3) { dma_image(lds, oth, srcK + (size_t)(ch + 1) * 128 * INW, tid, w); dma_image(lds, oth + 32768, srcV + (size_t)(ch + 1) * 128 * INW, tid, w);
            asm volatile("s_waitcnt vmcnt(8)" ::: "memory"); }
        else asm volatile("s_waitcnt vmcnt(0)" ::: "memory");
        MIX_BAR();
#pragma unroll
        for (int c = 0; c < 8; ++c) st[c] = st[c] * g128;
        kv_chunk<8>(lds + cur, lds + cur + 32768, B, f0, g32i, st);
        MIX_BAR();
    }
    f32x4* dump = (f32x4*)(p.ws + WS_SSUP) + (size_t)wg * 4096;
#pragma unroll
    for (int c = 0; c < 8; ++c) dump[c * 512 + tid] = st[c];
}
__device__ __forceinline__ void ret_item(const Ptrs& p, int l, LAS unsigned char* lds, int wg) {
    const int tid = hidden_tid(), lane = tid & 63, w = __builtin_amdgcn_readfirstlane(tid >> 6), q4 = lane >> 4, fr = lane & 15;
    const int b = wg >> 6, h = (wg >> 3) & 7, q8 = wg & 7;
    const float lg = log2_gamma(h), g128 = exp2f(lg * 128.0f), g512 = exp2f(lg * 512.0f), g32i = exp2f(-lg * 32.0f);
    const bf16_t* P = (const bf16_t*)(p.ws + WS_P); bf16_t* mix = (bf16_t*)(p.ws + WS_MIX);
    const size_t rowb = (size_t)b * SEQ + q8 * 512;
    const bf16_t* srcK = P + rowb * INW + COL_K + h * 128; const bf16_t* srcV = srcK + (COL_V - COL_K);
    __syncthreads();
    dma_image(lds, BUF_K0, srcK, tid, w); dma_image(lds, BUF_V0, srcV, tid, w);
    TrBases B; make_bases(B, w, lane);
    float f0[8];
#pragma unroll
    for (int j = 0; j < 8; ++j) f0[j] = exp2f(lg * (float)(127 - 8 * q4 - j));
    unsigned kb0[4], sb[4];
    const unsigned kr = 8 * (fr >> 2) + (fr & 3);
#pragma unroll
    for (int ks = 0; ks < 4; ++ks) { kb0[ks] = off_b(kr, 4 * ks + q4); sb[ks] = off_b(fr, 4 * ks + q4); }
    const unsigned dk = off_b(kr + 4, q4) - off_b(kr, q4);
    const unsigned stw = off_b(fr, 2 * w + (q4 >> 1)) + 8 * (q4 & 1);
    const int t = 16 * w + fr;
    const float gq = exp2f(lg * (float)(t + 1));
    bf16x8 qf[4];
#pragma unroll
    for (int ks = 0; ks < 4; ++ks) qf[ks] = *(const bf16x8*)(P + (rowb + t) * INW + COL_Q + h * 128 + 32 * ks + 8 * q4);
    LAS float* gnw = (LAS float*)(lds + LDS_TAB);
    if (tid < 128) gnw[tid] = p.ret_gn_w[l * 1024 + h * 128 + tid];
    f32x4 st[8];
#pragma unroll
    for (int c = 0; c < 8; ++c) st[c] = (f32x4){0.f, 0.f, 0.f, 0.f};
    for (int q0 = 0; q0 < q8; q0 += 4) {
        const f32x4* dump = (const f32x4*)(p.ws + WS_SSUP) + (size_t)(wg - q8 + q0) * 4096 + tid;
        f32x4 dv[4][8]; const int nq = q8 - q0;
#pragma unroll
        for (int i = 0; i < 4; ++i) if (i < nq) {
#pragma unroll
            for (int c = 0; c < 8; ++c) dv[i][c] = dump[(size_t)i * 4096 + c * 512]; }
#pragma unroll
        for (int i = 0; i < 4; ++i) if (i < nq) {
#pragma unroll
            for (int c = 0; c < 8; ++c) st[c] = st[c] * g512 + dv[i][c]; }
    }
    for (int ch = 0; ch < 4; ++ch) {
        const size_t row0 = rowb + ch * 128;
        const unsigned cur = (ch & 1) ? BUF_K1 : BUF_K0, oth = (ch & 1) ? BUF_K0 : BUF_K1;
        const LAS unsigned char* kimg = lds + cur; const LAS unsigned char* vimg = lds + cur + 32768; LAS unsigned char* simg = lds + oth + 32768;
        asm volatile("s_waitcnt vmcnt(0)" ::: "memory");
        MIX_BAR();
#pragma unroll
        for (int c = 0; c < 8; ++c) { u32x2 wv; wv.x = pk2(st[c][0], st[c][1]); wv.y = pk2(st[c][2], st[c][3]); *(LAS u32x2*)(simg + stw + 4096 * c) = wv; }
        if (ch < 3) dma_image(lds, oth, srcK + (size_t)(ch + 1) * 128 * INW, tid, w);
        u32x2 gv8[8];
#pragma unroll
        for (int c = 0; c < 8; ++c) gv8[c] = *(const u32x2*)(P + (row0 + t) * INW + COL_G + h * 128 + 16 * c + 4 * q4);
        MIX_BAR();
        f32x4 O[8];
#pragma unroll
        for (int c2 = 0; c2 < 8; c2 += 2) {
            bf16x8 sa[2][4];
#pragma unroll
            for (int c = 0; c < 2; ++c)
#pragma unroll
                for (int ks = 0; ks < 4; ++ks) sa[c][ks] = *(const LAS bf16x8*)(simg + sb[ks] + 4096 * (c2 + c));
            __builtin_amdgcn_sched_barrier(0);
#pragma unroll
            for (int c = 0; c < 2; ++c) { O[c2 + c] = (f32x4){0.f, 0.f, 0.f, 0.f};
#pragma unroll
                for (int ks = 0; ks < 4; ++ks) O[c2 + c] = __builtin_amdgcn_mfma_f32_16x16x32_bf16(sa[c][ks], qf[ks], O[c2 + c], 0, 0, 0);
                O[c2 + c] = O[c2 + c] * gq; }
            __builtin_amdgcn_sched_barrier(0);
        }
        MIX_BAR();
        if (ch < 3) dma_image(lds, oth + 32768, srcV + (size_t)(ch + 1) * 128 * INW, tid, w);
#ifdef RP_I
        for (int rr = 0; rr < 1 + RP_I; ++rr) { float zf = rr ? 0.f : 1.f; asm volatile("" : "+v"(zf));
#else
        { const float zf = 1.f;
#endif
        for (int stp = 0; stp <= (w >> 1); ++stp) {
            f32x4 T0 = (f32x4){0.f, 0.f, 0.f, 0.f}, T1 = T0;
            const LAS unsigned char* kst = kimg + 8192 * stp; const LAS unsigned char* vst = vimg + 8192 * stp; unsigned dvl = B.dv, dkl = dk; asm volatile("" : "+v"(dvl), "+v"(dkl));
            bf16x8 a0[4], a1[4];
#pragma unroll
            for (int ks = 0; ks < 4; ++ks) { a0[ks] = *(const LAS bf16x8*)(kst + kb0[ks]); a1[ks] = *(const LAS bf16x8*)(kst + (kb0[ks] + dkl)); }
            __builtin_amdgcn_sched_barrier(0);
#pragma unroll
            for (int ks = 0; ks < 4; ++ks) { T0 = __builtin_amdgcn_mfma_f32_16x16x32_bf16(a0[ks], qf[ks], T0, 0, 0, 0); T1 = __builtin_amdgcn_mfma_f32_16x16x32_bf16(a1[ks], qf[ks], T1, 0, 0, 0); }
            float pv[8];
#pragma unroll
            for (int r = 0; r < 4; ++r) { const int s0 = 32 * stp + 8 * q4 + r, s1 = s0 + 4;
                pv[r] = (t >= s0) ? T0[r] * (zf * exp2f(lg * (float)(t - s0))) : 0.f; pv[4 + r] = (t >= s1) ? T1[r] * (zf * exp2f(lg * (float)(t - s1))) : 0.f; }
            u32x4 pk; pk.x = pk2(pv[0], pv[1]); pk.y = pk2(pv[2], pv[3]); pk.z = pk2(pv[4], pv[5]); pk.w = pk2(pv[6], pv[7]);
            const bf16x8 pf = __builtin_bit_cast(bf16x8, pk);
#pragma unroll
            for (int c4 = 0; c4 < 8; c4 += 4) {
                s16x4 va[4], vb[4];
#pragma unroll
                for (int c = 0; c < 4; ++c) { va[c] = trd(vst + B.v0[c4 + c]); vb[c] = trd(vst + (B.v0[c4 + c] + dvl)); }
                __builtin_amdgcn_sched_barrier(0);
#pragma unroll
                for (int c = 0; c < 4; ++c) O[c4 + c] = __builtin_amdgcn_mfma_f32_16x16x32_bf16(mk8(va[c], vb[c]), pf, O[c4 + c], 0, 0, 0);
                __builtin_amdgcn_sched_barrier(0);
            }
        }
        }
        if (ch < 3) {
#pragma unroll
            for (int ks = 0; ks < 4; ++ks) qf[ks] = *(const bf16x8*)(P + (row0 + 128 + t) * INW + COL_Q + h * 128 + 32 * ks + 8 * q4); }
#ifdef RP_L
        for (int rr = 0; rr < 1 + RP_L; ++rr) { asm volatile("" : "+v"(O[0]));
#else
        {
#endif
        { float s = 0.f;
#pragma unroll
          for (int c = 0; c < 8; ++c) s += (O[c][0] + O[c][1]) + (O[c][2] + O[c][3]);
          s += shx(s, lane, 16); s += shx(s, lane, 32);
          const float mu = s * (1.0f / 128.0f); float qv = 0.f;
#pragma unroll
          for (int c = 0; c < 8; ++c) { const f32x4 d = O[c] - mu; qv += (d[0] * d[0] + d[1] * d[1]) + (d[2] * d[2] + d[3] * d[3]); }
          qv += shx(qv, lane, 16); qv += shx(qv, lane, 32);
          const float rs = 1.0f / sqrtf(qv * (1.0f / 128.0f) + EPS);
          const size_t row = row0 + t;
#pragma unroll
          for (int c = 0; c < 8; ++c) { const int e0 = h * 128 + 16 * c + 4 * q4;
              const u32x2 gv = gv8[c]; const f32x4 gw = *(const LAS f32x4*)(gnw + 16 * c + 4 * q4);
              const float g0 = bf2f(gv.x & 0xffffu), g1 = bf2f(gv.x >> 16), g2 = bf2f(gv.y & 0xffffu), g3 = bf2f(gv.y >> 16);
              const float m0 = silu(g0) * ((O[c][0] - mu) * rs * gw[0]), m1 = silu(g1) * ((O[c][1] - mu) * rs * gw[1]), m2 = silu(g2) * ((O[c][2] - mu) * rs * gw[2]), m3 = silu(g3) * ((O[c][3] - mu) * rs * gw[3]);
              if (FP8G2) *(unsigned*)((unsigned char*)mix + row * DM + e0) = pk4_fp8(m0 * 4.f, m1 * 4.f, m2 * 4.f, m3 * 4.f);
              else { u32x2 o; o.x = pk2(m0, m1); o.y = pk2(m2, m3); *(u32x2*)(mix + row * DM + e0) = o; } } }
        }
#pragma unroll
        for (int c = 0; c < 8; ++c) st[c] = st[c] * g128;
        kv_chunk<4>(kimg, vimg, B, f0, g32i, st);
#ifdef RP_K
        for (int rr = 0; rr < RP_K; ++rr) { float zf = 0.f; asm volatile("" : "+v"(zf)); kv_chunk<4>(kimg, vimg, B, f0, g32i, st, zf); }
#endif
    }
    MIX_BAR();
}
__device__ __forceinline__ float dpp_sum16(float v) {
    int x;
    x = __builtin_amdgcn_update_dpp(0, __builtin_bit_cast(int, v), 0xB1, 0xF, 0xF, true); v += __builtin_bit_cast(float, x);
    x = __builtin_amdgcn_update_dpp(0, __builtin_bit_cast(int, v), 0x4E, 0xF, 0xF, true); v += __builtin_bit_cast(float, x);
    x = __builtin_amdgcn_update_dpp(0, __builtin_bit_cast(int, v), 0x141, 0xF, 0xF, true); v += __builtin_bit_cast(float, x);
    x = __builtin_amdgcn_update_dpp(0, __builtin_bit_cast(int, v), 0x140, 0xF, 0xF, true); v += __builtin_bit_cast(float, x);
    return v;
}
__device__ __forceinline__ void gmlp_fetch(const Ptrs& p, int it, int tid, u32x4 (&vq)[4]) {
    const int b = it >> 8, nb = (it >> 3) & 31, g = it & 7;
    const bf16_t* src = (const bf16_t*)(p.ws + WS_P) + ((size_t)b * SEQ + nb * 128) * INW;
#pragma unroll
    for (int i = 0; i < 4; ++i) { const int idx = tid + 512 * i, row = idx >> 4, ch = idx & 15; vq[i] = *(const u32x4*)(src + (size_t)row * INW + COL_VS + g * 128 + ch * 8); }
}
__device__ __forceinline__ void gmlp_items(const Ptrs& p, int l, LAS unsigned char* lds, int first, int G) {
    const int tid = hidden_tid(), lane = tid & 63, w = __builtin_amdgcn_readfirstlane(tid >> 6), q4 = lane >> 4, fr = lane & 15;
    bf16_t* mix = (bf16_t*)(p.ws + WS_MIX);
    const int ucol = 16 * w + 4 * q4;
    u32x4 vq[4];
    if (first < 1024) gmlp_fetch(p, first, tid, vq);
    int gcur = -1; float bs[8]; f32x4 n0, n1;
    const unsigned long long tpA = TP_NOW();
    for (int it = first; it < 1024; it += G) {
        const int b = it >> 8, nb = (it >> 3) & 31, g = it & 7;
        const size_t row0 = (size_t)b * SEQ + nb * 128;
        const unsigned long long tpB = TP_NOW();
        if (g != gcur) {
            gcur = g;
            const bf16_t* Wm = (const bf16_t*)(p.ws + WS_WSB) + ((size_t)l * GG + g) * 128 * 128;
            __syncthreads();
#pragma unroll
            for (int i = 0; i < 4; ++i) { const int idx = tid + 512 * i, row = idx >> 4, ch = idx & 15; *(LAS u32x4*)(lds + IMG_V + off_b(row, ch)) = *(const u32x4*)(Wm + (size_t)row * 128 + ch * 8); }
#pragma unroll
            for (int tt = 0; tt < 8; ++tt) bs[tt] = p.b_s[((size_t)l * GG + g) * 128 + 16 * tt + fr];
            n0 = *(const f32x4*)(p.gmlp_norm_w + l * 1024 + g * 128 + (tid & 15) * 8); n1 = *(const f32x4*)(p.gmlp_norm_w + l * 1024 + g * 128 + (tid & 15) * 8 + 4);
        }
        __syncthreads();
#ifdef GP_A
        for (int rr = 0; rr < GP_A; ++rr)
#endif
#pragma unroll
        for (int i = 0; i < 4; ++i) { const int idx = tid + 512 * i, row = idx >> 4, ch = idx & 15;
            float x[8]; unpack8(vq[i], x);
#ifdef GP_A
            asm volatile("" : "+v"(x[0]));
#endif
            float s = 0.f;
#pragma unroll
            for (int j = 0; j < 8; ++j) s += x[j];
            s = dpp_sum16(s);
            const float mu = s * (1.0f / 128.0f); float qv = 0.f;
#pragma unroll
            for (int j = 0; j < 8; ++j) { x[j] -= mu; qv += x[j] * x[j]; }
            qv = dpp_sum16(qv);
            const float rs = __builtin_amdgcn_rsqf(qv * (1.0f / 128.0f) + EPS);
            u32x4 o; o.x = pk2(x[0] * rs * n0[0], x[1] * rs * n0[1]); o.y = pk2(x[2] * rs * n0[2], x[3] * rs * n0[3]); o.z = pk2(x[4] * rs * n1[0], x[5] * rs * n1[1]); o.w = pk2(x[6] * rs * n1[2], x[7] * rs * n1[3]);
            *(LAS u32x4*)(lds + IMG_K + off_b(row, ch)) = o; }
        u32x2 uv[8];
#pragma unroll
        for (int tt = 0; tt < 8; ++tt) uv[tt] = *(const u32x2*)((const bf16_t*)(p.ws + WS_P) + (row0 + 16 * tt + fr) * INW + COL_U + g * 128 + ucol);
        if (it + G < 1024) gmlp_fetch(p, it + G, tid, vq);
        __syncthreads();
        if (l == 0) TP_ADD(CW_TB, tpB);
        const unsigned tb0 = IMG_K + tr_addr(8 * q4, w, lane), tb1 = IMG_K + tr_addr(8 * q4 + 4, w, lane);
        bf16x8 af[4];
#pragma unroll
        for (int ks = 0; ks < 4; ++ks) af[ks] = mk8(trd(lds + tb0 + 8192 * ks), trd(lds + tb1 + 8192 * ks));
        unsigned wmb[4];
#pragma unroll
        for (int ks = 0; ks < 4; ++ks) wmb[ks] = off_b(fr, 4 * ks + q4);
        f32x4 Z[8];
#ifdef GP_B
        for (int rr = 0; rr < GP_B; ++rr) { asm volatile("" : "+v"(wmb[0]));
#endif
#pragma unroll
        for (int tt = 0; tt < 8; ++tt) {
            Z[tt] = (f32x4){0.f, 0.f, 0.f, 0.f};
#pragma unroll
            for (int ks = 0; ks < 4; ++ks) { if (tt < 4 && ks >= 2) continue;
                const bf16x8 bw = *(const LAS bf16x8*)(lds + IMG_V + wmb[ks] + 4096 * tt);
                Z[tt] = __builtin_amdgcn_mfma_f32_16x16x32_bf16(af[ks], bw, Z[tt], 0, 0, 0); }
        }
#ifdef GP_B
        }
#endif
        const int c0 = g * 128 + ucol;
#ifdef GP_C
        for (int rr = 0; rr < GP_C; ++rr) { asm volatile("" : "+v"(Z[0]));
#endif
#pragma unroll
        for (int tt = 0; tt < 8; ++tt) { const size_t row = row0 + 16 * tt + fr;
            const float m0 = bf2f(uv[tt].x & 0xffffu) * (Z[tt][0] + bs[tt]), m1 = bf2f(uv[tt].x >> 16) * (Z[tt][1] + bs[tt]), m2 = bf2f(uv[tt].y & 0xffffu) * (Z[tt][2] + bs[tt]), m3 = bf2f(uv[tt].y >> 16) * (Z[tt][3] + bs[tt]);
            if (FP8G2) *(unsigned*)((unsigned char*)mix + row * DM + 1024 + c0) = pk4_fp8(m0 * 4.f, m1 * 4.f, m2 * 4.f, m3 * 4.f);
            else { u32x2 o; o.x = pk2(m0, m1); o.y = pk2(m2, m3); *(u32x2*)(mix + row * DM + 1024 + c0) = o; } }
#ifdef GP_C
        }
#endif
    }
    if (l == 0) TP_ADD(CW_TA, tpA);
}

template <int MODE, class EB>
__device__ __forceinline__ void row_phase2(const Ptrs& p, const void* srcv, bf16_t* xres  , bf16_t* xb, const Rec* rec, const bf16_t* y, EB ebase, int gw, int ngw, int lane) {
    for (int row = gw; row < NTOK; row += ngw) {
        float v[4][8];
        if (MODE == 0) { const f32x4* xr = (const f32x4*)((const float*)srcv + (size_t)row * DM) + 2 * lane;
#pragma unroll
            for (int j = 0; j < 4; ++j) { const f32x4 a = __builtin_nontemporal_load(xr + 128 * j), b = __builtin_nontemporal_load(xr + 128 * j + 1); v[j][0] = a.x; v[j][1] = a.y; v[j][2] = a.z; v[j][3] = a.w; v[j][4] = b.x; v[j][5] = b.y; v[j][6] = b.z; v[j][7] = b.w; }
        } else {
            const Rec r = rec[row];
            const size_t r0 = (size_t)(ebase[r.e0] + r.s0), r1 = (size_t)(ebase[r.e1] + r.s1);
            const u32x4* xr = (const u32x4*)((const bf16_t*)srcv + (size_t)row * DM) + lane;
            u32x4 xv[4];
#pragma unroll
            for (int j = 0; j < 4; ++j) xv[j] = __builtin_nontemporal_load(xr + 64 * j);
            if (FP8MOE) {
                const u32x2* y0 = (const u32x2*)((const unsigned char*)y + r0 * DM) + lane; const u32x2* y1 = (const u32x2*)((const unsigned char*)y + r1 * DM) + lane;
                u32x2 av[4], bv[4]; const float w0 = r.w0 * (1.0f / 16.0f), w1 = r.w1 * (1.0f / 16.0f);
#pragma unroll
                for (int j = 0; j < 4; ++j) { av[j] = __builtin_nontemporal_load(y0 + 64 * j); bv[j] = __builtin_nontemporal_load(y1 + 64 * j); }
#pragma unroll
                for (int j = 0; j < 4; ++j) { float a[8], b[8]; unpack8(xv[j], v[j]); unpack8_fp8(av[j], a); unpack8_fp8(bv[j], b);
#pragma unroll
                    for (int i = 0; i < 8; ++i) v[j][i] += w0 * a[i] + w1 * b[i]; }
            } else {
                const u32x4* y0 = (const u32x4*)(y + r0 * DM) + lane; const u32x4* y1 = (const u32x4*)(y + r1 * DM) + lane;
                u32x4 av[4], bv[4];
#pragma unroll
                for (int j = 0; j < 4; ++j) { av[j] = y0[64 * j]; bv[j] = y1[64 * j]; }
#pragma unroll
                for (int j = 0; j < 4; ++j) { float a[8], b[8]; unpack8(xv[j], v[j]); unpack8(av[j], a); unpack8(bv[j], b);
#pragma unroll
                    for (int i = 0; i < 8; ++i) v[j][i] += r.w0 * a[i] + r.w1 * b[i]; }
            }
        }
        float s = 0.f;
#pragma unroll
        for (int j = 0; j < 4; ++j)
#pragma unroll
            for (int i = 0; i < 8; ++i) s += v[j][i] * v[j][i];
        const float rstd = 1.0f / sqrtf(wave_sum_l(s, lane) * (1.0f / DM) + EPS);
        if (MODE <= 1) { u32x4* o = (u32x4*)(xres + (size_t)row * DM) + lane; u32x4* o2 = (u32x4*)(xb + (size_t)row * DM) + lane;
#pragma unroll
            for (int j = 0; j < 4; ++j) { __builtin_nontemporal_store(pack8(v[j]), o + 64 * j); float n[8];
#pragma unroll
                for (int i = 0; i < 8; ++i) n[i] = v[j][i] * rstd;
                if (FP8G1) { u32x2 w8; w8.x = pk4_fp8(n[0], n[1], n[2], n[3]); w8.y = pk4_fp8(n[4], n[5], n[6], n[7]); *((u32x2*)((unsigned char*)xb + (size_t)row * DM) + lane + 64 * j) = w8; }
                else o2[64 * j] = pack8(n); } }
#ifdef TIMER_PROBE
        float tp_scale = 1.0f, tp_spike = 0.f;
        if (MODE == 2) { const unsigned* cw = (const unsigned*)(p.ws + WS_CTL); tp_scale = 1.0f + sqrtf((float)cw[CW_TA] * 1e-5f); if (row == 0 && lane == 0) tp_spike = (float)cw[CW_TB]; }
#else
        const float tp_scale = 1.0f, tp_spike = 0.f;
#endif
        if (MODE == 2) { f32x4* o = (f32x4*)(p.out + (size_t)row * DM) + 2 * lane; const f32x4* fw = (const f32x4*)p.final_w + 2 * lane;
#pragma unroll
            for (int j = 0; j < 4; ++j) { const f32x4 f0 = fw[128 * j], f1 = fw[128 * j + 1];
                __builtin_nontemporal_store((f32x4){v[j][0] * rstd * f0.x * tp_scale + (j == 0 ? tp_spike : 0.f), v[j][1] * rstd * f0.y * tp_scale, v[j][2] * rstd * f0.z * tp_scale, v[j][3] * rstd * f0.w * tp_scale}, o + 128 * j);
                __builtin_nontemporal_store((f32x4){v[j][4] * rstd * f1.x * tp_scale, v[j][5] * rstd * f1.y * tp_scale, v[j][6] * rstd * f1.z * tp_scale, v[j][7] * rstd * f1.w * tp_scale}, o + 128 * j + 1); } }
    }
}

template <class EB>
__device__ __forceinline__ void rp_fetch(const bf16_t* srcb, const unsigned char* y8, const Rec& r, EB ebase, int row, int lane, u32x4 (&xv)[4], u32x2 (&av)[4], u32x2 (&bv)[4]) {
    const size_t r0 = (size_t)(ebase[r.e0] + r.s0), r1 = (size_t)(ebase[r.e1] + r.s1);
    const u32x4* xr = (const u32x4*)(srcb + (size_t)row * DM) + lane; const u32x2* y0 = (const u32x2*)(y8 + r0 * DM) + lane; const u32x2* y1 = (const u32x2*)(y8 + r1 * DM) + lane;
#pragma unroll
    for (int j = 0; j < 4; ++j) { xv[j] = __builtin_nontemporal_load(xr + 64 * j); av[j] = __builtin_nontemporal_load(y0 + 64 * j); bv[j] = __builtin_nontemporal_load(y1 + 64 * j); }
}
template <int MODE, class EB>
__device__ __forceinline__ void row_phase3(const Ptrs& p, const bf16_t* srcb, bf16_t* xres, bf16_t* xb, const Rec* rec, const unsigned char* y8, EB ebase, int gw, int ngw, int lane) {
    int row = gw; if (row >= NTOK) return;
    Rec rc = rec[row]; Rec rn = rc; if (row + ngw < NTOK) rn = rec[row + ngw];
    u32x4 xv[4]; u32x2 av[4], bv[4];
    rp_fetch(srcb, y8, rc, ebase, row, lane, xv, av, bv);
    for (;;) {
        const int nrow = row + ngw; const bool hn = nrow < NTOK;
        u32x4 xn[4]; u32x2 an[4], bn[4]; Rec rnn = rn;
        if (hn) { rp_fetch(srcb, y8, rn, ebase, nrow, lane, xn, an, bn); if (nrow + ngw < NTOK) rnn = rec[nrow + ngw]; }
        float v[4][8]; const float w0 = rc.w0 * (1.0f / 16.0f), w1 = rc.w1 * (1.0f / 16.0f);
#pragma unroll
        for (int j = 0; j < 4; ++j) { float a[8], b[8]; unpack8(xv[j], v[j]); unpack8_fp8(av[j], a); unpack8_fp8(bv[j], b);
#pragma unroll
            for (int i = 0; i < 8; ++i) v[j][i] += w0 * a[i] + w1 * b[i]; }
        float s = 0.f;
#pragma unroll
        for (int j = 0; j < 4; ++j)
#pragma unroll
            for (int i = 0; i < 8; ++i) s += v[j][i] * v[j][i];
        const float rstd = 1.0f / sqrtf(wave_sum_l(s, lane) * (1.0f / DM) + EPS);
        if (MODE == 1) { u32x4* o = (u32x4*)(xres + (size_t)row * DM) + lane; u32x4* o2 = (u32x4*)(xb + (size_t)row * DM) + lane;
#pragma unroll
            for (int j = 0; j < 4; ++j) { __builtin_nontemporal_store(pack8(v[j]), o + 64 * j); float n[8];
#pragma unroll
                for (int i = 0; i < 8; ++i) n[i] = v[j][i] * rstd;
                o2[64 * j] = pack8(n); } }
        if (MODE == 2) { f32x4* o = (f32x4*)(p.out + (size_t)row * DM) + 2 * lane; const f32x4* fw = (const f32x4*)p.final_w + 2 * lane;
#pragma unroll
            for (int j = 0; j < 4; ++j) { const f32x4 f0 = fw[128 * j], f1 = fw[128 * j + 1];
                __builtin_nontemporal_store((f32x4){v[j][0] * rstd * f0.x, v[j][1] * rstd * f0.y, v[j][2] * rstd * f0.z, v[j][3] * rstd * f0.w}, o + 128 * j);
                __builtin_nontemporal_store((f32x4){v[j][4] * rstd * f1.x, v[j][5] * rstd * f1.y, v[j][6] * rstd * f1.z, v[j][7] * rstd * f1.w}, o + 128 * j + 1); } }
        if (!hn) break;
#pragma unroll
        for (int j = 0; j < 4; ++j) { xv[j] = xn[j]; av[j] = an[j]; bv[j] = bn[j]; }
        rc = rn; rn = rnn; row = nrow;
    }
}

constexpr int NPH = 1 + 8 * NL;
struct MegaArgs { Ptrs p; int ph_lo, ph_hi, use_bar, pad; };
__global__ void __launch_bounds__(NWAVES * 64, 2) k_mega(MegaArgs a) {
    extern __shared__ __attribute__((aligned(16))) unsigned char lds_raw[];
    LAS unsigned char* lds = (LAS unsigned char*)lds_raw;
    const Ptrs& p = a.p;
    const int tid = threadIdx.x;
    const int G = gridDim.x; const int bx = blockIdx.x; const int vcu = (G % 8 == 0) ? (bx % 8) * (G / 8) + bx / 8 : bx;
    unsigned* ctl = (unsigned*)(p.ws + WS_CTL);
    volatile LAS unsigned* MISC = (volatile LAS unsigned*)(lds + LDS_MISC);
    if (tid < 32) MISC[tid] = 0u;
    __syncthreads();
    XcdBarrier bar; bar.bar = ctl + CW_BAR; bar.x = 0; bar.st = MISC + 8;
    if (a.use_bar) bar = xcd_barrier_post(ctl + CW_BAR, MISC + 8);
    const int lo = a.ph_lo, hi = a.ph_hi;
#ifndef PHSEL
#define PHSEL 0xff
#endif
#define IN(k) (lo <= (k) && (k) < hi)
#define SEL(j) ((PHSEL >> (j)) & 1)
#ifndef REPEAT_MASK
#define REPEAT_MASK 0
#endif
#define NREP(j) (((REPEAT_MASK >> (j)) & 1) ? 2 : 1)
#define SEAM(k) do { if (IN((k) + 1)) xcd_barrier(bar); } while (0)
    const int ngw = G * NWAVES;
#define ROWIDS() const int _ht = hidden_tid(); const int lane_ = _ht & 63, gw_ = vcu * NWAVES + (_ht >> 6)
    if (IN(0)) for (int rep = 0; rep < NREP(8); ++rep) {
        prologue_phase(p, lds, vcu, G);
        { ROWIDS(); row_phase2<0>(p, p.x, (bf16_t*)(p.ws + WS_X0B), (bf16_t*)(p.ws + WS_XB), nullptr, nullptr, (const int*)nullptr, gw_, ngw, lane_); }
        SEAM(0);
    }
    for (int l = 0; l < NL; ++l) {
        const int pb = 1 + 8 * l;
        if (SEL(0) && IN(pb + 0)) {
            const bool win = (G == 256) && (l == 0 || xb_ld(ctl + CW_MODE) != 0u);
            if (!win || bx < G1_WGS) {
                pg8::DenseOrder S; S.init(NTOK, INW, win ? G1_WGS : G, bx);
                pg8::EpiG1 E{(bf16_t*)(p.ws + WS_P), (const float*)(p.ws + WS_ROPE), (const float*)(p.ws + WS_ROPE) + SEQ * 64, 0};
                pg8::gemm_phase<false>(lds, (const bf16_t*)(p.ws + WS_XB), (const bf16_t*)(p.ws + WS_WINT) + (size_t)l * INW * DM, DM, S, E);
                if (win && tid == 0) (void)xb_add(ctl + CW_G1D + l * 16, 1u);
            } else {
                const unsigned* dw = ctl + CW_G1D + l * 16;
                convert_stream(p, lds, TkClaimer{ctl, lds, (unsigned)TK_N, dw, 0, 0, TKBW});
            }
            SEAM(pb + 0);
        }
        if (SEL(1) && IN(pb + 1)) for (int rep = 0; rep < NREP(1); ++rep) {
            for (int it = bx; it < 256; it += G) kv_item(p, lds, it);
            gmlp_items(p, l, lds, bx, G);
            SEAM(pb + 1);
        }
        if (SEL(2) && IN(pb + 2)) for (int rep = 0; rep < NREP(2); ++rep) {
            for (int it = bx; it < 256; it += G) ret_item(p, l, lds, it);
            convert_drain(p, lds, ctl, l == 0 ? (unsigned)TK_L0 : (unsigned)TK_L2);
            SEAM(pb + 2);
        }
        if (SEL(3) && IN(pb + 3)) for (int rep = 0; rep < NREP(3); ++rep) {
            pg8::DenseOrder S; S.init(NTOK, DM, G, bx);
            pg8::EpiG2 E{(const bf16_t*)(p.ws + ((l == 0) ? WS_X0B : WS_X2)), (bf16_t*)(p.ws + WS_X1)};
            if (FP8G2) pg8::gemm_phase<true>(lds, (const bf16_t*)(p.ws + WS_MIX), (const bf16_t*)(p.ws + WS_WOUT) + (size_t)l * DM * (DM / 2), DM / 2, S, E);
            else pg8::gemm_phase<false>(lds, (const bf16_t*)(p.ws + WS_MIX), (const bf16_t*)(p.ws + WS_WOUT) + (size_t)l * DM * DM, DM, S, E);
            SEAM(pb + 3);
        }
        if (SEL(4) && IN(pb + 4)) {
            __syncthreads();
            r2_phase(p, l, lds, G);
            convert_drain(p, lds, ctl, l == 0 ? (unsigned)TK_L1 : (unsigned)TK_N);
            SEAM(pb + 4);
        }
        if (SEL(5) && IN(pb + 5)) for (int rep = 0; rep < NREP(5); ++rep) {
            const int nu = moe_units(ctl, l, lds, true, (const int*)(p.ws + WS_TOK));
            pg8::MoeOrder<true> S{(const LAS int*)(lds + LDS_UL), (const LAS int*)(lds + LDS_TAB), nu};
            pg8::EpiG3 E{(bf16_t*)(p.ws + WS_HE), (const float*)(p.ws + WS_RSE), (const LAS int*)(lds + LDS_EB)};
            if (FP8MOE) pg8::gemm_phase<true>(lds, (const bf16_t*)(p.ws + WS_H2B), (const bf16_t*)(p.ws + WS_WGU) + (size_t)l * NE * 2048 * (DM / 2), DM / 2, S, E);
            else pg8::gemm_phase<false>(lds, (const bf16_t*)(p.ws + WS_H2B), (const bf16_t*)(p.ws + WS_WGU) + (size_t)l * NE * 2048 * DM, DM, S, E);
            SEAM(pb + 5);
        }
        if (SEL(6) && IN(pb + 6)) for (int rep = 0; rep < NREP(6); ++rep) {
            const int nu = *(const LAS int*)(lds + LDS_UL + 192);
            pg8::MoeOrder<false> S{(const LAS int*)(lds + LDS_UL), (const LAS int*)(lds + LDS_TAB), nu};
            pg8::EpiG4 E{(bf16_t*)(p.ws + WS_Y)};
            if (FP8MOE) pg8::gemm_phase<true>(lds, (const bf16_t*)(p.ws + WS_HE), (const bf16_t*)(p.ws + WS_WD) + (size_t)l * NE * 2048 * (DE / 2), DE / 2, S, E);
            else pg8::gemm_phase<false>(lds, (const bf16_t*)(p.ws + WS_HE), (const bf16_t*)(p.ws + WS_WD) + (size_t)l * NE * 2048 * DE, DE, S, E);
            SEAM(pb + 6);
        }
        if (SEL(7) && IN(pb + 7)) {
            LAS int* eb = (LAS int*)(lds + LDS_EB);
            __syncthreads();
            if (tid == 0) { int acc = 0; for (int e = 0; e < NE; ++e) { eb[e] = acc; acc += (((int)ctl[CW_CNT + (l * NE + e) * 16] + 255) >> 8) << 8; } }
            __syncthreads();
            ROWIDS();
            if (l + 1 < NL) { row_phase3<1>(p, (const bf16_t*)(p.ws + WS_X1), (bf16_t*)(p.ws + WS_X2), (bf16_t*)(p.ws + WS_XB), (const Rec*)(p.ws + WS_REC), (const unsigned char*)(p.ws + WS_Y), (const LAS int*)eb, gw_, ngw, lane_);
                convert_drain(p, lds, ctl, (unsigned)TK_L2);
                if (bx == 0 && tid == 0) ctl[CW_MODE] = (xb_ld(ctl + CW_TK) + 9800u < (unsigned)TK_N) ? 1u : 0u;
                SEAM(pb + 7); }
            else row_phase3<2>(p, (const bf16_t*)(p.ws + WS_X1), nullptr, nullptr, (const Rec*)(p.ws + WS_REC), (const unsigned char*)(p.ws + WS_Y), (const LAS int*)eb, gw_, ngw, lane_);
        }
    }
#undef IN
#undef SEAM
}


extern "C" void kernel_launch(void* const* d_in, const int* in_sizes, int n_in, void* d_out, int out_size, void* d_ws, size_t ws_size, hipStream_t stream) {
    static int init = 0; static int grid = 0;
    if (!init) {
        if (n_in != 17 || ws_size < WS_END) { fprintf(stderr, "kernel_launch: unexpected n_in %d or ws %zu < %zu\n", n_in, ws_size, (size_t)WS_END); init = -1; return; }
        if (hipFuncSetAttribute((const void*)k_mega, hipFuncAttributeMaxDynamicSharedMemorySize, LDS_BYTES) != hipSuccess) { fprintf(stderr, "kernel_launch: hipFuncSetAttribute(k_mega) failed\n"); init = -1; return; }
        int dev = 0, cus = 0, per_cu = 0;
        (void)hipGetDevice(&dev); (void)hipDeviceGetAttribute(&cus, hipDeviceAttributeMultiprocessorCount, dev);
        if (hipOccupancyMaxActiveBlocksPerMultiprocessor(&per_cu, (const void*)k_mega, NWAVES * 64, LDS_BYTES) != hipSuccess || per_cu < 1) fprintf(stderr, "kernel_launch: occupancy query reports %d blocks per CU\n", per_cu);
        (void)hipGetLastError();
        grid = cus > 0 ? cus : 256;
        init = 1;
    }
    if (init < 0) return;
    Ptrs p{};
    p.x = (const float*)d_in[0]; p.norm1_w = (const float*)d_in[1]; p.w_in = (const float*)d_in[2]; p.ret_gn_w = (const float*)d_in[3]; p.gmlp_norm_w = (const float*)d_in[4];
    p.w_s = (const float*)d_in[5]; p.b_s = (const float*)d_in[6]; p.w_out = (const float*)d_in[7]; p.norm2_w = (const float*)d_in[8]; p.rg_w = (const float*)d_in[9]; p.rg_b = (const float*)d_in[10];
    p.re_w = (const float*)d_in[11]; p.re_b = (const float*)d_in[12]; p.w_gate = (const float*)d_in[13]; p.w_up = (const float*)d_in[14]; p.w_down = (const float*)d_in[15]; p.final_w = (const float*)d_in[16];
    p.out = (float*)d_out; p.ws = (unsigned char*)d_ws;
    (void)hipMemsetAsync((char*)d_ws + WS_CTL, 0, 65536, stream);
    MegaArgs a{}; a.p = p; a.pad = 0; a.ph_lo = 0; a.ph_hi = NPH; a.use_bar = 1;
    hipLaunchKernelGGL(k_mega, dim3(grid), dim3(NWAVES * 64), LDS_BYTES, stream, a);
}
```

```cpp
#include <hip/hip_runtime.h>
#include <cstdio>
#include <cstdint>

#define GAS __attribute__((address_space(1)))
#define LAS __attribute__((address_space(3)))
typedef unsigned short bf16_t;
typedef short bf16x8 __attribute__((ext_vector_type(8)));
typedef float f32x4 __attribute__((ext_vector_type(4)));
typedef float f32x2 __attribute__((ext_vector_type(2)));
typedef unsigned u32x4 __attribute__((ext_vector_type(4)));
typedef unsigned u32x2 __attribute__((ext_vector_type(2)));

constexpr int NTOK = 16384, DM = 2048, SEQ = 4096, NBATCH = 4, NH = 8, DH = 128, INW = 6144, NE = 32, EPG = 8, NGRP = 4, DE = 1024, NL = 2;
constexpr int GG = 8, GBLK = 128;
constexpr int SLOTS = 40960;
constexpr float EPS = 1e-6f;
constexpr int COL_Q = 0, COL_K = 1024, COL_V = 2048, COL_G = 3072, COL_U = 4096, COL_VS = 5120;

constexpr size_t MiB = 1u << 20;
constexpr size_t WS_CTL = 0, CTL_BYTES = 1 * MiB;
constexpr size_t WS_ROPE = 1 * MiB;
constexpr size_t WS_WINT = 3 * MiB;
constexpr size_t WS_WOUT = WS_WINT + 48 * MiB;
constexpr size_t WS_WGU = WS_WOUT + 16 * MiB;
constexpr size_t WS_WD = WS_WGU + 512 * MiB;
constexpr size_t WS_WR = WS_WD + 256 * MiB;
constexpr size_t WS_WSB = WS_WR + 1 * MiB;
constexpr size_t WS_XB = WS_WSB + 1 * MiB;
constexpr size_t WS_P = WS_XB + 64 * MiB;
constexpr size_t WS_SSUP = WS_P + 192 * MiB;
constexpr size_t WS_MIX = WS_SSUP + 16 * MiB;
constexpr size_t WS_X1 = WS_MIX + 64 * MiB;
constexpr size_t WS_X0B = WS_X1 + 64 * MiB;
constexpr size_t WS_H2B = WS_X1 + 128 * MiB;
constexpr size_t WS_REC = WS_H2B + 64 * MiB;
constexpr size_t WS_TOK = WS_REC + 1 * MiB;
constexpr size_t WS_RSE = WS_TOK + 2 * MiB;
constexpr size_t WS_HE = WS_RSE + 2 * MiB;
constexpr size_t WS_Y = WS_HE + 80 * MiB;
constexpr size_t WS_X2 = WS_Y + 160 * MiB;
constexpr size_t WS_END = WS_X2 + 128 * MiB;
constexpr int CW_TMO = 0, CW_BAR = 4096, CW_CNT = 8192;

struct Rec { int e0, s0; float w0; int e1, s1; float w1; int pad0, pad1; };

__device__ __forceinline__ unsigned f2bf(float f) { unsigned u = __builtin_bit_cast(unsigned, f); return (u + 0x7fffu + ((u >> 16) & 1u)) >> 16; }
__device__ __forceinline__ float bf2f(unsigned b) { return __builtin_bit_cast(float, b << 16); }
__device__ __forceinline__ unsigned pk2(float lo, float hi) { return f2bf(lo) | (f2bf(hi) << 16); }
__device__ __forceinline__ float wave_sum(float v) {
#pragma unroll
    for (int o = 1; o < 64; o <<= 1) v += __shfl_xor(v, o);
    return v;
}
__device__ __forceinline__ float shx(float v, int lane, int m) { return __builtin_bit_cast(float, __builtin_amdgcn_ds_bpermute((lane ^ m) << 2, __builtin_bit_cast(int, v))); }
__device__ __forceinline__ float wave_sum_l(float v, int lane) {
#pragma unroll
    for (int o = 1; o < 64; o <<= 1) v += shx(v, lane, o);
    return v;
}
__device__ __forceinline__ float gelu_tanh(float x) {
    const float u = x * (-2.302208198f) * (1.0f + 0.044715f * x * x);
    return x * __builtin_amdgcn_rcpf(1.0f + __builtin_amdgcn_exp2f(u));
}
__device__ __forceinline__ float silu(float x) { return x * __builtin_amdgcn_rcpf(1.0f + __builtin_amdgcn_exp2f(x * -1.4426950408889634f)); }
__device__ __forceinline__ float log2_gamma(int h) { return log2f(1.0f - exp2f(-5.0f - (float)h)); }

struct Ptrs {
    const float *x, *norm1_w, *w_in, *ret_gn_w, *gmlp_norm_w, *w_s, *b_s, *w_out, *norm2_w, *rg_w, *rg_b, *re_w, *re_b, *w_gate, *w_up, *w_down, *final_w;
    float* out; unsigned char* ws;
};

template <class LP>
__device__ __forceinline__ void route_token(LP lg  , int& e0, int& e1, float& w0, float& w1) {
    int gs = 0; float gm = lg[0];
#pragma unroll
    for (int j = 1; j < NGRP; ++j) { const float v = lg[j]; if (v > gm) { gm = v; gs = j; } }
    float den = 0.f;
#pragma unroll
    for (int j = 0; j < NGRP; ++j) den += __expf(lg[j] - gm);
    const float psel = 1.0f / den;
    const int eb = 4 + 8 * gs;
    int i0 = 0; float v0 = lg[eb];
#pragma unroll
    for (int i = 1; i < EPG; ++i) { const float v = lg[eb + i]; if (v > v0) { v0 = v; i0 = i; } }
    int i1 = -1; float v1 = -3.0e38f;
#pragma unroll
    for (int i = 0; i < EPG; ++i) { const float v = lg[eb + i]; if (i != i0 && v > v1) { v1 = v; i1 = i; } }
    const float a = 1.0f / (1.0f + __expf(v1 - v0));
    e0 = gs * 8 + i0; e1 = gs * 8 + i1; w0 = a * psel; w1 = (1.0f - a) * psel;
}
#define XB_TMO      128
#define XB_XCNT(j)  (256  + 64 * (j))
#define XB_XSUB(j)  (1280 + 64 * (j))
#define XB_XGEN(j)  (2304 + 64 * (j))
#define XB_TOP      3328
#define XB_TOPGEN   3392
#define XCD_BAR_WORDS 3456
#define XB_SPIN_CAP (1u << 18)

__device__ __forceinline__ unsigned xb_ld(unsigned* p)              { return __hip_atomic_load(p, __ATOMIC_RELAXED, __HIP_MEMORY_SCOPE_AGENT); }
__device__ __forceinline__ unsigned xb_add(unsigned* p, unsigned v) { return __hip_atomic_fetch_add(p, v, __ATOMIC_RELAXED, __HIP_MEMORY_SCOPE_AGENT); }
__device__ __forceinline__ unsigned xb_xcc_id() { return (unsigned)__builtin_amdgcn_s_getreg((3 << 11) | 20) & 0xFu; }
#define XB_SPIN(cond, bar) do { unsigned _sp = 0; while (cond) { __builtin_amdgcn_s_sleep(1); \
    if ((++_sp & 255u) == 0u) { if (xb_ld(&(bar)[XB_TMO])) break; if (_sp > XB_SPIN_CAP) { atomicAdd(&(bar)[XB_TMO], 1u); break; } } } } while (0)

struct XcdBarrier {
    unsigned* bar; unsigned x;
    volatile LAS unsigned* st;
};

__device__ __forceinline__ XcdBarrier xcd_barrier_post(unsigned* bar, volatile LAS unsigned* st) {
    XcdBarrier b; b.bar = bar; b.x = xb_xcc_id(); b.st = st;
    if (threadIdx.x == 0) (void)xb_add(&bar[XB_XCNT(b.x)], 1u);
    return b;
}
__device__ __forceinline__ void xcd_barrier_complete(unsigned* bar, unsigned x, unsigned& nloc, unsigned& nx) {
    const unsigned G = gridDim.x * gridDim.y * gridDim.z;
    unsigned sum, cnt, mine, sp = 0u;
    for (;;) {
        sum = 0u; cnt = 0u; mine = 0u;
#pragma unroll
        for (unsigned j = 0; j < 16; ++j) { const unsigned c = xb_ld(&bar[XB_XCNT(j)]); sum += c; cnt += (c > 0u) ? 1u : 0u; mine = (j == x) ? c : mine; }
        if (sum == G) break;
        __builtin_amdgcn_s_sleep(1);
        if ((++sp & 255u) == 0u) { if (xb_ld(&bar[XB_TMO])) break; if (sp > XB_SPIN_CAP) { atomicAdd(&bar[XB_TMO], 1u); break; } }
    }
    nloc = mine > 0u ? mine : 1u; nx = cnt > 0u ? cnt : 1u;
}

__device__ __forceinline__ void xcd_barrier(const XcdBarrier& b) {
    asm volatile("s_waitcnt vmcnt(0)" ::: "memory");
    __syncthreads();
    if (threadIdx.x == 0) {
        unsigned* bar = b.bar;
        __builtin_amdgcn_s_waitcnt(0);
        unsigned nloc = b.st[0], nx = b.st[1];
        if (nloc == 0u) { xcd_barrier_complete(bar, b.x, nloc, nx); b.st[0] = nloc; b.st[1] = nx; }
        const unsigned old = xb_add(&bar[XB_XSUB(b.x)], 1u);
        const unsigned gen = old / nloc;
        if (old + 1u == (gen + 1u) * nloc) {
            __builtin_amdgcn_fence(__ATOMIC_RELEASE, "agent");
            asm volatile("s_waitcnt vmcnt(0)" ::: "memory");
            const unsigned og = xb_add(&bar[XB_TOP], 1u);
            const unsigned tg = og / nx;
            if (og + 1u == (tg + 1u) * nx) xb_add(&bar[XB_TOPGEN], 1u);
            else XB_SPIN(xb_ld(&bar[XB_TOPGEN]) == tg, bar);
            __builtin_amdgcn_fence(__ATOMIC_ACQUIRE, "agent");
            xb_add(&bar[XB_XGEN(b.x)], 1u);
            asm volatile("s_waitcnt vmcnt(0)" ::: "memory");
        } else {
            XB_SPIN(xb_ld(&bar[XB_XGEN(b.x)]) == gen, bar);
            __builtin_amdgcn_fence(__ATOMIC_ACQUIRE, "agent");
            asm volatile("s_waitcnt vmcnt(0)" ::: "memory");
        }
    }
    __syncthreads();
}

__device__ __forceinline__ int hidden_tid() { int t = threadIdx.x; asm volatile("" : "+v"(t)); return t; }
__device__ __forceinline__ void unpack8(const u32x4 v, float (&f)[8]) { f[0] = bf2f(v.x & 0xffffu); f[1] = bf2f(v.x >> 16); f[2] = bf2f(v.y & 0xffffu); f[3] = bf2f(v.y >> 16); f[4] = bf2f(v.z & 0xffffu); f[5] = bf2f(v.z >> 16); f[6] = bf2f(v.w & 0xffffu); f[7] = bf2f(v.w >> 16); }
__device__ __forceinline__ u32x4 pack8(const float (&f)[8]) { u32x4 w; w.x = pk2(f[0], f[1]); w.y = pk2(f[2], f[3]); w.z = pk2(f[4], f[5]); w.w = pk2(f[6], f[7]); return w; }
__device__ __forceinline__ void unpack8_fp8(const u32x2 v, float (&f)[8]) {
    const f32x2 a = __builtin_amdgcn_cvt_pk_f32_fp8((int)v.x, false), b = __builtin_amdgcn_cvt_pk_f32_fp8((int)v.x, true), c = __builtin_amdgcn_cvt_pk_f32_fp8((int)v.y, false), d = __builtin_amdgcn_cvt_pk_f32_fp8((int)v.y, true);
    f[0] = a.x; f[1] = a.y; f[2] = b.x; f[3] = b.y; f[4] = c.x; f[5] = c.y; f[6] = d.x; f[7] = d.y; }
constexpr int CW_TA = 16, CW_TB = 17;
#if defined(TIMER_PROBE) && defined(GMLP_TIMER)
#define TP_NOW() __builtin_amdgcn_s_memrealtime()
#define TP_ADD(word, t0) do { if (blockIdx.x == 0 && threadIdx.x == 0) atomicAdd((unsigned*)(p.ws + WS_CTL) + (word), (unsigned)(__builtin_amdgcn_s_memrealtime() - (t0))); } while (0)
#else
#define TP_NOW() 0ull
#define TP_ADD(word, t0) do { (void)(t0); } while (0)
#endif
constexpr int LDS_STAGE = 0;
constexpr int LDS_TAB = 131072;
constexpr int LDS_UL = LDS_TAB + 8192;
constexpr int LDS_EB = LDS_UL + 256;
constexpr int LDS_MISC = LDS_EB + 256;
constexpr int LDS_BYTES = 147456;
constexpr int NWAVES = 8;

__device__ __forceinline__ unsigned cvt_pk_bf16(float lo, float hi) { unsigned r; asm volatile("v_cvt_pk_bf16_f32 %0, %1, %2" : "=v"(r) : "v"(lo), "v"(hi)); return r; }

#ifndef FP8G2
#define FP8G2 1
#endif
#ifndef FP8G1
#define FP8G1 0
#endif
#ifndef FP8MOE
#define FP8MOE 1
#endif
typedef int i32x8 __attribute__((ext_vector_type(8)));
typedef int i32x4 __attribute__((ext_vector_type(4)));
#ifdef FP8_SW
__device__ __forceinline__ unsigned f2e4m3_sw(float x) {
    unsigned u = __builtin_bit_cast(unsigned, x); const unsigned sgn = (u >> 24) & 0x80u; u &= 0x7fffffffu;
    const float a = __builtin_bit_cast(float, u); unsigned code;
    if (a >= 0.015625f) { u += 0x7ffffu + ((u >> 20) & 1u); u &= 0xfff00000u; const float r = __builtin_bit_cast(float, u);
        if (r >= 448.0f) code = 0x7eu; else code = ((((u >> 23) - 120u) & 0xfu) << 3) | ((u >> 20) & 7u); }
    else code = (unsigned)__builtin_rintf(a * 512.0f);
    return sgn | code;
}
__device__ __forceinline__ unsigned pk4_fp8(float a, float b, float c, float d) { return f2e4m3_sw(a) | (f2e4m3_sw(b) << 8) | (f2e4m3_sw(c) << 16) | (f2e4m3_sw(d) << 24); }
#else
__device__ __forceinline__ unsigned pk4_fp8(float a, float b, float c, float d) { int w = 0; w = __builtin_amdgcn_cvt_pk_fp8_f32(a, b, w, false); w = __builtin_amdgcn_cvt_pk_fp8_f32(c, d, w, true); return (unsigned)w; }
#endif
namespace pg8 {
constexpr int BM = 256, BK = 64, HALF = 128, HTB = HALF * BK * 2, STAGE_BYTES = 8 * HTB, NXCD = 8, WGM = 8;
__host__ __device__ __forceinline__ int lds_byte(int r, int c) { const int st = (r >> 4) * 2 + (c >> 5), rr = r & 15, cc = c & 31, ob = rr * 64 + cc * 2; return st * 1024 + (ob ^ (((ob >> 9) & 1) << 5)); }
__host__ __device__ __forceinline__ void stage_rc(int b, int& R, int& C) { const int st = b / 1024, sb = b % 1024, swz = sb ^ (((sb >> 9) & 1) << 5); R = (st >> 1) * 16 + swz / 64; C = (st & 1) * 32 + (swz % 64) / 2; }
__host__ __device__ __forceinline__ int perm32(int rho) { const int n = rho >> 4, i = rho & 15; return 8 * (i >> 2) + 4 * n + (i & 3); }

struct Unit { int pm, pn, e, pnl, hm; };

struct DenseOrder {
    static constexpr bool HALVES = false;
    int nM, nN, nwg, G, c;
    __device__ void init(int M, int N, int G_, int c_) { nM = M / BM; nN = N / BM; nwg = nM * nN; G = G_; c = c_; }
    __device__ __forceinline__ bool next(int i, Unit& u) const {
        const long L = (long)i * G + c; if (L >= nwg) return false;
        int wgid = (int)L; { const int q = nwg / NXCD, r = nwg % NXCD, xcd = wgid % NXCD, off = wgid / NXCD; wgid = (xcd < r ? xcd * (q + 1) : r * (q + 1) + (xcd - r) * q) + off; }
        const int nig = WGM * nN, gid = wgid / nig, fm = gid * WGM, gsz = (nM - fm) < WGM ? (nM - fm) : WGM;
        u.pm = fm + ((wgid % nig) % gsz); u.pn = (wgid % nig) / gsz; u.e = 0; u.pnl = u.pn; u.hm = 0; return true;
    }
    __device__ __forceinline__ int arow(int, const Unit& u, int r) const { return u.pm * BM + r; }
};
template <bool GATHER> struct MoeOrder {
    static constexpr bool HALVES = true;
    const LAS int* ul; const LAS int* tab; int nu;
    __device__ __forceinline__ bool next(int i, Unit& u) const {
        if (i >= nu) return false;
        u.pm = __builtin_amdgcn_readfirstlane(ul[4 * i + 0]); u.pn = __builtin_amdgcn_readfirstlane(ul[4 * i + 1]);
        const int ev = __builtin_amdgcn_readfirstlane(ul[4 * i + 2]); u.e = ev & 255; u.hm = ev >> 8; u.pnl = __builtin_amdgcn_readfirstlane(ul[4 * i + 3]); return true;
    }
    __device__ __forceinline__ int arow(int ui, const Unit& u, int r) const { const int rr = u.hm ? ((u.hm == 2 ? HALF : 0) + (r & (HALF - 1))) : r; return GATHER ? tab[ui * 256 + rr] : u.pm * BM + rr; }
};

template <bool FP8, class Epi, class Sched>
__device__ __forceinline__ void gemm_phase(LAS unsigned char* lds, const bf16_t* A, const bf16_t* Bt, const int K, const Sched& S, const Epi& E) {
    const int tid = hidden_tid(), wid = __builtin_amdgcn_readfirstlane(tid >> 6), lane = tid & 63, wr = wid >> 2, wc = wid & 3, fr = lane & 15, fq = lane >> 4;
    const int nt = K / BK;
    unsigned voffB[2];
#pragma unroll
    for (int i = 0; i < 2; ++i) { int R_, C_; stage_rc(tid * 16 + i * 8192, R_, C_); const int Rb = Epi::PERM ? ((R_ & ~31) + perm32(R_ & 31)) : R_; voffB[i] = (unsigned)(Rb * K + C_) * 2u; }
    const size_t kstep = (size_t)(BK * 2);
    const size_t hstep = (size_t)HALF * K * 2;
    const size_t tstep = 2 * hstep;
    const unsigned ldsw = (unsigned)wid * 1024u;
    const int aoff = lds_byte(wr * 64 + fr, fq * 8), boff = lds_byte(wc * 32 + fr, fq * 8);
#define PG8_SA(b, h) (((b) * 2 + (h)) * HTB)
#define PG8_SB(b, h) ((4 + (b) * 2 + (h)) * HTB)
#define PG8_STAGE(bufoff, gbase, voff) do { const char* _gb = (const char*)(gbase); asm volatile("" : "+s"(_gb));     \
        _Pragma("unroll") for (int _i = 0; _i < 2; ++_i) { unsigned _vo = (voff)[_i]; asm volatile("" : "+v"(_vo)); \
        __builtin_amdgcn_global_load_lds((const unsigned*)(_gb + _vo), (LAS unsigned*)(lds + (bufoff) + ldsw + _i * 8192), 16, 0, 0); } } while (0)
#define PG8_LDA(dst, b, h) do { _Pragma("unroll") for (int m = 0; m < 4; ++m) _Pragma("unroll") for (int k = 0; k < 2; ++k) dst[m][k] = *(const LAS bf16x8*)(lds + PG8_SA(b, h) + aoff + m * 2048 + k * 1024); } while (0)
#define PG8_LDB(dst, b, h) do { _Pragma("unroll") for (int n = 0; n < 2; ++n) _Pragma("unroll") for (int k = 0; k < 2; ++k) dst[n][k] = *(const LAS bf16x8*)(lds + PG8_SB(b, h) + boff + n * 2048 + k * 1024); } while (0)
#define PG8_CAT(x0, x1) __builtin_shufflevector(__builtin_bit_cast(i32x4, x0), __builtin_bit_cast(i32x4, x1), 0, 1, 2, 3, 4, 5, 6, 7)
#define PG8_MMA(ai, bj, At, Bt_) do { __builtin_amdgcn_s_setprio(1); _Pragma("unroll") for (int m = 0; m < 4; ++m) _Pragma("unroll") for (int n = 0; n < 2; ++n) { \
        if constexpr (FP8) acc[ai][bj][m][n] = __builtin_amdgcn_mfma_scale_f32_16x16x128_f8f6f4(PG8_CAT(Bt_[n][0], Bt_[n][1]), PG8_CAT(At[m][0], At[m][1]), acc[ai][bj][m][n], 0, 0, 0, 0x7f7f7f7f, 0, 0x7f7f7f7f); \
        else { _Pragma("unroll") for (int k = 0; k < 2; ++k) acc[ai][bj][m][n] = __builtin_amdgcn_mfma_f32_16x16x32_bf16(Bt_[n][k], At[m][k], acc[ai][bj][m][n], 0, 0, 0); } } \
        __builtin_amdgcn_s_setprio(0); } while (0)
#define PG8_WAIT_V(n) asm volatile("s_waitcnt vmcnt(" #n ")" ::: "memory")
#define PG8_WAIT_L(n) asm volatile("s_waitcnt lgkmcnt(" #n ")" ::: "memory")
#define PG8_BAR __builtin_amdgcn_s_barrier()
#define PG8_SCHED __builtin_amdgcn_sched_barrier(0)
#define PG8_SKIP_IF(flag) do { if constexpr (Sched::HALVES) { PG8_SCHED; asm volatile("s_cmp_lg_u32 %0, 0\n\ts_cbranch_scc1 1f" :: "s"(flag) : "scc", "memory"); PG8_SCHED; } } while (0)
#define PG8_SKIP_END do { if constexpr (Sched::HALVES) { PG8_SCHED; asm volatile("1:" ::: "memory"); PG8_SCHED; } } while (0)
#define PG8_AOFF(dst, ui_, u_, h) do { int _tz = threadIdx.x; asm volatile("" : "+v"(_tz)); _Pragma("unroll") for (int _i = 0; _i < 2; ++_i) { int _R, _C; stage_rc(_tz * 16 + _i * 8192, _R, _C); \
        dst[_i] = (unsigned)(S.arow(ui_, u_, (h) * HALF + _R) * K + _C) * 2u; } } while (0)
    Unit cur, nxt; int ui = 0;
    if (!S.next(0, cur)) return;
    f32x4 acc[2][2][4][2];
#pragma unroll
    for (int a = 0; a < 2; ++a)
#pragma unroll
        for (int b = 0; b < 2; ++b)
#pragma unroll
            for (int m = 0; m < 4; ++m)
#pragma unroll
                for (int n = 0; n < 2; ++n) acc[a][b][m][n] = (f32x4){0.f, 0.f, 0.f, 0.f};
    bf16x8 At[4][2], B0[2][2], B1[2][2];
    unsigned vA0[2], vA1[2];
    PG8_AOFF(vA0, 0, cur, 0); PG8_AOFF(vA1, 0, cur, 1);
    const char* cA = (const char*)A; const char* cB = (const char*)Bt + (size_t)cur.pn * tstep;
    PG8_STAGE(PG8_SB(0, 0), cB, voffB); PG8_STAGE(PG8_SB(0, 1), cB + hstep, voffB); PG8_STAGE(PG8_SA(0, 0), cA, vA0); PG8_STAGE(PG8_SA(0, 1), cA, vA1);
    if (wr == 1) PG8_BAR;
    PG8_WAIT_V(2); PG8_BAR;
    PG8_STAGE(PG8_SB(1, 0), cB + kstep, voffB); PG8_STAGE(PG8_SA(1, 0), cA + kstep, vA0); PG8_STAGE(PG8_SB(1, 1), cB + hstep + kstep, voffB);
    PG8_WAIT_V(6); PG8_BAR;
    for (;;) {
        const bool has_next = S.next(ui + 1, nxt);
        const char* nB = has_next ? (const char*)Bt + (size_t)nxt.pn * tstep : cB;
        const int chm = Sched::HALVES ? cur.hm : 0;
        asm volatile(".p2align 8" ::: "memory");
        for (int t = 0; t < nt; t += 2) {
            const bool last = (t == nt - 2);
            const char* a1 = cA + (size_t)(t + 1) * kstep;
            const char* a2 = last ? cA : cA + (size_t)(t + 2) * kstep; const char* b2 = last ? nB : cB + (size_t)(t + 2) * kstep;
            const char* a3 = a2 + kstep; const char* b3 = b2 + kstep;
            if (last && has_next) { PG8_AOFF(vA0, ui + 1, nxt, 0); }
            PG8_LDB(B0, 0, 0); PG8_LDB(B1, 0, 1); PG8_SCHED; PG8_LDA(At, 0, 0); PG8_STAGE(PG8_SA(1, 1), a1, vA1);
            PG8_WAIT_V(8); PG8_WAIT_L(0); PG8_BAR; PG8_MMA(0, 0, At, B0); PG8_MMA(0, 1, At, B1); PG8_BAR; PG8_SCHED;
            if (last && has_next) { PG8_AOFF(vA1, ui + 1, nxt, 1); }
            PG8_LDA(At, 0, 1); PG8_STAGE(PG8_SB(0, 0), b2, voffB); PG8_STAGE(PG8_SB(0, 1), b2 + hstep, voffB); PG8_STAGE(PG8_SA(0, 0), a2, vA0);
            PG8_WAIT_V(8); PG8_WAIT_L(0); PG8_BAR; PG8_SKIP_IF(chm); PG8_MMA(1, 0, At, B0); PG8_MMA(1, 1, At, B1); PG8_SKIP_END; PG8_BAR; PG8_SCHED;
            PG8_LDB(B0, 1, 0); PG8_LDB(B1, 1, 1); PG8_SCHED; PG8_LDA(At, 1, 0); PG8_STAGE(PG8_SA(0, 1), a2, vA1);
            PG8_WAIT_V(8); PG8_WAIT_L(0); PG8_BAR; PG8_MMA(0, 0, At, B0); PG8_MMA(0, 1, At, B1); PG8_BAR; PG8_SCHED;
            PG8_LDA(At, 1, 1); PG8_STAGE(PG8_SB(1, 0), b3, voffB); PG8_STAGE(PG8_SB(1, 1), b3 + hstep, voffB); PG8_STAGE(PG8_SA(1, 0), a3, vA0);
            PG8_WAIT_V(8); PG8_WAIT_L(0); PG8_BAR; PG8_SKIP_IF(chm); PG8_MMA(1, 0, At, B0); PG8_MMA(1, 1, At, B1); PG8_SKIP_END; PG8_BAR; PG8_SCHED;
        }
#ifndef NO_ALIGN_EPI
        if (wr == 0) PG8_BAR;
#endif
        E(acc, cur, wr, wc, fr, fq);
        if (!has_next) break;
#pragma unroll
        for (int a = 0; a < 2; ++a)
#pragma unroll
            for (int b = 0; b < 2; ++b)
#pragma unroll
                for (int m = 0; m < 4; ++m)
#pragma unroll
                    for (int n = 0; n < 2; ++n) acc[a][b][m][n] = (f32x4){0.f, 0.f, 0.f, 0.f};
        cur = nxt; cB = nB; ++ui;
#ifndef NO_ALIGN_EPI
        if (wr == 1) PG8_BAR;
#endif
    }
    PG8_WAIT_V(0);
#ifdef NO_ALIGN_EPI
    if (wr == 0) PG8_BAR;
#endif
    PG8_BAR;
#undef PG8_SA
#undef PG8_SB
#undef PG8_STAGE
#undef PG8_LDA
#undef PG8_LDB
#undef PG8_MMA
#undef PG8_CAT
#undef PG8_WAIT_V
#undef PG8_WAIT_L
#undef PG8_BAR
#undef PG8_SCHED
#undef PG8_SKIP_IF
#undef PG8_SKIP_END
#undef PG8_AOFF
}

struct EpiG1 {
    static constexpr bool PERM = true;
    bf16_t* P; const float* cosT; const float* sinT; int skip;
    __device__ __forceinline__ void operator()(const f32x4 (&acc)[2][2][4][2], const Unit& u, int wr, int wc, int fr, int fq) const {
        const int row0 = u.pm * BM + wr * 64 + fr;
#ifdef PROBE_NULL_EPI
        if (skip) return;
#endif
        if (u.pn < 8) {
            const int i0 = (32 * wc + 8 * fq) & 63, hl = wc >> 1, colb = u.pn * 256 + hl * 128 + i0;
#pragma unroll
            for (int ai = 0; ai < 2; ++ai) {
                f32x4 cs[4][4];
#pragma unroll
                for (int m = 0; m < 4; ++m) { const int pos = (row0 + ai * HALF + m * 16) & (SEQ - 1);
                    cs[m][0] = *(const f32x4*)(cosT + pos * 64 + i0); cs[m][1] = *(const f32x4*)(cosT + pos * 64 + i0 + 4); cs[m][2] = *(const f32x4*)(sinT + pos * 64 + i0); cs[m][3] = *(const f32x4*)(sinT + pos * 64 + i0 + 4); }
                asm volatile("" ::: "memory");
#pragma unroll
                for (int m = 0; m < 4; ++m) { const int row = row0 + ai * HALF + m * 16;
                    const f32x4 c0 = cs[m][0], c1 = cs[m][1], s0 = cs[m][2], s1 = cs[m][3];
                    const float sc = FP8G1 ? (1.0f / 256.0f) : 1.0f; const f32x4 a0 = acc[ai][0][m][0] * sc, a1 = acc[ai][0][m][1] * sc, b0 = acc[ai][1][m][0] * sc, b1 = acc[ai][1][m][1] * sc;
                    const f32x4 o10 = a0 * c0 - b0 * s0, o11 = a1 * c1 - b1 * s1, o20 = a0 * s0 + b0 * c0, o21 = a1 * s1 + b1 * c1;
                    u32x4 w1, w2; w1.x = cvt_pk_bf16(o10[0], o10[1]); w1.y = cvt_pk_bf16(o10[2], o10[3]); w1.z = cvt_pk_bf16(o11[0], o11[1]); w1.w = cvt_pk_bf16(o11[2], o11[3]);
                    w2.x = cvt_pk_bf16(o20[0], o20[1]); w2.y = cvt_pk_bf16(o20[2], o20[3]); w2.z = cvt_pk_bf16(o21[0], o21[1]); w2.w = cvt_pk_bf16(o21[2], o21[3]);
                    bf16_t* rp = P + (size_t)row * INW + colb; *(u32x4*)rp = w1; *(u32x4*)(rp + 64) = w2; }
                asm volatile("" ::: "memory");
            }
        } else {
            const bool act = (u.pn >= 16);
            const int colb = u.pn * 256 + wc * 32 + 8 * fq;
#pragma unroll
            for (int ai = 0; ai < 2; ++ai)
#pragma unroll
                for (int m = 0; m < 4; ++m) { bf16_t* rp = P + (size_t)(row0 + ai * HALF + m * 16) * INW + colb;
#pragma unroll
                    for (int bj = 0; bj < 2; ++bj) { const float sc = FP8G1 ? (1.0f / 256.0f) : 1.0f; f32x4 v0 = acc[ai][bj][m][0] * sc, v1 = acc[ai][bj][m][1] * sc;
                        if (act) {
#pragma unroll
                            for (int j = 0; j < 4; ++j) { v0[j] = gelu_tanh(v0[j]); v1[j] = gelu_tanh(v1[j]); } }
                        u32x4 w; w.x = cvt_pk_bf16(v0[0], v0[1]); w.y = cvt_pk_bf16(v0[2], v0[3]); w.z = cvt_pk_bf16(v1[0], v1[1]); w.w = cvt_pk_bf16(v1[2], v1[3]);
                        *(u32x4*)(rp + bj * HALF) = w; } }
        }
    }
};
struct EpiNull {
    static constexpr bool PERM = true;
    __device__ __forceinline__ void operator()(const f32x4 (&acc)[2][2][4][2], const Unit& u, int wr, int wc, int fr, int fq) const {
#pragma unroll
        for (int ai = 0; ai < 2; ++ai)
#pragma unroll
            for (int bj = 0; bj < 2; ++bj)
#pragma unroll
                for (int m = 0; m < 4; ++m)
#pragma unroll
                    for (int n = 0; n < 2; ++n) asm volatile("" :: "v"(acc[ai][bj][m][n]));
    }
};
struct EpiG2 {
    static constexpr bool PERM = true;
    const bf16_t* xin; bf16_t* x1;
    __device__ __forceinline__ void operator()(const f32x4 (&acc)[2][2][4][2], const Unit& u, int wr, int wc, int fr, int fq) const {
        const int row0 = u.pm * BM + wr * 64 + fr, col0 = u.pn * BM + wc * 32 + 8 * fq;
        u32x4 xv[2][4][2];
#pragma unroll
        for (int ai = 0; ai < 2; ++ai)
#pragma unroll
            for (int m = 0; m < 4; ++m) { const size_t off = (size_t)(row0 + ai * HALF + m * 16) * DM + col0;
#pragma unroll
                for (int bj = 0; bj < 2; ++bj) xv[ai][m][bj] = *(const u32x4*)(xin + off + bj * HALF); }
        asm volatile("" ::: "memory");
#pragma unroll
        for (int ai = 0; ai < 2; ++ai)
#pragma unroll
            for (int m = 0; m < 4; ++m) { const size_t off = (size_t)(row0 + ai * HALF + m * 16) * DM + col0;
#pragma unroll
                for (int bj = 0; bj < 2; ++bj) { const u32x4 x = xv[ai][m][bj]; const float sc = FP8G2 ? (1.0f / 1024.0f) : 1.0f; const f32x4 a0 = acc[ai][bj][m][0] * sc, a1 = acc[ai][bj][m][1] * sc;
                    u32x4 w; w.x = cvt_pk_bf16(bf2f(x.x & 0xffffu) + a0[0], bf2f(x.x >> 16) + a0[1]); w.y = cvt_pk_bf16(bf2f(x.y & 0xffffu) + a0[2], bf2f(x.y >> 16) + a0[3]);
                    w.z = cvt_pk_bf16(bf2f(x.z & 0xffffu) + a1[0], bf2f(x.z >> 16) + a1[1]); w.w = cvt_pk_bf16(bf2f(x.w & 0xffffu) + a1[2], bf2f(x.w >> 16) + a1[3]);
                    *(u32x4*)(x1 + off + bj * HALF) = w; } }
    }
};
struct EpiG3 {
    static constexpr bool PERM = true;
    bf16_t* he; const float* rse; const LAS int* etb;
    __device__ __forceinline__ void operator()(const f32x4 (&acc)[2][2][4][2], const Unit& u, int wr, int wc, int fr, int fq) const {
        const int rl0 = wr * 64 + fr + (u.hm == 2 ? HALF : 0), mt = u.pm - etb[u.e];
        const float* rsp = rse + (size_t)u.e * NTOK + mt * 256;
        const int colb = u.pnl * 128 + wc * 32 + 8 * fq;
        float rsv[2][4];
#pragma unroll
        for (int ai = 0; ai < 2; ++ai) if (ai == 0 || u.hm == 0)
#pragma unroll
            for (int m = 0; m < 4; ++m) rsv[ai][m] = rsp[rl0 + ai * HALF + m * 16];
        asm volatile("" ::: "memory");
#pragma unroll
        for (int ai = 0; ai < 2; ++ai) if (ai == 0 || u.hm == 0)
#pragma unroll
            for (int m = 0; m < 4; ++m) { const int rl = rl0 + ai * HALF + m * 16; const float rs = rsv[ai][m] * (FP8MOE ? (1.0f / 256.0f) : 1.0f);
                const f32x4 g0 = acc[ai][0][m][0] * rs, g1 = acc[ai][0][m][1] * rs, u0 = acc[ai][1][m][0] * rs, u1 = acc[ai][1][m][1] * rs;
                f32x4 h0, h1;
#pragma unroll
                for (int j = 0; j < 4; ++j) { h0[j] = silu(g0[j]) * u0[j]; h1[j] = silu(g1[j]) * u1[j]; }
                if (FP8MOE) { u32x2 w; w.x = pk4_fp8(h0[0] * 8.f, h0[1] * 8.f, h0[2] * 8.f, h0[3] * 8.f); w.y = pk4_fp8(h1[0] * 8.f, h1[1] * 8.f, h1[2] * 8.f, h1[3] * 8.f);
                    *(u32x2*)((unsigned char*)he + (size_t)(u.pm * BM + rl) * DE + colb) = w; }
                else { u32x4 w; w.x = cvt_pk_bf16(h0[0], h0[1]); w.y = cvt_pk_bf16(h0[2], h0[3]); w.z = cvt_pk_bf16(h1[0], h1[1]); w.w = cvt_pk_bf16(h1[2], h1[3]);
                    *(u32x4*)(he + (size_t)(u.pm * BM + rl) * DE + colb) = w; } }
    }
};
struct EpiG4 {
    static constexpr bool PERM = true;
    bf16_t* y;
    __device__ __forceinline__ void operator()(const f32x4 (&acc)[2][2][4][2], const Unit& u, int wr, int wc, int fr, int fq) const {
        const int row0 = u.pm * BM + wr * 64 + fr + (u.hm == 2 ? HALF : 0), colb = u.pnl * 256 + wc * 32 + 8 * fq;
#pragma unroll
        for (int ai = 0; ai < 2; ++ai) if (ai == 0 || u.hm == 0)
#pragma unroll
            for (int m = 0; m < 4; ++m) {
                if (FP8MOE) {
                    const float sc = 1.0f / 128.0f; const f32x4 a = acc[ai][0][m][0] * sc, b = acc[ai][0][m][1] * sc, c2 = acc[ai][1][m][0] * sc, d = acc[ai][1][m][1] * sc;
                    u32x4 w; w.x = pk4_fp8(a[0], a[1], a[2], a[3]); w.y = pk4_fp8(b[0], b[1], b[2], b[3]); w.z = pk4_fp8(c2[0], c2[1], c2[2], c2[3]); w.w = pk4_fp8(d[0], d[1], d[2], d[3]);
                    *(u32x4*)((unsigned char*)y + (size_t)(row0 + ai * HALF + m * 16) * DM + u.pnl * 256 + 64 * wc + 16 * fq) = w; }
                else {
#pragma unroll
                    for (int bj = 0; bj < 2; ++bj) { const f32x4 v0 = acc[ai][bj][m][0], v1 = acc[ai][bj][m][1];
                        u32x4 w; w.x = cvt_pk_bf16(v0[0], v0[1]); w.y = cvt_pk_bf16(v0[2], v0[3]); w.z = cvt_pk_bf16(v1[0], v1[1]); w.w = cvt_pk_bf16(v1[2], v1[3]);
                        *(u32x4*)(y + (size_t)(row0 + ai * HALF + m * 16) * DM + colb + bj * HALF) = w; } } }
    }
};
}

__device__ __forceinline__ int moe_units(const unsigned* ctl, int l, LAS unsigned char* lds, bool gather, const int* tokg) {
    LAS int* etb = (LAS int*)(lds + LDS_EB); LAS int* ul = (LAS int*)(lds + LDS_UL); LAS int* tab = (LAS int*)(lds + LDS_TAB);
    LAS int* nup = (LAS int*)(lds + LDS_UL + 192); LAS int* tl = (LAS int*)(lds + LDS_MISC + 256);
    const int tid = hidden_tid(), G = gridDim.x;
    __syncthreads();
    if (tid == 0) { int acc = 0; for (int e = 0; e < NE; ++e) { etb[e] = acc; acc += ((int)ctl[CW_CNT + (l * NE + e) * 16] + 255) >> 8; } etb[NE] = acc; }
    __syncthreads();
    const int T = etb[NE];
    const int nx = (G % 8 == 0) ? 8 : 1, x = (int)blockIdx.x % nx, rank = (int)blockIdx.x / nx, nrank = G / nx;
    const int lo = (int)((long)x * T / nx), hi = (int)((long)(x + 1) * T / nx), ntl = hi - lo, nun = ntl * 8;
    if (tid < 64) {
        const unsigned long long below = (1ull << tid) - 1ull;
        int nF = 0;
        for (int c0 = 0; c0 < ntl; c0 += 64) { const int mtg = lo + c0 + tid; const bool in = c0 + tid < ntl; bool isH = false;
            if (in) { int e = 0; while (etb[e + 1] <= mtg) ++e; isH = ((int)ctl[CW_CNT + (l * NE + e) * 16] - (mtg - etb[e]) * 256) <= 128; }
            nF += __popcll(__ballot(in && !isH)); }
        int bF = 0, bH = nF;
        for (int c0 = 0; c0 < ntl; c0 += 64) { const int mtg = lo + c0 + tid; const bool in = c0 + tid < ntl; bool isH = false; int e = 0;
            if (in) { while (etb[e + 1] <= mtg) ++e; isH = ((int)ctl[CW_CNT + (l * NE + e) * 16] - (mtg - etb[e]) * 256) <= 128; }
            const unsigned long long mF = __ballot(in && !isH), mH = __ballot(in && isH);
            if (in) tl[1 + (isH ? bH + __popcll(mH & below) : bF + __popcll(mF & below))] = mtg | (e << 16);
            bF += __popcll(mF); bH += __popcll(mH); }
        if (tid == 0) tl[0] = nF;
    }
    __syncthreads();
    const int nF8 = tl[0] * 8, R = nun / nrank, rem = nun - R * nrank;
    int remF = nF8 - R * nrank; remF = remF < 0 ? 0 : (remF > rem ? rem : remF);
    const int remH = rem - remF;
    int lastv = -1, lasthm = 0;
    if (remF > 0 && 2 * remF + remH <= nrank) {
        if (rank < 2 * remF) { lastv = R * nrank + (rank >> 1); lasthm = 1 + (rank & 1); }
        else if (rank < 2 * remF + remH) { lastv = R * nrank + remF + (rank - 2 * remF); lasthm = 1; }
    } else if (rank < rem) { lastv = R * nrank + rank; lasthm = (lastv >= nF8) ? 1 : 0; }
    int nu = R + (lastv >= 0 ? 1 : 0); if (nu > 8) nu = 8;
    if (tid < nu) { int v, hm; if (tid < R) { v = rank + tid * nrank; hm = (v >= nF8) ? 1 : 0; } else { v = lastv; hm = lasthm; }
        const int te = tl[1 + (v >> 3)], mtg = te & 0xffff, e = te >> 16, pnl = v & 7;
        ul[4 * tid + 0] = mtg; ul[4 * tid + 1] = e * 8 + pnl; ul[4 * tid + 2] = e | (hm << 8); ul[4 * tid + 3] = pnl; }
    if (tid == 0) nup[0] = nu;
    __syncthreads();
    if (gather) {
        for (int idx = tid; idx < nu * 256; idx += 512) { const int i = idx >> 8, r = idx & 255; const int mtg = ul[4 * i + 0], e = ul[4 * i + 2] & 255, mt = mtg - etb[e]; const int cnt = (int)ctl[CW_CNT + (l * NE + e) * 16];
            int s = mt * 256 + r; if (s >= cnt) s = cnt - 1; tab[idx] = tokg[(size_t)e * NTOK + s]; }
        __syncthreads();
    }
    return nu;
}

struct CvItem { const float* sa; const float* sb; const float* ks; unsigned char* dst; int o0, o1, o2, o3, ld, K, k0, f8, y16; float cmul; };
constexpr int IT_WIN = NL * 32 * 24, IT_WOUT = NL * 32 * 8, IT_WGU = NL * NE * 32 * 8, IT_WD = NL * NE * 16 * 8, IT_ALL = IT_WIN + IT_WOUT + IT_WGU + IT_WD;
__device__ __forceinline__ void cv_decode(const Ptrs& p, int it, CvItem& c) {
    int r = it;
    if (r < IT_WIN) { const int l = r / (32 * 24), q = r % (32 * 24), kt = q / 24, pn = q % 24; const bool qk = pn < 8;
        c.sa = c.sb = p.w_in + (size_t)l * DM * INW + pn * 256; c.o0 = 0; c.o1 = qk ? 128 : 64; c.o2 = qk ? 64 : 128; c.o3 = 192; c.ld = INW; c.K = DM; c.k0 = kt * 64; c.f8 = FP8G1; c.y16 = 0;
        c.dst = p.ws + WS_WINT + (((size_t)l * INW + pn * 256) * DM) * (FP8G1 ? 1 : 2); c.ks = p.norm1_w + l * DM; c.cmul = ((pn >= 4 && pn < 8) ? 0.08838834764831845f : 1.0f) * (FP8G1 ? 256.0f : 1.0f);
    } else if ((r -= IT_WIN) < IT_WOUT) { const int l = r / (32 * 8), q = r % (32 * 8), kt = q / 8, pn = q % 8;
        c.sa = c.sb = p.w_out + (size_t)l * DM * DM + pn * 256; c.o0 = 0; c.o1 = 64; c.o2 = 128; c.o3 = 192; c.ld = DM; c.K = DM; c.k0 = kt * 64; c.f8 = FP8G2; c.y16 = 0;
        c.dst = p.ws + WS_WOUT + (((size_t)l * DM + pn * 256) * DM) * (FP8G2 ? 1 : 2); c.ks = nullptr; c.cmul = FP8G2 ? 256.0f : 1.0f;
    } else if ((r -= IT_WOUT) < IT_WGU) { const int le = r / (32 * 8), q = r % (32 * 8), kt = q / 8, pn = q % 8, l = le / NE;
        c.sa = p.w_gate + (size_t)le * DM * DE + pn * 128; c.sb = p.w_up + (size_t)le * DM * DE + pn * 128; c.o0 = 0; c.o1 = 64; c.o2 = 0; c.o3 = 64; c.ld = DE; c.K = DM; c.k0 = kt * 64; c.f8 = FP8MOE; c.y16 = 0;
        c.dst = p.ws + WS_WGU + (((size_t)le * 2048 + pn * 256) * DM) * (FP8MOE ? 1 : 2); c.ks = p.norm2_w + l * DM; c.cmul = FP8MOE ? 256.0f : 1.0f;
    } else { r -= IT_WGU; const int le = r / (16 * 8), q = r % (16 * 8), kt = q / 8, pn = q % 8;
        c.sa = c.sb = p.w_down + (size_t)le * DE * DM + pn * 256; c.o0 = 0; c.o1 = 64; c.o2 = 128; c.o3 = 192; c.ld = DM; c.K = DE; c.k0 = kt * 64; c.f8 = FP8MOE; c.y16 = FP8MOE;
        c.dst = p.ws + WS_WD + (((size_t)le * 2048 + pn * 256) * DE) * (FP8MOE ? 1 : 2); c.ks = nullptr; c.cmul = FP8MOE ? 256.0f : 1.0f;
    }
}
__device__ __forceinline__ void cv_load(const CvItem& c, int tid, f32x4 (&v)[8], float (&sc)[8]) {
    const int lane = tid & 63, w = __builtin_amdgcn_readfirstlane(tid >> 6), run = lane >> 4, rc = (lane & 15) * 4;
    const int y16c = 64 * ((lane >> 3) & 3) + 16 * ((lane >> 1) & 3) + 8 * (lane >> 5) + 4 * (lane & 1);
    const float* sp = c.y16 ? c.sa + y16c : (run < 2 ? c.sa : c.sb) + (run == 0 ? c.o0 : run == 1 ? c.o1 : run == 2 ? c.o2 : c.o3) + rc;
#pragma unroll
    for (int i = 0; i < 8; ++i) { const int k = c.k0 + (c.f8 ? 8 * w + i : w + 8 * i); v[i] = __builtin_nontemporal_load(     (const f32x4*)(sp + (size_t)k * c.ld)); sc[i] = (c.ks ? c.ks[k] : 1.0f) * c.cmul; }
}
__device__ __forceinline__ void cv_store(const CvItem& c, LAS unsigned char* lds, int tid, const f32x4 (&v)[8], const float (&sc)[8]) {
    const int lane = tid & 63, w = tid >> 6;
    if (c.f8) {
        unsigned D[8];
#pragma unroll
        for (int i = 0; i < 8; ++i) D[i] = pk4_fp8(v[i].x * sc[i], v[i].y * sc[i], v[i].z * sc[i], v[i].w * sc[i]);
        unsigned T[4][2];
#pragma unroll
        for (int h = 0; h < 2; ++h) {
            const unsigned l01 = __builtin_amdgcn_perm(D[4 * h + 1], D[4 * h + 0], 0x05010400u), h01 = __builtin_amdgcn_perm(D[4 * h + 1], D[4 * h + 0], 0x07030602u);
            const unsigned l23 = __builtin_amdgcn_perm(D[4 * h + 3], D[4 * h + 2], 0x05010400u), h23 = __builtin_amdgcn_perm(D[4 * h + 3], D[4 * h + 2], 0x07030602u);
            T[0][h] = __builtin_amdgcn_perm(l23, l01, 0x05040100u); T[1][h] = __builtin_amdgcn_perm(l23, l01, 0x07060302u);
            T[2][h] = __builtin_amdgcn_perm(h23, h01, 0x05040100u); T[3][h] = __builtin_amdgcn_perm(h23, h01, 0x07060302u); }
#pragma unroll
        for (int e = 0; e < 4; ++e) { u32x2 t; t.x = T[e][0]; t.y = T[e][1]; *(LAS u32x2*)(lds + (4 * lane + e) * 80 + 8 * w) = t; }
        __syncthreads();
#pragma unroll
        for (int pss = 0; pss < 2; ++pss) { const int idx = tid + 512 * pss, tl = idx >> 2, ko = idx & 3;
            const u32x4 o = *(const LAS u32x4*)(lds + tl * 80 + 16 * ko);
            __builtin_nontemporal_store(o, (u32x4*)(c.dst + (size_t)tl * c.K + c.k0 + 16 * ko)); }
    } else {
#pragma unroll
        for (int i = 0; i < 8; ++i) { const int kk = w + 8 * i; LAS unsigned* d = (LAS unsigned*)(lds + kk * 516 + lane * 8);
            d[0] = pk2(v[i].x * sc[i], v[i].y * sc[i]); d[1] = pk2(v[i].z * sc[i], v[i].w * sc[i]); }
        __syncthreads();
#pragma unroll
        for (int pss = 0; pss < 4; ++pss) { const int idx = tid + 512 * pss, tl = idx >> 3, ko = idx & 7;
            const LAS unsigned short* bp = (const LAS unsigned short*)(lds + (8 * ko) * 516 + tl * 2);
            u32x4 o; o.x = (unsigned)bp[0] | ((unsigned)bp[258] << 16); o.y = (unsigned)bp[516] | ((unsigned)bp[774] << 16); o.z = (unsigned)bp[1032] | ((unsigned)bp[1290] << 16); o.w = (unsigned)bp[1548] | ((unsigned)bp[1806] << 16);
            *(u32x4*)(c.dst + ((size_t)tl * c.K + c.k0 + 8 * ko) * 2) = o; }
    }
    __syncthreads();
}
constexpr int TK_L0 = 256, TK_L1 = TK_L0 + 8192 + 4096, TK_L2 = TK_L1 + 768 + 256, TK_N = TK_L2 + 8192 + 4096;
constexpr int CW_TK = 9280, CW_G1D = 9296, CW_MODE = 9344;
constexpr int G1_WGS = 192;
__device__ __forceinline__ int tk_item(int t) {
    if (t < 256) return IT_WIN + t;
    t -= 256; if (t < 8192) return IT_WIN + IT_WOUT + t;
    t -= 8192; if (t < 4096) return IT_WIN + IT_WOUT + IT_WGU + t;
    t -= 4096; if (t < 768) return 768 + t;
    t -= 768; if (t < 256) return IT_WIN + 256 + t;
    t -= 256; if (t < 8192) return IT_WIN + IT_WOUT + 8192 + t;
    t -= 8192; return IT_WIN + IT_WOUT + IT_WGU + 4096 + t;
}
constexpr int NLANE = 64, TKM_L0 = TK_L0 / NLANE, TKM_L1 = TK_L1 / NLANE, TKM_L2 = TK_L2 / NLANE, TKM_N = TK_N / NLANE;
static_assert(TK_L0 % NLANE == 0 && TK_L1 % NLANE == 0 && TK_L2 % NLANE == 0 && TK_N % NLANE == 0, "class boundaries");
constexpr int CW_PROG = 9408;
struct SrcStride { int t, te, step, lane, mul;
    __device__ __forceinline__ int next() { if (t >= te) return -1; const int r = mul ? tk_item(lane + mul * t) : t; t += step; return r; }
    __device__ __forceinline__ void pre() {} __device__ __forceinline__ void post() {} };
struct SrcWindow { volatile LAS int* slot; const unsigned* done_word; int j, m, stop, par; unsigned dv;
    __device__ __forceinline__ int next() { if (stop || m >= TKM_N) return -1; const int t = j + NLANE * m; ++m; return tk_item(t); }
    __device__ __forceinline__ void pre() { if (threadIdx.x == 0) slot[par] = (dv >= (unsigned)G1_WGS) ? 1 : 0; }
    __device__ __forceinline__ void post() { stop = __builtin_amdgcn_readfirstlane(slot[par]); par ^= 1; if (threadIdx.x == 0) dv = xb_ld((unsigned*)done_word); } };
template <class Src>
__device__ __forceinline__ void convert_stream(const Ptrs& p, LAS unsigned char* lds, Src& src) {
    const int tid = hidden_tid();
    CvItem ca0, ca1, cb0, cb1; f32x4 va0[8], va1[8], vb0[8], vb1[8]; float sa0[8], sa1[8], sb0[8], sb1[8];
    int ia0 = src.next(), ia1 = ia0 >= 0 ? src.next() : -1;
    if (ia0 < 0) return;
    cv_decode(p, ia0, ca0); cv_load(ca0, tid, va0, sa0);
    if (ia1 >= 0) { cv_decode(p, ia1, ca1); cv_load(ca1, tid, va1, sa1); }
    for (;;) {
        const int ib0 = ia1 >= 0 ? src.next() : -1, ib1 = ib0 >= 0 ? src.next() : -1;
        if (ib0 >= 0) { cv_decode(p, ib0, cb0); cv_load(cb0, tid, vb0, sb0); }
        if (ib1 >= 0) { cv_decode(p, ib1, cb1); cv_load(cb1, tid, vb1, sb1); }
        src.pre(); cv_store(ca0, lds, tid, va0, sa0);
        if (ia1 >= 0) cv_store(ca1, lds, tid, va1, sa1);
        src.post();
        if (ib0 < 0) break;
        ia0 = ib1 >= 0 ? src.next() : -1; ia1 = ia0 >= 0 ? src.next() : -1;
        if (ia0 >= 0) { cv_decode(p, ia0, ca0); cv_load(ca0, tid, va0, sa0); }
        if (ia1 >= 0) { cv_decode(p, ia1, ca1); cv_load(ca1, tid, va1, sa1); }
        src.pre(); cv_store(cb0, lds, tid, vb0, sb0);
        if (ib1 >= 0) cv_store(cb1, lds, tid, vb1, sb1);
        src.post();
        if (ia0 < 0) break;
    }
}
__device__ __forceinline__ void convert_drain(const Ptrs& p, LAS unsigned char* lds, unsigned* ctl, int floor_m, int lim_m, int b, int G) {
    asm volatile("s_waitcnt vmcnt(0)" ::: "memory");
    __syncthreads();
    SrcStride src{floor_m * NLANE + b, lim_m * NLANE, G, 0, 1};
    if (G == 4 * NLANE) { const int j = b & (NLANE - 1); int m = __builtin_amdgcn_readfirstlane((int)xb_ld(ctl + CW_PROG + j)); m = (m > floor_m ? m : floor_m) + (b >> 6);
        src.t = m; src.te = lim_m; src.step = 4; src.lane = j; src.mul = NLANE; }
    convert_stream(p, lds, src);
}
__device__ __forceinline__ void convert_window(const Ptrs& p, LAS unsigned char* lds, unsigned* ctl, int j, int floor_m, const unsigned* done_word) {
    int m = __builtin_amdgcn_readfirstlane((int)xb_ld(ctl + CW_PROG + j)); m = m > floor_m ? m : floor_m;
    SrcWindow src{(volatile LAS int*)(lds + LDS_MISC + 192), done_word, j, m, 0, 0, 0u};
    if (threadIdx.x == 0) src.dv = xb_ld((unsigned*)done_word);
    convert_stream(p, lds, src);
    if (threadIdx.x == 0) ctl[CW_PROG + j] = (unsigned)src.m;
}
__device__ __forceinline__ void prologue_phase(const Ptrs& p, LAS unsigned char* lds, int vcu, int G) {
    const int tid = hidden_tid();
    { SrcStride src{vcu, 768, G, 0, 0}; convert_stream(p, lds, src); }
    const size_t gt = (size_t)vcu * 512 + tid, gn = (size_t)G * 512;
    bf16_t* wr = (bf16_t*)(p.ws + WS_WR);
    for (size_t i = gt; i < (size_t)NL * 48 * DM; i += gn) { const int l = (int)(i / (48 * DM)), o = (int)(i / DM) % 48, k = (int)(i % DM);
        float w = 0.f; if (o < 4) w = p.rg_w[((size_t)l * DM + k) * NGRP + o]; else if (o < 36) w = p.re_w[((size_t)l * DM + k) * NE + (o - 4)];
        w *= p.norm2_w[l * DM + k];
        const unsigned hi = f2bf(w); const unsigned lo = f2bf(w - bf2f(hi));
        wr[((size_t)(l * 2 + 0) * 48 + o) * DM + k] = (bf16_t)hi; wr[((size_t)(l * 2 + 1) * 48 + o) * DM + k] = (bf16_t)lo; }
    bf16_t* wsb = (bf16_t*)(p.ws + WS_WSB);
    for (size_t i = gt; i < (size_t)NL * GG * 128 * 128; i += gn) wsb[i] = (bf16_t)f2bf(p.w_s[i]);
    float* cosT = (float*)(p.ws + WS_ROPE); float* sinT = cosT + SEQ * 64;
    for (size_t i = gt; i < (size_t)SEQ * 64; i += gn) { const int pos = (int)(i >> 6), ii = (int)(i & 63);
        const float ang = (float)pos * powf(10000.0f, -(float)ii / 64.0f); cosT[i] = cosf(ang); sinT[i] = sinf(ang); }
}

__device__ __forceinline__ void r2_phase(const Ptrs& p, int l, LAS unsigned char* lds, int G) {
    unsigned* ctl = (unsigned*)(p.ws + WS_CTL);
    const int tid = hidden_tid(), lane = tid & 63, w = __builtin_amdgcn_readfirstlane(tid >> 6), r = lane & 15, q4 = lane >> 4, tp = w >> 1, kh = w & 1;
    LAS float* lgp = (LAS float*)lds;
    LAS float* ssq = (LAS float*)(lds + 8 * 16 * 48 * 4);
    LAS int* lcnt = (LAS int*)(lds + 8 * 16 * 48 * 4 + 512);
    LAS int* gbase = lcnt + 32;
    const bf16_t* x1 = (const bf16_t*)(p.ws + WS_X1); bf16_t* h2b = (bf16_t*)(p.ws + WS_H2B);
    const bf16_t* whi = (const bf16_t*)(p.ws + WS_WR) + (size_t)(l * 2 + 0) * 48 * DM; const bf16_t* wlo = (const bf16_t*)(p.ws + WS_WR) + (size_t)(l * 2 + 1) * 48 * DM;
    for (int base = (int)blockIdx.x * 64; base < NTOK; base += G * 64) {
        const int row = base + 16 * tp + r;
        f32x4 acc[3]; acc[0] = acc[1] = acc[2] = (f32x4){0.f, 0.f, 0.f, 0.f}; float ss = 0.f;
        const bf16_t* xr = x1 + (size_t)row * DM + kh * 1024 + 16 * q4; unsigned char* hr8 = (unsigned char*)h2b + (size_t)row * DM + kh * 1024 + 16 * q4; bf16_t* hr = h2b + (size_t)row * DM + kh * 1024 + 16 * q4;
        const bf16_t* bh = whi + (size_t)r * DM + kh * 1024 + 16 * q4; const bf16_t* bl = wlo + (size_t)r * DM + kh * 1024 + 16 * q4;
        constexpr int NBS = 4;
        for (int S0 = 0; S0 < 16; S0 += NBS) {
            u32x4 xq[2 * NBS]; u32x4 h8[NBS];
#pragma unroll
            for (int j = 0; j < 2 * NBS; ++j) xq[j] = *(const u32x4*)(xr + 64 * (S0 + (j >> 1)) + 8 * (j & 1));
#pragma unroll
            for (int j = 0; j < 2 * NBS; ++j) { const int ko = 64 * (S0 + (j >> 1)) + 8 * (j & 1);
                float xv[8]; unpack8(xq[j], xv);
#pragma unroll
                for (int i = 0; i < 8; ++i) ss += xv[i] * xv[i];
                if (j & 1) { h8[j >> 1].z = pk4_fp8(xv[0], xv[1], xv[2], xv[3]); h8[j >> 1].w = pk4_fp8(xv[4], xv[5], xv[6], xv[7]); } else { h8[j >> 1].x = pk4_fp8(xv[0], xv[1], xv[2], xv[3]); h8[j >> 1].y = pk4_fp8(xv[4], xv[5], xv[6], xv[7]); }
                const bf16x8 ahi = __builtin_bit_cast(bf16x8, xq[j]);
#pragma unroll
                for (int nt = 0; nt < 3; ++nt) {
#ifdef R2_HILO
                    const bf16x8 bhi = *(const bf16x8*)(bh + (size_t)nt * 16 * DM + ko), blo = *(const bf16x8*)(bl + (size_t)nt * 16 * DM + ko);
                    acc[nt] = __builtin_amdgcn_mfma_f32_16x16x32_bf16(ahi, bhi, acc[nt], 0, 0, 0);
                    acc[nt] = __builtin_amdgcn_mfma_f32_16x16x32_bf16(ahi, blo, acc[nt], 0, 0, 0);
#else
                    const bf16x8 bhi = *(const bf16x8*)(bh + (size_t)nt * 16 * DM + ko);
                    acc[nt] = __builtin_amdgcn_mfma_f32_16x16x32_bf16(ahi, bhi, acc[nt], 0, 0, 0);
#endif
                }
            }
            asm volatile("" ::: "memory");
#pragma unroll
            for (int j = 0; j < NBS; ++j) { if (FP8MOE) *(u32x4*)(hr8 + 64 * (S0 + j)) = h8[j]; else { *(u32x4*)(hr + 64 * (S0 + j)) = xq[2 * j]; *(u32x4*)(hr + 64 * (S0 + j) + 8) = xq[2 * j + 1]; } }
            asm volatile("" ::: "memory");
        }
#pragma unroll
        for (int nt = 0; nt < 3; ++nt)
#pragma unroll
            for (int rr = 0; rr < 4; ++rr) lgp[(w * 16 + 4 * q4 + rr) * 48 + 16 * nt + r] = acc[nt][rr];
        ss += shx(ss, lane, 16); ss += shx(ss, lane, 32);
        if (q4 == 0) ssq[w * 16 + r] = ss;
        if (tid < 32) lcnt[tid] = 0;
        __syncthreads();
        int e0 = 0, e1 = 0, lp0 = 0, lp1 = 0; float w0 = 0.f, w1 = 0.f, rstd = 0.f;
        const bool router = (kh == 0 && lane < 16);
        const int tokn = base + 16 * tp + lane;
        if (router) {
            rstd = 1.0f / sqrtf((ssq[w * 16 + lane] + ssq[(w + 1) * 16 + lane]) * (1.0f / DM) + EPS);
            LAS float* mine = lgp + (w * 16 + lane) * 48; const LAS float* oth = lgp + ((w + 1) * 16 + lane) * 48;
            for (int o = 0; o < 36; ++o) mine[o] = (mine[o] + oth[o]) * rstd + (o < 4 ? p.rg_b[l * NGRP + o] : p.re_b[l * NE + o - 4]);
            route_token((const LAS float*)mine, e0, e1, w0, w1);
            lp0 = __hip_atomic_fetch_add(&lcnt[e0], 1, __ATOMIC_RELAXED, __HIP_MEMORY_SCOPE_WORKGROUP); lp1 = __hip_atomic_fetch_add(&lcnt[e1], 1, __ATOMIC_RELAXED, __HIP_MEMORY_SCOPE_WORKGROUP);
        }
        __syncthreads();
        if (tid < 32) { const int c = lcnt[tid]; gbase[tid] = c ? (int)__hip_atomic_fetch_add(&ctl[CW_CNT + (l * NE + tid) * 16], (unsigned)c, __ATOMIC_RELAXED, __HIP_MEMORY_SCOPE_AGENT) : 0; }
        __syncthreads();
        if (router) {
            const int s0 = gbase[e0] + lp0, s1 = gbase[e1] + lp1;
            int* tok = (int*)(p.ws + WS_TOK); float* rse = (float*)(p.ws + WS_RSE);
            tok[(size_t)e0 * NTOK + s0] = tokn; rse[(size_t)e0 * NTOK + s0] = rstd; tok[(size_t)e1 * NTOK + s1] = tokn; rse[(size_t)e1 * NTOK + s1] = rstd;
            Rec rc; rc.e0 = e0; rc.s0 = s0; rc.w0 = w0; rc.e1 = e1; rc.s1 = s1; rc.w1 = w1; rc.pad0 = 0; rc.pad1 = 0;
            ((Rec*)(p.ws + WS_REC))[tokn] = rc;
        }
        __syncthreads();
    }
}

typedef short s16x4 __attribute__((ext_vector_type(4)));
__device__ __forceinline__ unsigned off_b(unsigned row, unsigned ch) { return 256u * row + 16u * (ch ^ (((row & 3u) << 2) | ((row >> 2) & 3u))); }
__device__ __forceinline__ unsigned tr_addr(unsigned r0, unsigned c, unsigned lane) { const unsigned q = (lane & 15u) >> 2, pp = lane & 3u; return off_b(r0 + q, 2u * c + (pp >> 1)) + 8u * (pp & 1u); }
__device__ __forceinline__ s16x4 trd(const LAS unsigned char* p) { return __builtin_amdgcn_ds_read_tr16_b64_v4i16((LAS s16x4*)p); }
__device__ __forceinline__ bf16x8 mk8(s16x4 a, s16x4 b) { return __builtin_shufflevector(a, b, 0, 1, 2, 3, 4, 5, 6, 7); }
constexpr unsigned IMG_K = 0, IMG_V = 32768, IMG_S = 65536;
constexpr unsigned BUF_K0 = 0, BUF_V0 = 32768, BUF_K1 = 65536, BUF_V1 = 98304;

__device__ __forceinline__ void load_image(LAS unsigned char* lds, unsigned img, const bf16_t* src, int tid) {
#pragma unroll
    for (int i = 0; i < 4; ++i) { const int idx = tid + 512 * i, row = idx >> 4, ch = idx & 15;
        const u32x4 v = *(const u32x4*)(src + (size_t)row * INW + ch * 8);
        *(LAS u32x4*)(lds + img + off_b(row, ch)) = v; }
}
__device__ __forceinline__ void dma_image(LAS unsigned char* lds, unsigned img, const bf16_t* src, int tid, int wv) {
#pragma unroll
    for (int j = 0; j < 4; ++j) { const unsigned row = 32u * j + ((unsigned)tid >> 4), cp = (unsigned)tid & 15u, cl = cp ^ (((row & 3u) << 2) | ((row >> 2) & 3u));
        __builtin_amdgcn_global_load_lds((const unsigned*)(src + (size_t)row * INW + cl * 8), (LAS unsigned*)(lds + img + (unsigned)(j * 512 + wv * 64) * 16u), 16, 0, 0); }
}
#define MIX_BAR() do { asm volatile("s_waitcnt lgkmcnt(0)" ::: "memory"); __builtin_amdgcn_s_barrier(); asm volatile("" ::: "memory"); } while (0)
struct TrBases { unsigned k0, v0[8], dv; };
__device__ __forceinline__ void make_bases(TrBases& B, int w, int lane) {
    const unsigned q4 = lane >> 4;
    B.k0 = tr_addr(8 * q4, w, lane); B.dv = tr_addr(8 * q4 + 4, 0, lane) - tr_addr(8 * q4, 0, lane);
#pragma unroll
    for (int c = 0; c < 8; ++c) B.v0[c] = tr_addr(8 * q4, c, lane);
}
template <int CB>
__device__ __forceinline__ void kv_chunk(const LAS unsigned char* kimg, const LAS unsigned char* vimg, const TrBases& B, const float (&f0)[8], float g32i, f32x4 (&D)[8], float sk0 = 1.0f) {
    float sk = sk0; unsigned dv = B.dv; asm volatile("" : "+v"(dv));
#pragma unroll
    for (int ks = 0; ks < 4; ++ks) {
        const s16x4 ka = trd(kimg + B.k0 + 8192 * ks), kb = trd(kimg + (B.k0 + dv) + 8192 * ks);
        u32x4 kk;
        kk.x = pk2(bf2f((unsigned short)ka[0]) * (f0[0] * sk), bf2f((unsigned short)ka[1]) * (f0[1] * sk)); kk.y = pk2(bf2f((unsigned short)ka[2]) * (f0[2] * sk), bf2f((unsigned short)ka[3]) * (f0[3] * sk));
        kk.z = pk2(bf2f((unsigned short)kb[0]) * (f0[4] * sk), bf2f((unsigned short)kb[1]) * (f0[5] * sk)); kk.w = pk2(bf2f((unsigned short)kb[2]) * (f0[6] * sk), bf2f((unsigned short)kb[3]) * (f0[7] * sk));
        const bf16x8 af = __builtin_bit_cast(bf16x8, kk);
#pragma unroll
        for (int c4 = 0; c4 < 8; c4 += CB) {
            s16x4 va[CB], vb[CB];
#pragma unroll
            for (int c = 0; c < CB; ++c) { va[c] = trd(vimg + B.v0[c4 + c] + 8192 * ks); vb[c] = trd(vimg + (B.v0[c4 + c] + dv) + 8192 * ks); }
            __builtin_amdgcn_sched_barrier(0);
#pragma unroll
            for (int c = 0; c < CB; ++c) D[c4 + c] = __builtin_amdgcn_mfma_f32_16x16x32_bf16(af, mk8(va[c], vb[c]), D[c4 + c], 0, 0, 0);
            __builtin_amdgcn_sched_barrier(0);
        }
        sk *= g32i;
    }
}
__device__ __forceinline__ void kv_item(const Ptrs& p, LAS unsigned char* lds, int wg) {
    const int tid = hidden_tid(), lane = tid & 63, w = __builtin_amdgcn_readfirstlane(tid >> 6), q4 = lane >> 4;
    const int b = wg >> 6, h = (wg >> 3) & 7, q8 = wg & 7;
    const float lg = log2_gamma(h), g128 = exp2f(lg * 128.0f), g32i = exp2f(-lg * 32.0f);
    const bf16_t* P = (const bf16_t*)(p.ws + WS_P);
    const bf16_t* srcK = P + ((size_t)b * SEQ + q8 * 512) * INW + COL_K + h * 128; const bf16_t* srcV = srcK + (COL_V - COL_K);
    TrBases B; make_bases(B, w, lane);
    float f0[8];
#pragma unroll
    for (int j = 0; j < 8; ++j) f0[j] = exp2f(lg * (float)(127 - 8 * q4 - j));
    f32x4 st[8];
#pragma unroll
    for (int c = 0; c < 8; ++c) st[c] = (f32x4){0.f, 0.f, 0.f, 0.f};
    __syncthreads();
    dma_image(lds, BUF_K0, srcK, tid, w); dma_image(lds, BUF_V0, srcV, tid, w);
    for (int ch = 0; ch < 4; ++ch) {
        const unsigned cur = (ch & 1) ? BUF_K1 : BUF_K0, oth = (ch & 1) ? BUF_K0 : BUF_K1;
        if (ch < 3) { dma_image(lds, oth, srcK + (size_t)(ch + 1) * 128 * INW, tid, w); dma_image(lds, oth + 32768, srcV + (size_t)(ch + 1) * 128 * INW, tid, w);
            asm volatile("s_waitcnt vmcnt(8)" ::: "memory"); }
        else asm volatile("s_waitcnt vmcnt(0)" ::: "memory");
        MIX_BAR();
#pragma unroll
        for (int c = 0; c < 8; ++c) st[c] = st[c] * g128;
        kv_chunk<8>(lds + cur, lds + cur + 32768, B, f0, g32i, st);
        MIX_BAR();
    }
    f32x4* dump = (f32x4*)(p.ws + WS_SSUP) + (size_t)wg * 4096;
#pragma unroll
    for (int c = 0; c < 8; ++c) dump[c * 512 + tid] = st[c];
}
__device__ __forceinline__ void ret_item(const Ptrs& p, int l, LAS unsigned char* lds, int wg) {
    const int tid = hidden_tid(), lane = tid & 63, w = __builtin_amdgcn_readfirstlane(tid >> 6), q4 = lane >> 4, fr = lane & 15;
    const int b = wg >> 6, h = (wg >> 3) & 7, q8 = wg & 7;
    const float lg = log2_gamma(h), g128 = exp2f(lg * 128.0f), g512 = exp2f(lg * 512.0f), g32i = exp2f(-lg * 32.0f);
    const bf16_t* P = (const bf16_t*)(p.ws + WS_P); bf16_t* mix = (bf16_t*)(p.ws + WS_MIX);
    const size_t rowb = (size_t)b * SEQ + q8 * 512;
    const bf16_t* srcK = P + rowb * INW + COL_K + h * 128; const bf16_t* srcV = srcK + (COL_V - COL_K);
    __syncthreads();
    dma_image(lds, BUF_K0, srcK, tid, w); dma_image(lds, BUF_V0, srcV, tid, w);
    TrBases B; make_bases(B, w, lane);
    float f0[8];
#pragma unroll
    for (int j = 0; j < 8; ++j) f0[j] = exp2f(lg * (float)(127 - 8 * q4 - j));
    unsigned kb0[4], sb[4];
    const unsigned kr = 8 * (fr >> 2) + (fr & 3);
#pragma unroll
    for (int ks = 0; ks < 4; ++ks) { kb0[ks] = off_b(kr, 4 * ks + q4); sb[ks] = off_b(fr, 4 * ks + q4); }
    const unsigned dk = off_b(kr + 4, q4) - off_b(kr, q4);
    const unsigned stw = off_b(fr, 2 * w + (q4 >> 1)) + 8 * (q4 & 1);
    const int t = 16 * w + fr;
    const float gq = exp2f(lg * (float)(t + 1));
    bf16x8 qf[4];
#pragma unroll
    for (int ks = 0; ks < 4; ++ks) qf[ks] = *(const bf16x8*)(P + (rowb + t) * INW + COL_Q + h * 128 + 32 * ks + 8 * q4);
    LAS float* gnw = (LAS float*)(lds + LDS_TAB);
    if (tid < 128) gnw[tid] = p.ret_gn_w[l * 1024 + h * 128 + tid];
    f32x4 st[8];
#pragma unroll
    for (int c = 0; c < 8; ++c) st[c] = (f32x4){0.f, 0.f, 0.f, 0.f};
    for (int q0 = 0; q0 < q8; q0 += 4) {
        const f32x4* dump = (const f32x4*)(p.ws + WS_SSUP) + (size_t)(wg - q8 + q0) * 4096 + tid;
        f32x4 dv[4][8]; const int nq = q8 - q0;
#pragma unroll
        for (int i = 0; i < 4; ++i) if (i < nq) {
#pragma unroll
            for (int c = 0; c < 8; ++c) dv[i][c] = dump[(size_t)i * 4096 + c * 512]; }
#pragma unroll
        for (int i = 0; i < 4; ++i) if (i < nq) {
#pragma unroll
            for (int c = 0; c < 8; ++c) st[c] = st[c] * g512 + dv[i][c]; }
    }
    for (int ch = 0; ch < 4; ++ch) {
        const size_t row0 = rowb + ch * 128;
        const unsigned cur = (ch & 1) ? BUF_K1 : BUF_K0, oth = (ch & 1) ? BUF_K0 : BUF_K1;
        const LAS unsigned char* kimg = lds + cur; const LAS unsigned char* vimg = lds + cur + 32768; LAS unsigned char* simg = lds + oth + 32768;
        asm volatile("s_waitcnt vmcnt(0)" ::: "memory");
        MIX_BAR();
#pragma unroll
        for (int c = 0; c < 8; ++c) { u32x2 wv; wv.x = pk2(st[c][0], st[c][1]); wv.y = pk2(st[c][2], st[c][3]); *(LAS u32x2*)(simg + stw + 4096 * c) = wv; }
        if (ch < 3) dma_image(lds, oth, srcK + (size_t)(ch + 1) * 128 * INW, tid, w);
        u32x2 gv8[8];
#pragma unroll
        for (int c = 0; c < 8; ++c) gv8[c] = *(const u32x2*)(P + (row0 + t) * INW + COL_G + h * 128 + 16 * c + 4 * q4);
        MIX_BAR();
        f32x4 O[8];
#pragma unroll
        for (int c2 = 0; c2 < 8; c2 += 2) {
            bf16x8 sa[2][4];
#pragma unroll
            for (int c = 0; c < 2; ++c)
#pragma unroll
                for (int ks = 0; ks < 4; ++ks) sa[c][ks] = *(const LAS bf16x8*)(simg + sb[ks] + 4096 * (c2 + c));
            __builtin_amdgcn_sched_barrier(0);
#pragma unroll
            for (int c = 0; c < 2; ++c) { O[c2 + c] = (f32x4){0.f, 0.f, 0.f, 0.f};
#pragma unroll
                for (int ks = 0; ks < 4; ++ks) O[c2 + c] = __builtin_amdgcn_mfma_f32_16x16x32_bf16(sa[c][ks], qf[ks], O[c2 + c], 0, 0, 0);
                O[c2 + c] = O[c2 + c] * gq; }
            __builtin_amdgcn_sched_barrier(0);
        }
        MIX_BAR();
        if (ch < 3) dma_image(lds, oth + 32768, srcV + (size_t)(ch + 1) * 128 * INW, tid, w);
#ifdef RP_I
        for (int rr = 0; rr < 1 + RP_I; ++rr) { float zf = rr ? 0.f : 1.f; asm volatile("" : "+v"(zf));
#else
        { const float zf = 1.f;
#endif
        for (int stp = 0; stp <= (w >> 1); ++stp) {
            f32x4 T0 = (f32x4){0.f, 0.f, 0.f, 0.f}, T1 = T0;
            const LAS unsigned char* kst = kimg + 8192 * stp; const LAS unsigned char* vst = vimg + 8192 * stp; unsigned dvl = B.dv, dkl = dk; asm volatile("" : "+v"(dvl), "+v"(dkl));
            bf16x8 a0[4], a1[4];
#pragma unroll
            for (int ks = 0; ks < 4; ++ks) { a0[ks] = *(const LAS bf16x8*)(kst + kb0[ks]); a1[ks] = *(const LAS bf16x8*)(kst + (kb0[ks] + dkl)); }
            __builtin_amdgcn_sched_barrier(0);
#pragma unroll
            for (int ks = 0; ks < 4; ++ks) { T0 = __builtin_amdgcn_mfma_f32_16x16x32_bf16(a0[ks], qf[ks], T0, 0, 0, 0); T1 = __builtin_amdgcn_mfma_f32_16x16x32_bf16(a1[ks], qf[ks], T1, 0, 0, 0); }
            float pv[8];
#pragma unroll
            for (int r = 0; r < 4; ++r) { const int s0 = 32 * stp + 8 * q4 + r, s1 = s0 + 4;
                pv[r] = (t >= s0) ? T0[r] * (zf * exp2f(lg * (float)(t - s0))) : 0.f; pv[4 + r] = (t >= s1) ? T1[r] * (zf * exp2f(lg * (float)(t - s1))) : 0.f; }
            u32x4 pk; pk.x = pk2(pv[0], pv[1]); pk.y = pk2(pv[2], pv[3]); pk.z = pk2(pv[4], pv[5]); pk.w = pk2(pv[6], pv[7]);
            const bf16x8 pf = __builtin_bit_cast(bf16x8, pk);
#pragma unroll
            for (int c4 = 0; c4 < 8; c4 += 4) {
                s16x4 va[4], vb[4];
#pragma unroll
                for (int c = 0; c < 4; ++c) { va[c] = trd(vst + B.v0[c4 + c]); vb[c] = trd(vst + (B.v0[c4 + c] + dvl)); }
                __builtin_amdgcn_sched_barrier(0);
#pragma unroll
                for (int c = 0; c < 4; ++c) O[c4 + c] = __builtin_amdgcn_mfma_f32_16x16x32_bf16(mk8(va[c], vb[c]), pf, O[c4 + c], 0, 0, 0);
                __builtin_amdgcn_sched_barrier(0);
            }
        }
        }
        if (ch < 3) {
#pragma unroll
            for (int ks = 0; ks < 4; ++ks) qf[ks] = *(const bf16x8*)(P + (row0 + 128 + t) * INW + COL_Q + h * 128 + 32 * ks + 8 * q4); }
#ifdef RP_L
        for (int rr = 0; rr < 1 + RP_L; ++rr) { asm volatile("" : "+v"(O[0]));
#else
        {
#endif
        { float s = 0.f;
#pragma unroll
          for (int c = 0; c < 8; ++c) s += (O[c][0] + O[c][1]) + (O[c][2] + O[c][3]);
          s += shx(s, lane, 16); s += shx(s, lane, 32);
          const float mu = s * (1.0f / 128.0f); float qv = 0.f;
#pragma unroll
          for (int c = 0; c < 8; ++c) { const f32x4 d = O[c] - mu; qv += (d[0] * d[0] + d[1] * d[1]) + (d[2] * d[2] + d[3] * d[3]); }
          qv += shx(qv, lane, 16); qv += shx(qv, lane, 32);
          const float rs = 1.0f / sqrtf(qv * (1.0f / 128.0f) + EPS);
          const size_t row = row0 + t;
#pragma unroll
          for (int c = 0; c < 8; ++c) { const int e0 = h * 128 + 16 * c + 4 * q4;
              const u32x2 gv = gv8[c]; const f32x4 gw = *(const LAS f32x4*)(gnw + 16 * c + 4 * q4);
              const float g0 = bf2f(gv.x & 0xffffu), g1 = bf2f(gv.x >> 16), g2 = bf2f(gv.y & 0xffffu), g3 = bf2f(gv.y >> 16);
              const float m0 = silu(g0) * ((O[c][0] - mu) * rs * gw[0]), m1 = silu(g1) * ((O[c][1] - mu) * rs * gw[1]), m2 = silu(g2) * ((O[c][2] - mu) * rs * gw[2]), m3 = silu(g3) * ((O[c][3] - mu) * rs * gw[3]);
              if (FP8G2) *(unsigned*)((unsigned char*)mix + row * DM + e0) = pk4_fp8(m0 * 4.f, m1 * 4.f, m2 * 4.f, m3 * 4.f);
              else { u32x2 o; o.x = pk2(m0, m1); o.y = pk2(m2, m3); *(u32x2*)(mix + row * DM + e0) = o; } } }
        }
#pragma unroll
        for (int c = 0; c < 8; ++c) st[c] = st[c] * g128;
        kv_chunk<4>(kimg, vimg, B, f0, g32i, st);
#ifdef RP_K
        for (int rr = 0; rr < RP_K; ++rr) { float zf = 0.f; asm volatile("" : "+v"(zf)); kv_chunk<4>(kimg, vimg, B, f0, g32i, st, zf); }
#endif
    }
    MIX_BAR();
}
__device__ __forceinline__ float dpp_sum16(float v) {
    int x;
    x = __builtin_amdgcn_update_dpp(0, __builtin_bit_cast(int, v), 0xB1, 0xF, 0xF, true); v += __builtin_bit_cast(float, x);
    x = __builtin_amdgcn_update_dpp(0, __builtin_bit_cast(int, v), 0x4E, 0xF, 0xF, true); v += __builtin_bit_cast(float, x);
    x = __builtin_amdgcn_update_dpp(0, __builtin_bit_cast(int, v), 0x141, 0xF, 0xF, true); v += __builtin_bit_cast(float, x);
    x = __builtin_amdgcn_update_dpp(0, __builtin_bit_cast(int, v), 0x140, 0xF, 0xF, true); v += __builtin_bit_cast(float, x);
    return v;
}
__device__ __forceinline__ void gmlp_fetch(const Ptrs& p, int it, int tid, u32x4 (&vq)[4]) {
    const int b = it >> 8, nb = (it >> 3) & 31, g = it & 7;
    const bf16_t* src = (const bf16_t*)(p.ws + WS_P) + ((size_t)b * SEQ + nb * 128) * INW;
#pragma unroll
    for (int i = 0; i < 4; ++i) { const int idx = tid + 512 * i, row = idx >> 4, ch = idx & 15; vq[i] = *(const u32x4*)(src + (size_t)row * INW + COL_VS + g * 128 + ch * 8); }
}
__device__ __forceinline__ void gmlp_items(const Ptrs& p, int l, LAS unsigned char* lds, int first, int G) {
    const int tid = hidden_tid(), lane = tid & 63, w = __builtin_amdgcn_readfirstlane(tid >> 6), q4 = lane >> 4, fr = lane & 15;
    bf16_t* mix = (bf16_t*)(p.ws + WS_MIX);
    const int ucol = 16 * w + 4 * q4;
    u32x4 vq[4];
    if (first < 1024) gmlp_fetch(p, first, tid, vq);
    int gcur = -1; float bs[8]; f32x4 n0, n1;
    const unsigned long long tpA = TP_NOW();
    for (int it = first; it < 1024; it += G) {
        const int b = it >> 8, nb = (it >> 3) & 31, g = it & 7;
        const size_t row0 = (size_t)b * SEQ + nb * 128;
        const unsigned long long tpB = TP_NOW();
        if (g != gcur) {
            gcur = g;
            const bf16_t* Wm = (const bf16_t*)(p.ws + WS_WSB) + ((size_t)l * GG + g) * 128 * 128;
            __syncthreads();
#pragma unroll
            for (int i = 0; i < 4; ++i) { const int idx = tid + 512 * i, row = idx >> 4, ch = idx & 15; *(LAS u32x4*)(lds + IMG_V + off_b(row, ch)) = *(const u32x4*)(Wm + (size_t)row * 128 + ch * 8); }
#pragma unroll
            for (int tt = 0; tt < 8; ++tt) bs[tt] = p.b_s[((size_t)l * GG + g) * 128 + 16 * tt + fr];
            n0 = *(const f32x4*)(p.gmlp_norm_w + l * 1024 + g * 128 + (tid & 15) * 8); n1 = *(const f32x4*)(p.gmlp_norm_w + l * 1024 + g * 128 + (tid & 15) * 8 + 4);
        }
        __syncthreads();
#ifdef GP_A
        for (int rr = 0; rr < GP_A; ++rr)
#endif
#pragma unroll
        for (int i = 0; i < 4; ++i) { const int idx = tid + 512 * i, row = idx >> 4, ch = idx & 15;
            float x[8]; unpack8(vq[i], x);
#ifdef GP_A
            asm volatile("" : "+v"(x[0]));
#endif
            float s = 0.f;
#pragma unroll
            for (int j = 0; j < 8; ++j) s += x[j];
            s = dpp_sum16(s);
            const float mu = s * (1.0f / 128.0f); float qv = 0.f;
#pragma unroll
            for (int j = 0; j < 8; ++j) { x[j] -= mu; qv += x[j] * x[j]; }
            qv = dpp_sum16(qv);
            const float rs = __builtin_amdgcn_rsqf(qv * (1.0f / 128.0f) + EPS);
            u32x4 o; o.x = pk2(x[0] * rs * n0[0], x[1] * rs * n0[1]); o.y = pk2(x[2] * rs * n0[2], x[3] * rs * n0[3]); o.z = pk2(x[4] * rs * n1[0], x[5] * rs * n1[1]); o.w = pk2(x[6] * rs * n1[2], x[7] * rs * n1[3]);
            *(LAS u32x4*)(lds + IMG_K + off_b(row, ch)) = o; }
        u32x2 uv[8];
#pragma unroll
        for (int tt = 0; tt < 8; ++tt) uv[tt] = *(const u32x2*)((const bf16_t*)(p.ws + WS_P) + (row0 + 16 * tt + fr) * INW + COL_U + g * 128 + ucol);
        if (it + G < 1024) gmlp_fetch(p, it + G, tid, vq);
        __syncthreads();
        if (l == 0) TP_ADD(CW_TB, tpB);
        const unsigned tb0 = IMG_K + tr_addr(8 * q4, w, lane), tb1 = IMG_K + tr_addr(8 * q4 + 4, w, lane);
        bf16x8 af[4];
#pragma unroll
        for (int ks = 0; ks < 4; ++ks) af[ks] = mk8(trd(lds + tb0 + 8192 * ks), trd(lds + tb1 + 8192 * ks));
        unsigned wmb[4];
#pragma unroll
        for (int ks = 0; ks < 4; ++ks) wmb[ks] = off_b(fr, 4 * ks + q4);
        f32x4 Z[8];
#ifdef GP_B
        for (int rr = 0; rr < GP_B; ++rr) { asm volatile("" : "+v"(wmb[0]));
#endif
#pragma unroll
        for (int tt = 0; tt < 8; ++tt) {
            Z[tt] = (f32x4){0.f, 0.f, 0.f, 0.f};
#pragma unroll
            for (int ks = 0; ks < 4; ++ks) { if (tt < 4 && ks >= 2) continue;
                const bf16x8 bw = *(const LAS bf16x8*)(lds + IMG_V + wmb[ks] + 4096 * tt);
                Z[tt] = __builtin_amdgcn_mfma_f32_16x16x32_bf16(af[ks], bw, Z[tt], 0, 0, 0); }
        }
#ifdef GP_B
        }
#endif
        const int c0 = g * 128 + ucol;
#ifdef GP_C
        for (int rr = 0; rr < GP_C; ++rr) { asm volatile("" : "+v"(Z[0]));
#endif
#pragma unroll
        for (int tt = 0; tt < 8; ++tt) { const size_t row = row0 + 16 * tt + fr;
            const float m0 = bf2f(uv[tt].x & 0xffffu) * (Z[tt][0] + bs[tt]), m1 = bf2f(uv[tt].x >> 16) * (Z[tt][1] + bs[tt]), m2 = bf2f(uv[tt].y & 0xffffu) * (Z[tt][2] + bs[tt]), m3 = bf2f(uv[tt].y >> 16) * (Z[tt][3] + bs[tt]);
            if (FP8G2) *(unsigned*)((unsigned char*)mix + row * DM + 1024 + c0) = pk4_fp8(m0 * 4.f, m1 * 4.f, m2 * 4.f, m3 * 4.f);
            else { u32x2 o; o.x = pk2(m0, m1); o.y = pk2(m2, m3); *(u32x2*)(mix + row * DM + 1024 + c0) = o; } }
#ifdef GP_C
        }
#endif
    }
    if (l == 0) TP_ADD(CW_TA, tpA);
}

template <int MODE, class EB>
__device__ __forceinline__ void row_phase2(const Ptrs& p, const void* srcv, bf16_t* xres  , bf16_t* xb, const Rec* rec, const bf16_t* y, EB ebase, int gw, int ngw, int lane) {
    for (int row = gw; row < NTOK; row += ngw) {
        float v[4][8];
        if (MODE == 0) { const f32x4* xr = (const f32x4*)((const float*)srcv + (size_t)row * DM) + 2 * lane;
#pragma unroll
            for (int j = 0; j < 4; ++j) { const f32x4 a = __builtin_nontemporal_load(xr + 128 * j), b = __builtin_nontemporal_load(xr + 128 * j + 1); v[j][0] = a.x; v[j][1] = a.y; v[j][2] = a.z; v[j][3] = a.w; v[j][4] = b.x; v[j][5] = b.y; v[j][6] = b.z; v[j][7] = b.w; }
        } else {
            const Rec r = rec[row];
            const size_t r0 = (size_t)(ebase[r.e0] + r.s0), r1 = (size_t)(ebase[r.e1] + r.s1);
            const u32x4* xr = (const u32x4*)((const bf16_t*)srcv + (size_t)row * DM) + lane;
            u32x4 xv[4];
#pragma unroll
            for (int j = 0; j < 4; ++j) xv[j] = __builtin_nontemporal_load(xr + 64 * j);
            if (FP8MOE) {
                const u32x2* y0 = (const u32x2*)((const unsigned char*)y + r0 * DM) + lane; const u32x2* y1 = (const u32x2*)((const unsigned char*)y + r1 * DM) + lane;
                u32x2 av[4], bv[4]; const float w0 = r.w0 * (1.0f / 16.0f), w1 = r.w1 * (1.0f / 16.0f);
#pragma unroll
                for (int j = 0; j < 4; ++j) { av[j] = __builtin_nontemporal_load(y0 + 64 * j); bv[j] = __builtin_nontemporal_load(y1 + 64 * j); }
#pragma unroll
                for (int j = 0; j < 4; ++j) { float a[8], b[8]; unpack8(xv[j], v[j]); unpack8_fp8(av[j], a); unpack8_fp8(bv[j], b);
#pragma unroll
                    for (int i = 0; i < 8; ++i) v[j][i] += w0 * a[i] + w1 * b[i]; }
            } else {
                const u32x4* y0 = (const u32x4*)(y + r0 * DM) + lane; const u32x4* y1 = (const u32x4*)(y + r1 * DM) + lane;
                u32x4 av[4], bv[4];
#pragma unroll
                for (int j = 0; j < 4; ++j) { av[j] = y0[64 * j]; bv[j] = y1[64 * j]; }
#pragma unroll
                for (int j = 0; j < 4; ++j) { float a[8], b[8]; unpack8(xv[j], v[j]); unpack8(av[j], a); unpack8(bv[j], b);
#pragma unroll
                    for (int i = 0; i < 8; ++i) v[j][i] += r.w0 * a[i] + r.w1 * b[i]; }
            }
        }
        float s = 0.f;
#pragma unroll
        for (int j = 0; j < 4; ++j)
#pragma unroll
            for (int i = 0; i < 8; ++i) s += v[j][i] * v[j][i];
        const float rstd = 1.0f / sqrtf(wave_sum_l(s, lane) * (1.0f / DM) + EPS);
        if (MODE <= 1) { u32x4* o = (u32x4*)(xres + (size_t)row * DM) + lane; u32x4* o2 = (u32x4*)(xb + (size_t)row * DM) + lane;
#pragma unroll
            for (int j = 0; j < 4; ++j) { __builtin_nontemporal_store(pack8(v[j]), o + 64 * j); float n[8];
#pragma unroll
                for (int i = 0; i < 8; ++i) n[i] = v[j][i] * rstd;
                if (FP8G1) { u32x2 w8; w8.x = pk4_fp8(n[0], n[1], n[2], n[3]); w8.y = pk4_fp8(n[4], n[5], n[6], n[7]); *((u32x2*)((unsigned char*)xb + (size_t)row * DM) + lane + 64 * j) = w8; }
                else o2[64 * j] = pack8(n); } }
#ifdef TIMER_PROBE
        float tp_scale = 1.0f, tp_spike = 0.f;
        if (MODE == 2) { const unsigned* cw = (const unsigned*)(p.ws + WS_CTL); tp_scale = 1.0f + sqrtf((float)cw[CW_TA] * 1e-5f); if (row == 0 && lane == 0) tp_spike = (float)cw[CW_TB]; }
#else
        const float tp_scale = 1.0f, tp_spike = 0.f;
#endif
        if (MODE == 2) { f32x4* o = (f32x4*)(p.out + (size_t)row * DM) + 2 * lane; const f32x4* fw = (const f32x4*)p.final_w + 2 * lane;
#pragma unroll
            for (int j = 0; j < 4; ++j) { const f32x4 f0 = fw[128 * j], f1 = fw[128 * j + 1];
                __builtin_nontemporal_store((f32x4){v[j][0] * rstd * f0.x * tp_scale + (j == 0 ? tp_spike : 0.f), v[j][1] * rstd * f0.y * tp_scale, v[j][2] * rstd * f0.z * tp_scale, v[j][3] * rstd * f0.w * tp_scale}, o + 128 * j);
                __builtin_nontemporal_store((f32x4){v[j][4] * rstd * f1.x * tp_scale, v[j][5] * rstd * f1.y * tp_scale, v[j][6] * rstd * f1.z * tp_scale, v[j][7] * rstd * f1.w * tp_scale}, o + 128 * j + 1); } }
    }
}

template <class EB>
__device__ __forceinline__ void rp_fetch(const bf16_t* srcb, const unsigned char* y8, const Rec& r, EB ebase, int row, int lane, u32x4 (&xv)[4], u32x2 (&av)[4], u32x2 (&bv)[4]) {
    const size_t r0 = (size_t)(ebase[r.e0] + r.s0), r1 = (size_t)(ebase[r.e1] + r.s1);
    const u32x4* xr = (const u32x4*)(srcb + (size_t)row * DM) + lane; const u32x2* y0 = (const u32x2*)(y8 + r0 * DM) + lane; const u32x2* y1 = (const u32x2*)(y8 + r1 * DM) + lane;
#pragma unroll
    for (int j = 0; j < 4; ++j) { xv[j] = __builtin_nontemporal_load(xr + 64 * j); av[j] = __builtin_nontemporal_load(y0 + 64 * j); bv[j] = __builtin_nontemporal_load(y1 + 64 * j); }
}
template <int MODE, class EB>
__device__ __forceinline__ void row_phase3(const Ptrs& p, const bf16_t* srcb, bf16_t* xres, bf16_t* xb, const Rec* rec, const unsigned char* y8, EB ebase, int gw, int ngw, int lane) {
    int row = gw; if (row >= NTOK) return;
    Rec rc = rec[row]; Rec rn = rc; if (row + ngw < NTOK) rn = rec[row + ngw];
    u32x4 xv[4]; u32x2 av[4], bv[4];
    rp_fetch(srcb, y8, rc, ebase, row, lane, xv, av, bv);
    for (;;) {
        const int nrow = row + ngw; const bool hn = nrow < NTOK;
        u32x4 xn[4]; u32x2 an[4], bn[4]; Rec rnn = rn;
        if (hn) { rp_fetch(srcb, y8, rn, ebase, nrow, lane, xn, an, bn); if (nrow + ngw < NTOK) rnn = rec[nrow + ngw]; }
        float v[4][8]; const float w0 = rc.w0 * (1.0f / 16.0f), w1 = rc.w1 * (1.0f / 16.0f);
#pragma unroll
        for (int j = 0; j < 4; ++j) { float a[8], b[8]; unpack8(xv[j], v[j]); unpack8_fp8(av[j], a); unpack8_fp8(bv[j], b);
#pragma unroll
            for (int i = 0; i < 8; ++i) v[j][i] += w0 * a[i] + w1 * b[i]; }
        float s = 0.f;
#pragma unroll
        for (int j = 0; j < 4; ++j)
#pragma unroll
            for (int i = 0; i < 8; ++i) s += v[j][i] * v[j][i];
        const float rstd = 1.0f / sqrtf(wave_sum_l(s, lane) * (1.0f / DM) + EPS);
        if (MODE == 1) { u32x4* o = (u32x4*)(xres + (size_t)row * DM) + lane; u32x4* o2 = (u32x4*)(xb + (size_t)row * DM) + lane;
#pragma unroll
            for (int j = 0; j < 4; ++j) { __builtin_nontemporal_store(pack8(v[j]), o + 64 * j); float n[8];
#pragma unroll
                for (int i = 0; i < 8; ++i) n[i] = v[j][i] * rstd;
                o2[64 * j] = pack8(n); } }
        if (MODE == 2) { f32x4* o = (f32x4*)(p.out + (size_t)row * DM) + 2 * lane; const f32x4* fw = (const f32x4*)p.final_w + 2 * lane;
#pragma unroll
            for (int j = 0; j < 4; ++j) { const f32x4 f0 = fw[128 * j], f1 = fw[128 * j + 1];
                __builtin_nontemporal_store((f32x4){v[j][0] * rstd * f0.x, v[j][1] * rstd * f0.y, v[j][2] * rstd * f0.z, v[j][3] * rstd * f0.w}, o + 128 * j);
                __builtin_nontemporal_store((f32x4){v[j][4] * rstd * f1.x, v[j][5] * rstd * f1.y, v[j][6] * rstd * f1.z, v[j][7] * rstd * f1.w}, o + 128 * j + 1); } }
        if (!hn) break;
#pragma unroll
        for (int j = 0; j < 4; ++j) { xv[j] = xn[j]; av[j] = an[j]; bv[j] = bn[j]; }
        rc = rn; rn = rnn; row = nrow;
    }
}

constexpr int NPH = 1 + 8 * NL;
struct MegaArgs { Ptrs p; int ph_lo, ph_hi, use_bar, pad; };
__global__ void __launch_bounds__(NWAVES * 64, 2) k_mega(MegaArgs a) {
    extern __shared__ __attribute__((aligned(16))) unsigned char lds_raw[];
    LAS unsigned char* lds = (LAS unsigned char*)lds_raw;
    const Ptrs& p = a.p;
    const int tid = threadIdx.x;
    const int G = gridDim.x; const int bx = blockIdx.x; const int vcu = (G % 8 == 0) ? (bx % 8) * (G / 8) + bx / 8 : bx;
    unsigned* ctl = (unsigned*)(p.ws + WS_CTL);
    volatile LAS unsigned* MISC = (volatile LAS unsigned*)(lds + LDS_MISC);
    if (tid < 32) MISC[tid] = 0u;
    __syncthreads();
    XcdBarrier bar; bar.bar = ctl + CW_BAR; bar.x = 0; bar.st = MISC + 8;
    if (a.use_bar) bar = xcd_barrier_post(ctl + CW_BAR, MISC + 8);
    const int lo = a.ph_lo, hi = a.ph_hi;
#ifndef PHSEL
#define PHSEL 0xff
#endif
#define IN(k) (lo <= (k) && (k) < hi)
#define SEL(j) ((PHSEL >> (j)) & 1)
#ifndef REPEAT_MASK
#define REPEAT_MASK 0
#endif
#define NREP(j) (((REPEAT_MASK >> (j)) & 1) ? 2 : 1)
#define SEAM(k) do { if (IN((k) + 1)) xcd_barrier(bar); } while (0)
    const int ngw = G * NWAVES;
#define ROWIDS() const int _ht = hidden_tid(); const int lane_ = _ht & 63, gw_ = vcu * NWAVES + (_ht >> 6)
    if (IN(0)) for (int rep = 0; rep < NREP(8); ++rep) {
        prologue_phase(p, lds, vcu, G);
        { ROWIDS(); row_phase2<0>(p, p.x, (bf16_t*)(p.ws + WS_X0B), (bf16_t*)(p.ws + WS_XB), nullptr, nullptr, (const int*)nullptr, gw_, ngw, lane_); }
        SEAM(0);
    }
    for (int l = 0; l < NL; ++l) {
        const int pb = 1 + 8 * l;
        if (SEL(0) && IN(pb + 0)) {
            const bool win = (G == 256) && (l == 0 || xb_ld(ctl + CW_MODE) != 0u);
            if (!win || bx < G1_WGS) {
                pg8::DenseOrder S; S.init(NTOK, INW, win ? G1_WGS : G, bx);
                pg8::EpiG1 E{(bf16_t*)(p.ws + WS_P), (const float*)(p.ws + WS_ROPE), (const float*)(p.ws + WS_ROPE) + SEQ * 64, 0};
                pg8::gemm_phase<false>(lds, (const bf16_t*)(p.ws + WS_XB), (const bf16_t*)(p.ws + WS_WINT) + (size_t)l * INW * DM, DM, S, E);
                if (win && tid == 0) (void)xb_add(ctl + CW_G1D + l * 16, 1u);
            } else {
                convert_window(p, lds, ctl, bx - G1_WGS, l == 0 ? 0 : TKM_L2, ctl + CW_G1D + l * 16);
            }
            SEAM(pb + 0);
        }
        if (SEL(1) && IN(pb + 1)) for (int rep = 0; rep < NREP(1); ++rep) {
            for (int it = bx; it < 256; it += G) kv_item(p, lds, it);
            gmlp_items(p, l, lds, bx, G);
            SEAM(pb + 1);
        }
        if (SEL(2) && IN(pb + 2)) for (int rep = 0; rep < NREP(2); ++rep) {
            for (int it = bx; it < 256; it += G) ret_item(p, l, lds, it);
            if (l == 0) convert_drain(p, lds, ctl, 0, TKM_L0, bx, G);
            SEAM(pb + 2);
        }
        if (SEL(3) && IN(pb + 3)) for (int rep = 0; rep < NREP(3); ++rep) {
            pg8::DenseOrder S; S.init(NTOK, DM, G, bx);
            pg8::EpiG2 E{(const bf16_t*)(p.ws + ((l == 0) ? WS_X0B : WS_X2)), (bf16_t*)(p.ws + WS_X1)};
            if (FP8G2) pg8::gemm_phase<true>(lds, (const bf16_t*)(p.ws + WS_MIX), (const bf16_t*)(p.ws + WS_WOUT) + (size_t)l * DM * (DM / 2), DM / 2, S, E);
            else pg8::gemm_phase<false>(lds, (const bf16_t*)(p.ws + WS_MIX), (const bf16_t*)(p.ws + WS_WOUT) + (size_t)l * DM * DM, DM, S, E);
            SEAM(pb + 3);
        }
        if (SEL(4) && IN(pb + 4)) {
            __syncthreads();
            r2_phase(p, l, lds, G);
            convert_drain(p, lds, ctl, l == 0 ? TKM_L0 : TKM_L2, l == 0 ? TKM_L1 : TKM_N, bx, G);
            SEAM(pb + 4);
        }
        if (SEL(5) && IN(pb + 5)) for (int rep = 0; rep < NREP(5); ++rep) {
            const int nu = moe_units(ctl, l, lds, true, (const int*)(p.ws + WS_TOK));
            pg8::MoeOrder<true> S{(const LAS int*)(lds + LDS_UL), (const LAS int*)(lds + LDS_TAB), nu};
            pg8::EpiG3 E{(bf16_t*)(p.ws + WS_HE), (const float*)(p.ws + WS_RSE), (const LAS int*)(lds + LDS_EB)};
            if (FP8MOE) pg8::gemm_phase<true>(lds, (const bf16_t*)(p.ws + WS_H2B), (const bf16_t*)(p.ws + WS_WGU) + (size_t)l * NE * 2048 * (DM / 2), DM / 2, S, E);
            else pg8::gemm_phase<false>(lds, (const bf16_t*)(p.ws + WS_H2B), (const bf16_t*)(p.ws + WS_WGU) + (size_t)l * NE * 2048 * DM, DM, S, E);
            SEAM(pb + 5);
        }
        if (SEL(6) && IN(pb + 6)) for (int rep = 0; rep < NREP(6); ++rep) {
            const int nu = *(const LAS int*)(lds + LDS_UL + 192);
            pg8::MoeOrder<false> S{(const LAS int*)(lds + LDS_UL), (const LAS int*)(lds + LDS_TAB), nu};
            pg8::EpiG4 E{(bf16_t*)(p.ws + WS_Y)};
            if (FP8MOE) pg8::gemm_phase<true>(lds, (const bf16_t*)(p.ws + WS_HE), (const bf16_t*)(p.ws + WS_WD) + (size_t)l * NE * 2048 * (DE / 2), DE / 2, S, E);
            else pg8::gemm_phase<false>(lds, (const bf16_t*)(p.ws + WS_HE), (const bf16_t*)(p.ws + WS_WD) + (size_t)l * NE * 2048 * DE, DE, S, E);
            SEAM(pb + 6);
        }
        if (SEL(7) && IN(pb + 7)) {
            LAS int* eb = (LAS int*)(lds + LDS_EB);
            __syncthreads();
            if (tid == 0) { int acc = 0; for (int e = 0; e < NE; ++e) { eb[e] = acc; acc += (((int)ctl[CW_CNT + (l * NE + e) * 16] + 255) >> 8) << 8; } }
            __syncthreads();
            ROWIDS();
            if (l + 1 < NL) { row_phase3<1>(p, (const bf16_t*)(p.ws + WS_X1), (bf16_t*)(p.ws + WS_X2), (bf16_t*)(p.ws + WS_XB), (const Rec*)(p.ws + WS_REC), (const unsigned char*)(p.ws + WS_Y), (const LAS int*)eb, gw_, ngw, lane_);
                convert_drain(p, lds, ctl, TKM_L1, TKM_L2, bx, G);
                if (bx == 0 && tid == 0) { int left = 0;
                    for (int q = 0; q < 4; ++q) { int m = (int)xb_ld(ctl + CW_PROG + 21 * q); m = m > TKM_L2 ? m : TKM_L2; left += TKM_N - m; }
                    ctl[CW_MODE] = (left * (NLANE / 4) > 9800) ? 1u : 0u; }
                SEAM(pb + 7); }
            else row_phase3<2>(p, (const bf16_t*)(p.ws + WS_X1), nullptr, nullptr, (const Rec*)(p.ws + WS_REC), (const unsigned char*)(p.ws + WS_Y), (const LAS int*)eb, gw_, ngw, lane_);
        }
    }
#undef IN
#undef SEAM
}


extern "C" void kernel_launch(void* const* d_in, const int* in_sizes, int n_in, void* d_out, int out_size, void* d_ws, size_t ws_size, hipStream_t stream) {
    static int init = 0; static int grid = 0;
    if (!init) {
        if (n_in != 17 || ws_size < WS_END) { fprintf(stderr, "kernel_launch: unexpected n_in %d or ws %zu < %zu\n", n_in, ws_size, (size_t)WS_END); init = -1; return; }
        if (hipFuncSetAttribute((const void*)k_mega, hipFuncAttributeMaxDynamicSharedMemorySize, LDS_BYTES) != hipSuccess) { fprintf(stderr, "kernel_launch: hipFuncSetAttribute(k_mega) failed\n"); init = -1; return; }
        int dev = 0, cus = 0, per_cu = 0;
        (void)hipGetDevice(&dev); (void)hipDeviceGetAttribute(&cus, hipDeviceAttributeMultiprocessorCount, dev);
        if (hipOccupancyMaxActiveBlocksPerMultiprocessor(&per_cu, (const void*)k_mega, NWAVES * 64, LDS_BYTES) != hipSuccess || per_cu < 1) fprintf(stderr, "kernel_launch: occupancy query reports %d blocks per CU\n", per_cu);
        (void)hipGetLastError();
        grid = cus > 0 ? cus : 256;
        init = 1;
    }
    if (init < 0) return;
    Ptrs p{};
    p.x = (const float*)d_in[0]; p.norm1_w = (const float*)d_in[1]; p.w_in = (const float*)d_in[2]; p.ret_gn_w = (const float*)d_in[3]; p.gmlp_norm_w = (const float*)d_in[4];
    p.w_s = (const float*)d_in[5]; p.b_s = (const float*)d_in[6]; p.w_out = (const float*)d_in[7]; p.norm2_w = (const float*)d_in[8]; p.rg_w = (const float*)d_in[9]; p.rg_b = (const float*)d_in[10];
    p.re_w = (const float*)d_in[11]; p.re_b = (const float*)d_in[12]; p.w_gate = (const float*)d_in[13]; p.w_up = (const float*)d_in[14]; p.w_down = (const float*)d_in[15]; p.final_w = (const float*)d_in[16];
    p.out = (float*)d_out; p.ws = (unsigned char*)d_ws;
    (void)hipMemsetAsync((char*)d_ws + WS_CTL, 0, 65536, stream);
    MegaArgs a{}; a.p = p; a.pad = 0; a.ph_lo = 0; a.ph_hi = NPH; a.use_bar = 1;
    hipLaunchKernelGGL(k_mega, dim3(grid), dim3(NWAVES * 64), LDS_BYTES, stream, a);
}
```
